# Optimizing an MI355X kernel written in HIP

```python
import math
import jax, jax.numpy as jnp
from jax import lax
import numpy as np

D_MODEL = 1024
BATCH = 8
SEQ = 4096
DEPTH = 1

CTX_LEN = 256
GRID_W = 64
HA = 8
DA = 64
HB = 8
NOPE = 128
ROPE = 64
VB = 128
Q_LORA = 256
KV_LORA = 256
N_KEYS = 128
N_EXPERTS = N_KEYS * N_KEYS
HP = 8
DK_HALF = 128
TOPK_HALF = 16
TOPK = 16
ROPE_BASE = 10000.0
Q_BLOCK = 128
TOK_BLOCK = 128
EPS = 1e-6
DEEPNORM_ALPHA = (2 * DEPTH) ** 0.25
DEEPNORM_BETA = (8 * DEPTH) ** -0.25
Q_A = HA * 2 * DA
GATES = 2 * D_MODEL
K_A = HA * 2 * DA
V_A = HA * 2 * DA
Q_COLS = Q_A + Q_LORA + GATES
KV_COLS = K_A + V_A + KV_LORA + ROPE
IN_COLS = Q_COLS + KV_COLS

kernel_name = "hybrid_diffattn_mla_peer_block"


def rms_norm(x, g):
    xf = x.astype(jnp.float32)
    y = xf * lax.rsqrt(jnp.mean(xf * xf, -1, keepdims=True) + EPS)
    return (y * g).astype(x.dtype)


def layer_norm(x, g, b):
    xf = x.astype(jnp.float32)
    mu = jnp.mean(xf, -1, keepdims=True)
    var = jnp.mean(jnp.square(xf - mu), -1, keepdims=True)
    return ((xf - mu) * lax.rsqrt(var + EPS) * g + b).astype(x.dtype)


def axial_rope(n, rot_dim):
    rows = n // GRID_W
    quarter = rot_dim // 4
    inv = ROPE_BASE ** (-jnp.arange(quarter, dtype=jnp.float32) / quarter)
    row_ang = jnp.arange(rows, dtype=jnp.float32)[:, None] * inv
    col_ang = jnp.arange(GRID_W, dtype=jnp.float32)[:, None] * inv
    ang = jnp.concatenate([
        jnp.broadcast_to(row_ang[:, None, :], (rows, GRID_W, quarter)),
        jnp.broadcast_to(col_ang[None, :, :], (rows, GRID_W, quarter))], -1).reshape(n, 2 * quarter)
    return jnp.cos(ang), jnp.sin(ang)


def apply_rope(x, cos, sin):
    half = x.shape[-1] // 2
    cos, sin = cos.astype(x.dtype), sin.astype(x.dtype)
    x1, x2 = x[..., :half], x[..., half:]
    return jnp.concatenate([x1 * cos - x2 * sin, x1 * sin + x2 * cos], -1)


def kv_side(h, w_in, w_kv_up, kv_norm_g, rope):
    B, N, _ = h.shape
    p = h @ w_in[:, Q_COLS:]
    k_a, v_a, kv_lat, k_rope = jnp.split(p, [K_A, K_A + V_A, K_A + V_A + KV_LORA], axis=-1)
    k_a = k_a.reshape(B, N, HA, 2, DA)
    v_a = v_a.reshape(B, N, HA, 2 * DA)
    kv = (rms_norm(kv_lat, kv_norm_g) @ w_kv_up).reshape(B, N, HB, NOPE + VB)
    k_nope, v_b = kv[..., :NOPE], kv[..., NOPE:]
    if rope is not None:
        cos, sin = rope
        k_a = apply_rope(k_a, cos[:, None, None, :], sin[:, None, None, :])
        k_rope = apply_rope(k_rope, cos, sin)
    return (k_a, v_a, k_nope, v_b, k_rope)


def q_side(h, w_in, w_q_up, q_norm_g, rope):
    B, N, _ = h.shape
    p = h @ w_in[:, :Q_COLS]
    q_a, q_lat, gates = jnp.split(p, [Q_A, Q_A + Q_LORA], axis=-1)
    q_a = q_a.reshape(B, N, HA, 2, DA)
    q_b = (rms_norm(q_lat, q_norm_g) @ w_q_up).reshape(B, N, HB, NOPE + ROPE)
    q_nope, q_rope = q_b[..., :NOPE], q_b[..., NOPE:]
    if rope is not None:
        cos, sin = rope
        q_a = apply_rope(q_a, cos[:, None, None, :], sin[:, None, None, :])
        q_rope = apply_rope(q_rope, cos[:, None, :], sin[:, None, :])
    return (q_a, q_nope, q_rope, gates)


def sweep(fn, *qs):
    B, N = qs[0].shape[:2]
    nb = N // Q_BLOCK
    blk = tuple(jnp.moveaxis(q.reshape(B, nb, Q_BLOCK, *q.shape[2:]), 1, 0) for q in qs)
    out = lax.map(lambda a: fn(*a), blk)
    return jnp.moveaxis(out, 0, 1).reshape(B, N, *out.shape[3:])


def diff_attention(q_a, k_a, v_a, lam, subln_g, lambda_init):
    scale = DA ** -0.5

    def block(qb):
        s = jnp.einsum('bqhmd,bkhmd->bhmqk', qb, k_a).astype(jnp.float32) * scale
        p = jax.nn.softmax(s, axis=-1)
        p = p[:, :, 0] - lam * p[:, :, 1]
        return jnp.einsum('bhqk,bkhe->bqhe', p.astype(v_a.dtype), v_a)

    o = sweep(block, q_a)
    return rms_norm(o, subln_g) * (1.0 - lambda_init)


def mla_attention(q_nope, q_rope, k_nope, k_rope, v_b):
    scale = (NOPE + ROPE) ** -0.5

    def block(qn, qr):
        s = (jnp.einsum('bqhd,bkhd->bhqk', qn, k_nope)
             + jnp.einsum('bqhr,bkr->bhqk', qr, k_rope)).astype(jnp.float32) * scale
        p = jax.nn.softmax(s, axis=-1)
        return jnp.einsum('bhqk,bkhe->bqhe', p.astype(v_b.dtype), v_b)

    return sweep(block, q_nope, q_rope)


def token_mixers(q, kv, lam, lambda_init, subln_g, w_pa, w_pb, w_out):
    q_a, q_nope, q_rope, gates = q
    k_a, v_a, k_nope, v_b, k_rope = kv
    B, N = gates.shape[:2]
    y_a = diff_attention(q_a, k_a, v_a, lam, subln_g, lambda_init).reshape(B, N, HA * 2 * DA)
    y_b = mla_attention(q_nope, q_rope, k_nope, k_rope, v_b).reshape(B, N, HB * VB)
    g_a = jax.nn.sigmoid(gates[..., :D_MODEL])
    g_b = jax.nn.sigmoid(gates[..., D_MODEL:])
    z = g_a * (y_a @ w_pa) + g_b * (y_b @ w_pb)
    return z @ w_out


def peer_ffn(h, w_pq, peer_keys, peer_u, peer_v):
    B, N, D = h.shape
    q = (h @ w_pq).reshape(B, N, HP, 2, DK_HALF)
    s = jnp.einsum('bnhmd,hmkd->bnhmk', q, peer_keys).astype(jnp.float32)
    s_top, i_top = lax.top_k(s, TOPK_HALF)
    cand = s_top[..., 0, :, None] + s_top[..., 1, None, :]
    cand_idx = i_top[..., 0, :, None] * N_KEYS + i_top[..., 1, None, :]
    g_s, pos = lax.top_k(cand.reshape(B, N, HP, TOPK_HALF * TOPK_HALF), TOPK)
    idx = jnp.take_along_axis(cand_idx.reshape(B, N, HP, TOPK_HALF * TOPK_HALF), pos, axis=-1)
    g = jax.nn.softmax(g_s, axis=-1)
    T = B * N
    nb = T // TOK_BLOCK
    xt = h.reshape(nb, TOK_BLOCK, D)
    it = idx.reshape(nb, TOK_BLOCK, HP * TOPK)
    gt = g.reshape(nb, TOK_BLOCK, HP * TOPK).astype(h.dtype)

    def block(args):
        xb, ib, gb = args
        u = peer_u[ib]
        v = peer_v[ib]
        a = jnp.einsum('td,tjd->tj', xb, u)
        return jnp.einsum('tj,tjd->td', jax.nn.gelu(a) * gb, v)

    return lax.map(block, (xt, it, gt)).reshape(B, N, D)


def setup_inputs(seed: int = 0) -> dict:
    key = jax.random.key(seed)
    ks = jax.random.split(key, 32)
    L = DEPTH

    def nrm(k, shape, scale):
        return jax.random.normal(k, shape, jnp.float32) * scale

    beta = DEEPNORM_BETA
    return {
        "x": nrm(ks[0], (BATCH, SEQ, D_MODEL), 1.0),
        "c": nrm(ks[1], (BATCH, D_MODEL), 1.0),
        "ctx": nrm(ks[2], (BATCH, CTX_LEN, D_MODEL), 1.0),
        "c_ctx": nrm(ks[3], (D_MODEL,), 1.0),
        "w_mod": nrm(ks[4], (L, D_MODEL, 6 * D_MODEL), 0.5 * D_MODEL ** -0.5),
        "b_mod": nrm(ks[5], (L, 6 * D_MODEL), 0.01),
        "w_in": nrm(ks[6], (L, D_MODEL, IN_COLS), D_MODEL ** -0.5),
        "w_q_up": nrm(ks[7], (L, Q_LORA, HB * (NOPE + ROPE)), Q_LORA ** -0.5),
        "q_norm_g": 1.0 + nrm(ks[8], (L, Q_LORA), 0.02),
        "w_kv_up": nrm(ks[9], (L, KV_LORA, HB * (NOPE + VB)), KV_LORA ** -0.5),
        "kv_norm_g": 1.0 + nrm(ks[10], (L, KV_LORA), 0.02),
        "lambda_q1": nrm(ks[11], (L, DA), 0.1),
        "lambda_k1": nrm(ks[12], (L, DA), 0.1),
        "lambda_q2": nrm(ks[13], (L, DA), 0.1),
        "lambda_k2": nrm(ks[14], (L, DA), 0.1),
        "subln_g": 1.0 + nrm(ks[15], (L, 2 * DA), 0.02),
        "w_pa": nrm(ks[16], (L, HA * 2 * DA, D_MODEL), beta * (HA * 2 * DA) ** -0.5),
        "w_pb": nrm(ks[17], (L, HB * VB, D_MODEL), beta * (HB * VB) ** -0.5),
        "w_out": nrm(ks[18], (L, D_MODEL, D_MODEL), beta * D_MODEL ** -0.5),
        "ln1_g": 1.0 + nrm(ks[19], (L, D_MODEL), 0.02),
        "ln1_b": nrm(ks[20], (L, D_MODEL), 0.01),
        "w_pq": nrm(ks[21], (L, D_MODEL, HP * 2 * DK_HALF), D_MODEL ** -0.5),
        "peer_keys": nrm(ks[22], (L, HP, 2, N_KEYS, DK_HALF), DK_HALF ** -0.5),
        "peer_u": nrm(ks[23], (L, N_EXPERTS, D_MODEL), D_MODEL ** -0.5),
        "peer_v": nrm(ks[24], (L, N_EXPERTS, D_MODEL), beta),
        "ln2_g": 1.0 + nrm(ks[25], (L, D_MODEL), 0.02),
        "ln2_b": nrm(ks[26], (L, D_MODEL), 0.01),
    }


def reference(x, c, ctx, c_ctx, w_mod, b_mod, w_in, w_q_up, q_norm_g, w_kv_up, kv_norm_g,
              lambda_q1, lambda_k1, lambda_q2, lambda_k2, subln_g, w_pa, w_pb, w_out,
              ln1_g, ln1_b, w_pq, peer_keys, peer_u, peer_v, ln2_g, ln2_b):
    rope = axial_rope(x.shape[1], DA)
    alpha = DEEPNORM_ALPHA
    for l in range(DEPTH):
        last = l == DEPTH - 1
        lambda_init = 0.8 - 0.6 * math.exp(-0.3 * l)
        mod = jax.nn.silu(c) @ w_mod[l] + b_mod[l]
        sh1, sc1, gt1, sh2, sc2, gt2 = [m[:, None, :] for m in jnp.split(mod, 6, axis=-1)]
        mod_c = jax.nn.silu(c_ctx) @ w_mod[l] + b_mod[l]
        csh1, csc1, cgt1, csh2, csc2, cgt2 = jnp.split(mod_c, 6, axis=-1)
        lam = (jnp.exp(jnp.sum(lambda_q1[l] * lambda_k1[l]).astype(jnp.float32))
               - jnp.exp(jnp.sum(lambda_q2[l] * lambda_k2[l]).astype(jnp.float32)) + lambda_init)

        h = x * (1.0 + sc1) + sh1
        hc = ctx * (1.0 + csc1) + csh1
        kv_c = kv_side(hc, w_in[l], w_kv_up[l], kv_norm_g[l], None)
        kv_x = kv_side(h, w_in[l], w_kv_up[l], kv_norm_g[l], rope)
        kv_all = tuple(jnp.concatenate([a, b], axis=1) for a, b in zip(kv_c, kv_x))
        q_x = q_side(h, w_in[l], w_q_up[l], q_norm_g[l], rope)
        y = token_mixers(q_x, kv_all, lam, lambda_init, subln_g[l], w_pa[l], w_pb[l], w_out[l])
        x = layer_norm(alpha * x + gt1 * y, ln1_g[l], ln1_b[l])
        if not last:
            q_c = q_side(hc, w_in[l], w_q_up[l], q_norm_g[l], None)
            yc = token_mixers(q_c, kv_c, lam, lambda_init, subln_g[l], w_pa[l], w_pb[l], w_out[l])
            ctx = layer_norm(alpha * ctx + cgt1 * yc, ln1_g[l], ln1_b[l])

        h = x * (1.0 + sc2) + sh2
        x = layer_norm(alpha * x + gt2 * peer_ffn(h, w_pq[l], peer_keys[l], peer_u[l], peer_v[l]),
                       ln2_g[l], ln2_b[l])
        if not last:
            hc = ctx * (1.0 + csc2) + csh2
            ctx = layer_norm(alpha * ctx + cgt2 * peer_ffn(hc, w_pq[l], peer_keys[l], peer_u[l], peer_v[l]),
                             ln2_g[l], ln2_b[l])
    return x
```

```cpp
#include <hip/hip_runtime.h>
#include <hip/hip_cooperative_groups.h>
#include <cstdio>
#include <cstdint>
namespace cg = cooperative_groups;
#ifndef PROBE_DUP
#define PROBE_DUP 0
#endif

typedef unsigned short bf16_t;
typedef short bf16x8 __attribute__((ext_vector_type(8)));
typedef short s16x4 __attribute__((ext_vector_type(4)));
typedef float f32x16 __attribute__((ext_vector_type(16)));
typedef float f32x8 __attribute__((ext_vector_type(8)));
typedef float f32x4 __attribute__((ext_vector_type(4)));
typedef unsigned u32x4 __attribute__((ext_vector_type(4)));
typedef int i32x8 __attribute__((ext_vector_type(8)));
typedef unsigned u32x2 __attribute__((ext_vector_type(2)));

constexpr int DM = 1024, NB = 8, SEQ = 4096, CTXL = 256, T = NB * SEQ, TC = NB * CTXL, NKEY = SEQ + CTXL, TK = NB * NKEY;
constexpr int Q_COLS = 3328, IN_COLS = 5696, IN_PAD = 5888;
constexpr float EPS = 1e-6f;
constexpr float ALPHA = 1.189207115002721f;
constexpr float LAMBDA_INIT = 0.2f;
constexpr int NTHR = 512;
constexpr float W8S = 64.f;
constexpr int LDS_BYTES = 152 * 1024;

constexpr size_t MiB = 1u << 20;
constexpr size_t WS_MODP = (25 + 374 + 80) * MiB;
constexpr size_t OFF_MOD = 0;
constexpr size_t OFF_ROPE = 256 * 1024;
constexpr size_t OFF_LAM = 300 * 1024;
constexpr size_t OFF_BAR = 512 * 1024;
constexpr size_t OFF_SR = 800 * 1024;
constexpr size_t OFF_SU = 600 * 1024, OFF_SV = 700 * 1024;
constexpr size_t OFF_MODP = WS_MODP;
constexpr size_t OFF_WINT = 1 * MiB;
constexpr size_t OFF_WQUPT = 13 * MiB;
constexpr size_t OFF_WKVUPT = 14 * MiB;
constexpr size_t OFF_WPAT = 15 * MiB, OFF_WPBT = 17 * MiB, OFF_WOUTT = 19 * MiB;
constexpr size_t OFF_WEFFT = 21 * MiB;
constexpr size_t WB = 25 * MiB;
constexpr size_t OFF_KA = WB, OFF_VA = WB + 68 * MiB, OFF_KNOPE = WB + 136 * MiB, OFF_VB = WB + 204 * MiB, OFF_KROPE = WB + 272 * MiB;
constexpr size_t OFF_QLAT = WB + 277 * MiB, OFF_KVLAT = WB + 293 * MiB, OFF_QA = WB + 310 * MiB, OFF_QB = WB + 374 * MiB, WS_END = WB + 470 * MiB;
constexpr size_t OFF_HMOD = OFF_QB;
constexpr size_t OFF_VAT = OFF_KA + 34 * MiB;
constexpr size_t OFF_VBT = OFF_KNOPE + 34 * MiB, OFF_YB = OFF_VB;
constexpr size_t OFF_Z8 = OFF_KNOPE;
constexpr size_t OFF_YA = OFF_VA;
constexpr size_t OFF_Z = OFF_KA, OFF_H2 = OFF_VA, OFF_U8 = OFF_KNOPE, OFF_V8 = OFF_KNOPE + 16 * MiB;
constexpr size_t OFF_IDX = OFF_Z, OFF_WGT = OFF_Z + 16 * MiB;

struct Params {
  const float *x, *c, *ctx, *c_ctx, *w_mod, *b_mod, *w_in, *w_q_up, *q_norm_g, *w_kv_up, *kv_norm_g, *lq1, *lk1, *lq2, *lk2, *subln_g, *w_pa, *w_pb, *w_out,
      *ln1_g, *ln1_b, *w_pq, *peer_keys, *peer_u, *peer_v, *ln2_g, *ln2_b;
  float* out; unsigned char* ws;
};

__device__ __forceinline__ unsigned cvtpk(float lo, float hi) { unsigned r; asm volatile("v_cvt_pk_bf16_f32 %0, %1, %2" : "=v"(r) : "v"(lo), "v"(hi)); return r; }
__device__ __forceinline__ bf16_t f2bf(float x) { return (bf16_t)(cvtpk(x, x) & 0xffffu); }
__device__ __forceinline__ float bf2f(bf16_t v) { return __uint_as_float(((unsigned)v) << 16); }
__device__ __forceinline__ int crow(int r, int hi) { return (r & 3) + 8 * (r >> 2) + 4 * hi; }
__device__ __forceinline__ unsigned pk4_fp8(float a, float b, float c, float d) { return (unsigned)__builtin_amdgcn_cvt_pk_fp8_f32(c, d, __builtin_amdgcn_cvt_pk_fp8_f32(a, b, 0, false), true); }
__device__ __forceinline__ bf16x8 pack8(const float* v) { u32x4 w = {cvtpk(v[0], v[1]), cvtpk(v[2], v[3]), cvtpk(v[4], v[5]), cvtpk(v[6], v[7])}; return *reinterpret_cast<bf16x8*>(&w); }
__device__ __forceinline__ float sigmoid_f(float v) { return __builtin_amdgcn_rcpf(1.f + __builtin_amdgcn_exp2f(-1.4426950408889634f * v)); }
__device__ __forceinline__ float silu_f(float v) { return v * sigmoid_f(v); }
template <int CTRL> __device__ __forceinline__ float dppf(float v) { return __uint_as_float((unsigned)__builtin_amdgcn_update_dpp(0, (int)__float_as_uint(v), CTRL, 0xF, 0xF, true)); }
__device__ __forceinline__ float wave_sum(float v) {
  v += dppf<0xB1>(v); v += dppf<0x4E>(v); v += dppf<0x141>(v); v += dppf<0x140>(v);
  { auto r = __builtin_amdgcn_permlane16_swap(__float_as_uint(v), __float_as_uint(v), false, false); v = __uint_as_float(r[0]) + __uint_as_float(r[1]); }
  { auto r = __builtin_amdgcn_permlane32_swap(__float_as_uint(v), __float_as_uint(v), false, false); v = __uint_as_float(r[0]) + __uint_as_float(r[1]); }
  return v;
}
__device__ __forceinline__ float wave_max(float v) {
  v = fmaxf(v, dppf<0xB1>(v)); v = fmaxf(v, dppf<0x4E>(v)); v = fmaxf(v, dppf<0x141>(v)); v = fmaxf(v, dppf<0x140>(v));
  { auto r = __builtin_amdgcn_permlane16_swap(__float_as_uint(v), __float_as_uint(v), false, false); v = fmaxf(__uint_as_float(r[0]), __uint_as_float(r[1])); }
  { auto r = __builtin_amdgcn_permlane32_swap(__float_as_uint(v), __float_as_uint(v), false, false); v = fmaxf(__uint_as_float(r[0]), __uint_as_float(r[1])); }
  return v;
}

__device__ __forceinline__ int opaque_tid() { int t = threadIdx.x; asm volatile("" : "+v"(t)); return t; }


#define XB_TMO      128
#define XB_XCNT(j)  (256  + 64 * (j))
#define XB_XSUB(j)  (1280 + 64 * (j))
#define XB_XGEN(j)  (2304 + 64 * (j))
#define XB_TOP      3328
#define XB_TOPGEN   3392
#define XCD_BAR_WORDS 3456
#define XB_SPIN_CAP (1u << 20)
#define LAS __attribute__((address_space(3)))
__device__ __forceinline__ unsigned xb_ld(unsigned* p)              { return __hip_atomic_load(p, __ATOMIC_RELAXED, __HIP_MEMORY_SCOPE_AGENT); }
__device__ __forceinline__ unsigned xb_add(unsigned* p, unsigned v) { return __hip_atomic_fetch_add(p, v, __ATOMIC_RELAXED, __HIP_MEMORY_SCOPE_AGENT); }
__device__ __forceinline__ unsigned xb_xcc_id() { return (unsigned)__builtin_amdgcn_s_getreg((3 << 11) | 20) & 0xFu; }
#define XB_SPIN(cond, bar) do { unsigned _sp = 0; while (cond) { __builtin_amdgcn_s_sleep(1); \
    if ((++_sp & 255u) == 0u) { if (xb_ld(&(bar)[XB_TMO])) break; if (_sp > XB_SPIN_CAP) { atomicAdd(&(bar)[XB_TMO], 1u); break; } } } } while (0)
struct XcdBarrier { unsigned* bar; unsigned x; volatile LAS unsigned* st; };
__device__ __forceinline__ XcdBarrier xcd_barrier_post(unsigned* bar, volatile LAS unsigned* st) {
    XcdBarrier b; b.bar = bar; b.x = xb_xcc_id(); b.st = st;
    if (threadIdx.x == 0) (void)xb_add(&bar[XB_XCNT(b.x)], 1u);
    return b;
}
__device__ __forceinline__ void xcd_barrier_complete(unsigned* bar, unsigned x, unsigned& nloc, unsigned& nx) {
    const unsigned G = gridDim.x * gridDim.y * gridDim.z;
    unsigned sum, cnt, mine, sp = 0u;
    for (;;) {
        sum = 0u; cnt = 0u; mine = 0u;
#pragma unroll
        for (unsigned j = 0; j < 16; ++j) { const unsigned c = xb_ld(&bar[XB_XCNT(j)]); sum += c; cnt += (c > 0u) ? 1u : 0u; mine = (j == x) ? c : mine; }
        if (sum == G) break;
        __builtin_amdgcn_s_sleep(1);
        if ((++sp & 255u) == 0u) { if (xb_ld(&bar[XB_TMO])) break; if (sp > XB_SPIN_CAP) { atomicAdd(&bar[XB_TMO], 1u); break; } }
    }
    nloc = mine > 0u ? mine : 1u; nx = cnt > 0u ? cnt : 1u;
}
__device__ __forceinline__ void xcd_barrier(const XcdBarrier& b) {
    asm volatile("s_waitcnt vmcnt(0)" ::: "memory");
    __syncthreads();
    if (threadIdx.x == 0) {
        unsigned* bar = b.bar;
        __builtin_amdgcn_s_waitcnt(0);
        unsigned nloc = b.st[0], nx = b.st[1];
        if (nloc == 0u) { xcd_barrier_complete(bar, b.x, nloc, nx); b.st[0] = nloc; b.st[1] = nx; }
        const unsigned old = xb_add(&bar[XB_XSUB(b.x)], 1u);
        const unsigned gen = old / nloc;
        if (old + 1u == (gen + 1u) * nloc) {
            __builtin_amdgcn_fence(__ATOMIC_RELEASE, "agent");
            asm volatile("s_waitcnt vmcnt(0)" ::: "memory");
            const unsigned og = xb_add(&bar[XB_TOP], 1u);
            const unsigned tg = og / nx;
            if (og + 1u == (tg + 1u) * nx) xb_add(&bar[XB_TOPGEN], 1u);
            else XB_SPIN(xb_ld(&bar[XB_TOPGEN]) == tg, bar);
            __builtin_amdgcn_fence(__ATOMIC_ACQUIRE, "agent");
            xb_add(&bar[XB_XGEN(b.x)], 1u);
            asm volatile("s_waitcnt vmcnt(0)" ::: "memory");
        } else {
            XB_SPIN(xb_ld(&bar[XB_XGEN(b.x)]) == gen, bar);
            __builtin_amdgcn_fence(__ATOMIC_ACQUIRE, "agent");
            asm volatile("s_waitcnt vmcnt(0)" ::: "memory");
        }
    }
    __syncthreads();
}

__device__ void p0_mod(const Params& p, char* lds) {
  float* s_l = (float*)lds;
  float* red = (float*)(lds + 9 * 64 * 4);
  const int tid = opaque_tid();
  float* MODP = (float*)(p.ws + OFF_MODP);
  for (int job = blockIdx.x; job < 256; job += gridDim.x) {
    const int kg = job >> 4, cg = job & 15, k0 = kg * 64, c0 = cg * 384;
    for (int i = tid; i < 9 * 64; i += NTHR) { const int r = i >> 6, k = k0 + (i & 63); const float v = r < 8 ? p.c[r * 1024 + k] : p.c_ctx[k]; s_l[i] = silu_f(v); }
    __syncthreads();
    const int cq = tid % 96, kr = tid / 96;
    if (kr < 5) {
      f32x4 w[13];
#pragma unroll
      for (int i = 0; i < 13; ++i) { const int kk = kr + 5 * i; w[i] = kk < 64 ? *(const f32x4*)(p.w_mod + (size_t)(k0 + kk) * 6144 + c0 + cq * 4) : (f32x4){0.f, 0.f, 0.f, 0.f}; }
      f32x4 acc[9];
#pragma unroll
      for (int r = 0; r < 9; ++r) acc[r] = (f32x4){0.f, 0.f, 0.f, 0.f};
#pragma unroll
      for (int i = 0; i < 13; ++i) { const int kk = kr + 5 * i; if (kk < 64) {
#pragma unroll
        for (int r = 0; r < 9; ++r) acc[r] += w[i] * s_l[r * 64 + kk]; } }
#pragma unroll
      for (int r = 0; r < 9; ++r) *(f32x4*)(red + ((kr * 96 + cq) * 9 + r) * 4) = acc[r];
    }
    __syncthreads();
    for (int i = tid; i < 96 * 9; i += NTHR) { const int cq2 = i / 9, r = i % 9; f32x4 s = {0.f, 0.f, 0.f, 0.f};
#pragma unroll
      for (int q = 0; q < 5; ++q) s += *(const f32x4*)(red + ((q * 96 + cq2) * 9 + r) * 4);
      *(f32x4*)(MODP + ((size_t)kg * 9 + r) * 6144 + c0 + cq2 * 4) = s; }
    __syncthreads();
  }
}
__device__ void p0_mod_reduce(const Params& p) {
  const float* MODP = (const float*)(p.ws + OFF_MODP); float* mod = (float*)(p.ws + OFF_MOD);
  for (int i = blockIdx.x * NTHR + threadIdx.x; i < 9 * 6144 / 4; i += gridDim.x * NTHR) {
    f32x4 s = *(const f32x4*)(p.b_mod + (i % 1536) * 4);
#pragma unroll
    for (int kg = 0; kg < 16; ++kg) s += *(const f32x4*)(MODP + (size_t)kg * 9 * 6144 + (size_t)i * 4);
    *(f32x4*)(mod + (size_t)i * 4) = s; }
}
__device__ void p0_transpose(const float* __restrict__ src, int K, int N, int Npad, bf16_t* __restrict__ dst, const float* __restrict__ gk, char* lds, int job0, int& jobctr, float f8scale = 0.f) {
  float* tile = (float*)lds;
  const int tid = opaque_tid(), nkt = K / 64, nnt = Npad / 64, ntile = nkt * nnt;
  const int Gd = (int)gridDim.x, first = (((int)blockIdx.x - job0) % Gd + Gd) % Gd;
  for (int tI = first; tI < ntile; tI += Gd) {
    const int kt = tI % nkt, nt = tI / nkt;
    { const int kk = tid >> 3, nc = (tid & 7) * 8; const int n0 = nt * 64 + nc; const float* sp = src + (size_t)(kt * 64 + kk) * N + n0;
      float v[8];
      if (n0 + 8 <= N) { const f32x4 a = *(const f32x4*)sp, b = *(const f32x4*)(sp + 4); v[0] = a[0]; v[1] = a[1]; v[2] = a[2]; v[3] = a[3]; v[4] = b[0]; v[5] = b[1]; v[6] = b[2]; v[7] = b[3]; }
      else { for (int j = 0; j < 8; ++j) v[j] = (n0 + j < N) ? sp[j] : 0.f; }
      const float g = gk ? gk[kt * 64 + kk] : 1.f;
      for (int j = 0; j < 8; ++j) tile[kk * 65 + nc + j] = v[j] * g; }
    __syncthreads();
    { const int n = tid >> 3, kc = (tid & 7) * 8; float v[8];
      for (int j = 0; j < 8; ++j) v[j] = tile[(kc + j) * 65 + n];
      if (f8scale != 0.f) { u32x2 w = {pk4_fp8(v[0] * f8scale, v[1] * f8scale, v[2] * f8scale, v[3] * f8scale), pk4_fp8(v[4] * f8scale, v[5] * f8scale, v[6] * f8scale, v[7] * f8scale)};
        *(u32x2*)((unsigned char*)dst + (size_t)(nt * 64 + n) * K + kt * 64 + kc) = w; }
      else *(bf16x8*)(dst + (size_t)(nt * 64 + n) * K + kt * 64 + kc) = pack8(v); }
    __syncthreads();
  }
  jobctr = job0 + ntile;
}
__device__ void p0_weff(const Params& p, char* lds) {
  float* ks = (float*)lds;
  float* wq = (float*)(lds + 128 * 129 * 4);
  bf16_t* dst = (bf16_t*)(p.ws + OFF_WEFFT);
  const int tid = opaque_tid();
  for (int job = blockIdx.x; job < 256; job += gridDim.x) {
    const int g = job >> 4, kc = job & 15;
#pragma unroll
    for (int it = 0; it < 8; ++it) { const int i = (it * NTHR + tid) * 4, key = i >> 7, d = i & 127; const f32x4 v = *(const f32x4*)(p.peer_keys + (size_t)g * 16384 + i);
      ks[key * 129 + d] = v[0]; ks[key * 129 + d + 1] = v[1]; ks[key * 129 + d + 2] = v[2]; ks[key * 129 + d + 3] = v[3]; }
#pragma unroll
    for (int it = 0; it < 4; ++it) { const int i = (it * NTHR + tid) * 4, kk = i >> 7, d = i & 127; *(f32x4*)(wq + i) = *(const f32x4*)(p.w_pq + (size_t)(kc * 64 + kk) * 2048 + g * 128 + d); }
    __syncthreads();
    const int key0 = tid & 63, ksub = tid >> 6; float a0[8], a1[8];
#pragma unroll
    for (int j = 0; j < 8; ++j) { a0[j] = 0.f; a1[j] = 0.f; }
    for (int d = 0; d < 128; ++d) { const float k0v = ks[key0 * 129 + d], k1v = ks[(key0 + 64) * 129 + d];
#pragma unroll
      for (int j = 0; j < 8; ++j) { const float wv = wq[(ksub * 8 + j) * 128 + d]; a0[j] = fmaf(k0v, wv, a0[j]); a1[j] = fmaf(k1v, wv, a1[j]); } }
    *(bf16x8*)(dst + (size_t)(g * 128 + key0) * 1024 + kc * 64 + ksub * 8) = pack8(a0);
    *(bf16x8*)(dst + (size_t)(g * 128 + key0 + 64) * 1024 + kc * 64 + ksub * 8) = pack8(a1);
    __syncthreads();
  }
}
__device__ void p0_misc(const Params& p) {
  if (blockIdx.x == 0) {
    float* rope = (float*)(p.ws + OFF_ROPE);
    for (int i = threadIdx.x; i < 1024; i += NTHR) { const int pos = i >> 4, q = i & 15; const float inv = powf(10000.f, -(float)q / 16.f); const float ang = (float)pos * inv; rope[i * 2] = cosf(ang); rope[i * 2 + 1] = sinf(ang); }
    if (threadIdx.x < 64) { const int l = threadIdx.x; float a = wave_sum(p.lq1[l] * p.lk1[l]), b = wave_sum(p.lq2[l] * p.lk2[l]);
      if (l == 0) *(float*)(p.ws + OFF_LAM) = expf(a) - expf(b) + LAMBDA_INIT; }
  }
}
__device__ void p0b_hmod(const Params& p) {
  const float* mod = (const float*)(p.ws + OFF_MOD); unsigned char* h = p.ws + OFF_HMOD;
  const size_t nchunk = (size_t)(T + TC) * 128;
  for (size_t i = (size_t)blockIdx.x * NTHR + threadIdx.x; i < nchunk; i += (size_t)gridDim.x * NTHR) {
    const int row = (int)(i >> 7), k = (int)(i & 127) * 8; const float* src; int mr;
    if (row < T) { src = p.x + (size_t)row * 1024 + k; mr = row >> 12; } else { src = p.ctx + (size_t)(row - T) * 1024 + k; mr = 8; }
    const f32x8 xv = *(const f32x8*)src, sh = *(const f32x8*)(mod + mr * 6144 + k), sc = *(const f32x8*)(mod + mr * 6144 + 1024 + k);
    float v[8];
#pragma unroll
    for (int j = 0; j < 8; ++j) v[j] = fmaf(xv[j], 1.f + sc[j], sh[j]);
    u32x2 w = {pk4_fp8(v[0], v[1], v[2], v[3]), pk4_fp8(v[4], v[5], v[6], v[7])};
    *(u32x2*)(h + (size_t)row * 1024 + k) = w;
  }
}

template <int BN> struct GT2 { static constexpr int MI = BN == 256 ? 4 : 2, A_B = 32768, B_B = BN * 128, STAGE = A_B + B_B, LDS = 2 * STAGE; };
template <int BN, int GM = 0, bool SUMSQ = false, class AL, class BL>
__device__ __forceinline__ void gemm_tile2(f32x16 (&acc)[GT2<BN>::MI][2], const AL& al, const BL& bl, int nk, char* lds, float* ssq = nullptr) {
  constexpr int MI = GT2<BN>::MI, STAGE = GT2<BN>::STAGE, A_B = GT2<BN>::A_B, NBI = BN / 64;
  const int tid = opaque_tid(), wid = __builtin_amdgcn_readfirstlane(tid >> 6), lane = tid & 63, r32 = lane & 31, hi = lane >> 5;
  const int wm = BN == 256 ? wid >> 2 : wid >> 1, wn = BN == 256 ? wid & 3 : wid & 1;
  const int srow = 8 * wid + (lane >> 3), sch = (lane & 7) ^ ((srow >> 1) & 7);
  const int swz = ((hi ^ ((r32 >> 1) & 7)) << 4);
  const int aoff = (wm * (MI * 32) + r32) * 128, boff = A_B + (wn * 64 + r32) * 128;
#pragma unroll
  for (int i = 0; i < MI; ++i)
#pragma unroll
    for (int j = 0; j < 2; ++j) acc[i][j] = f32x16{};
  auto stage1 = [&](int s, int kt, int n) {
    char* S = lds + s * STAGE + wid * 1024;
    if (n < 4) __builtin_amdgcn_global_load_lds((const unsigned*)al(srow + 64 * n, kt, sch), (unsigned*)(S + n * 8192), 16, 0, 0);
    else if (n - 4 < NBI) __builtin_amdgcn_global_load_lds((const unsigned*)bl(srow + 64 * (n - 4), kt, sch), (unsigned*)(S + A_B + (n - 4) * 8192), 16, 0, 0);
  };
  auto ldfr = [&](const char* S, int ks, bf16x8 (&fa)[MI], bf16x8 (&fb)[2]) {
    const int co = swz ^ (ks << 5);
#pragma unroll
    for (int i = 0; i < MI; ++i) fa[i] = *(const bf16x8*)(S + aoff + i * 4096 + co);
    fb[0] = *(const bf16x8*)(S + boff + co); fb[1] = *(const bf16x8*)(S + boff + 4096 + co);
  };
#define SB_() __builtin_amdgcn_sched_barrier(0)
  auto mm = [&](const bf16x8 (&fa)[MI], const bf16x8 (&fb)[2], bool pf, int s, int kt, int n0) {
    acc[0][0] = __builtin_amdgcn_mfma_f32_32x32x16_bf16(fa[0], fb[0], acc[0][0], 0, 0, 0);
    acc[0][1] = __builtin_amdgcn_mfma_f32_32x32x16_bf16(fa[0], fb[1], acc[0][1], 0, 0, 0);
    SB_(); if (GM != 1 && pf) stage1(s, kt, n0); SB_();
    acc[1][0] = __builtin_amdgcn_mfma_f32_32x32x16_bf16(fa[1], fb[0], acc[1][0], 0, 0, 0);
    acc[1][1] = __builtin_amdgcn_mfma_f32_32x32x16_bf16(fa[1], fb[1], acc[1][1], 0, 0, 0);
    SB_(); if (GM != 1 && pf) stage1(s, kt, n0 + 1); SB_();
#pragma unroll
    for (int i = 2; i < MI; ++i) {
      acc[i][0] = __builtin_amdgcn_mfma_f32_32x32x16_bf16(fa[i], fb[0], acc[i][0], 0, 0, 0);
      acc[i][1] = __builtin_amdgcn_mfma_f32_32x32x16_bf16(fa[i], fb[1], acc[i][1], 0, 0, 0);
    }
  };
  if (GM != 1) {
#pragma unroll
    for (int n = 0; n < 8; ++n) stage1(0, 0, n); }
  asm volatile("s_waitcnt vmcnt(0)" ::: "memory"); __syncthreads();
  for (int kt = 0; kt < nk; ++kt) {
    const char* S = lds + (kt & 1) * STAGE; const int ns = (kt + 1) & 1; const bool pf = kt + 1 < nk;
    if (GM == 2) { if (pf) {
#pragma unroll
      for (int n = 0; n < 8; ++n) stage1(ns, kt + 1, n); } asm volatile("s_waitcnt vmcnt(0)" ::: "memory"); __syncthreads(); continue; }
    bf16x8 a0[MI], b0[2], a1[MI], b1[2];
    ldfr(S, 0, a0, b0);
    if (SUMSQ) {
      const char* rp_ = S + (tid >> 1) * 128 + (tid & 1) * 64; float s_ = *ssq;
#pragma unroll
      for (int q = 0; q < 4; ++q) { const bf16x8 v_ = *(const bf16x8*)(rp_ + q * 16);
#pragma unroll
        for (int k = 0; k < 8; ++k) { const float f_ = bf2f((bf16_t)v_[k]); s_ = fmaf(f_, f_, s_); } }
      *ssq = s_; }
    ldfr(S, 1, a1, b1); SB_(); mm(a0, b0, pf, ns, kt + 1, 0);
    ldfr(S, 2, a0, b0); SB_(); mm(a1, b1, pf, ns, kt + 1, 2);
    ldfr(S, 3, a1, b1); SB_(); mm(a0, b0, pf, ns, kt + 1, 4);
    SB_(); mm(a1, b1, pf, ns, kt + 1, 6);
    asm volatile("s_waitcnt vmcnt(0)" ::: "memory"); __syncthreads();
  }
#undef SB_
}
template <int GM = 0, class AL, class BL>
__device__ __forceinline__ void gemm_tile8(f32x16 (&acc)[4][2], const AL& al, const BL& bl, int nk, char* lds) {
  constexpr int MI = 4, STAGE = GT2<256>::STAGE, A_B = GT2<256>::A_B;
  const int tid = opaque_tid(), wid = __builtin_amdgcn_readfirstlane(tid >> 6), lane = tid & 63, r32 = lane & 31, hi = lane >> 5;
  const int wm = wid >> 2, wn = wid & 3;
  const int srow = 8 * wid + (lane >> 3), sch = (lane & 7) ^ ((srow >> 1) & 7);
  const int sw = (r32 >> 1) & 7;
  const int aoff = (wm * (MI * 32) + r32) * 128, boff = A_B + (wn * 64 + r32) * 128;
#pragma unroll
  for (int i = 0; i < MI; ++i)
#pragma unroll
    for (int j = 0; j < 2; ++j) acc[i][j] = f32x16{};
  auto stage1 = [&](int s, int kt, int n) {
    char* S = lds + s * STAGE + wid * 1024;
    if (n < 4) __builtin_amdgcn_global_load_lds((const unsigned*)al(srow + 64 * n, kt, sch), (unsigned*)(S + n * 8192), 16, 0, 0);
    else __builtin_amdgcn_global_load_lds((const unsigned*)bl(srow + 64 * (n - 4), kt, sch), (unsigned*)(S + A_B + (n - 4) * 8192), 16, 0, 0);
  };
  auto rd32 = [&](const char* rowp, int ks) { const int c0 = ((4 * ks + 2 * hi) ^ sw) << 4, c1 = ((4 * ks + 2 * hi + 1) ^ sw) << 4;
    const u32x4 lo_ = *(const u32x4*)(rowp + c0), hi_ = *(const u32x4*)(rowp + c1);
    return (i32x8){(int)lo_[0], (int)lo_[1], (int)lo_[2], (int)lo_[3], (int)hi_[0], (int)hi_[1], (int)hi_[2], (int)hi_[3]}; };
#define SB_() __builtin_amdgcn_sched_barrier(0)
#define MF8(A_, B_, C_) C_ = __builtin_amdgcn_mfma_scale_f32_32x32x64_f8f6f4(A_, B_, C_, 0, 0, 0, 0x7f7f7f7f, 0, 0x7f7f7f7f)
  if (GM != 1) {
#pragma unroll
    for (int n = 0; n < 8; ++n) stage1(0, 0, n); }
  asm volatile("s_waitcnt vmcnt(0)" ::: "memory"); __syncthreads();
  for (int kt = 0; kt < nk; ++kt) {
    const char* S = lds + (kt & 1) * STAGE; const int ns = (kt + 1) & 1; const bool pf = kt + 1 < nk;
    i32x8 fa[MI], fb0[2], fb1[2];
#pragma unroll
    for (int i = 0; i < MI; ++i) fa[i] = rd32(S + aoff + i * 4096, 0);
    fb0[0] = rd32(S + boff, 0); fb0[1] = rd32(S + boff + 4096, 0); fb1[0] = rd32(S + boff, 1); fb1[1] = rd32(S + boff + 4096, 1);
    SB_();
#pragma unroll
    for (int i = 0; i < MI; ++i) { MF8(fa[i], fb0[0], acc[i][0]); MF8(fa[i], fb0[1], acc[i][1]); SB_(); fa[i] = rd32(S + aoff + i * 4096, 1); if (GM != 1 && pf) stage1(ns, kt + 1, i); SB_(); }
#pragma unroll
    for (int i = 0; i < MI; ++i) { MF8(fa[i], fb1[0], acc[i][0]); MF8(fa[i], fb1[1], acc[i][1]); SB_(); if (GM != 1 && pf) stage1(ns, kt + 1, 4 + i); SB_(); }
    asm volatile("s_waitcnt vmcnt(0)" ::: "memory"); __syncthreads();
  }
#undef MF8
#undef SB_
}
struct HeadLoader8 {
  const unsigned char* base;
  __device__ __forceinline__ const unsigned char* operator()(int r, int kt, int c) const { return base + ((size_t)kt * 4096 + r) * 128 + c * 16; }
};
struct RowLoader8 {
  const unsigned char* base; int ld;
  __device__ __forceinline__ const unsigned char* operator()(int r, int kt, int c) const { return base + (size_t)r * ld + kt * 128 + c * 16; }
};
struct RowLoader {
  const bf16_t* base; int ld;
  __device__ __forceinline__ const bf16_t* operator()(int r, int kt, int c) const { return base + (size_t)r * ld + kt * 64 + c * 8; }
};
struct HeadLoader {
  const bf16_t* base; int rs;
  __device__ __forceinline__ const bf16_t* operator()(int r, int kt, int c) const { return base + ((size_t)(kt >> 1) * 4096 + r) * rs + (kt & 1) * 64 + c * 8; }
};

__device__ __forceinline__ float dpp_xor1(float v) { return __uint_as_float((unsigned)__builtin_amdgcn_update_dpp(0, (int)__float_as_uint(v), 0xB1, 0xF, 0xF, true)); }
template <int MI, class G>
__device__ __forceinline__ void tile_stage(char* wl, int lane, G get) {
  asm volatile("" : "+v"(lane));
  const int c = lane & 31, hh = lane >> 5; const bool odd = (c & 1) != 0;
  char* lp = wl + ((odd ? 1 : 0) + 4 * hh) * 128 + ((c >> 3) << 4) + ((c & 6) << 1);
  const int oj0 = odd ? 64 : 0, oj1 = 64 - oj0;
#pragma unroll
  for (int i = 0; i < MI; ++i)
#pragma unroll
    for (int rq = 0; rq < 4; ++rq)
#pragma unroll
      for (int kp = 0; kp < 2; ++kp) {
        const int r = rq * 4 + 2 * kp, rowc = i * 32 + 8 * rq + 2 * kp;
        asm volatile("" ::: "memory");
        float a1, a2, b1, b2; get(i, r, a1, a2); get(i, r + 1, b1, b2);
        { const float t = dpp_xor1(odd ? a1 : b1); *(unsigned*)(lp + rowc * 128 + oj0) = cvtpk(odd ? t : a1, odd ? b1 : t); }
        { const float t = dpp_xor1(odd ? a2 : b2); *(unsigned*)(lp + rowc * 128 + oj1) = cvtpk(odd ? t : a2, odd ? b2 : t); }
      }
  asm volatile("s_waitcnt lgkmcnt(0)" ::: "memory");
}
__device__ __forceinline__ const char* tile_rd_ptr(const char* wl, int lane) { asm volatile("" : "+v"(lane)); return wl + (lane >> 3) * 128 + (((lane & 7) ^ (((lane >> 3) & 1) << 2)) << 4); }
template <int MI, int LD, bool DOST = true>
__device__ __forceinline__ void tile_store_bf16(const char* wl, int lane, bf16_t* dst) {
  if (!DOST) return;
  asm volatile("" : "+v"(lane));
  const char* rp = tile_rd_ptr(wl, lane); bf16_t* d = dst + (size_t)(lane >> 3) * LD + (lane & 7) * 8;
#pragma unroll
  for (int it = 0; it < 4 * MI; ++it) *(bf16x8*)(d + (size_t)it * 8 * LD) = *(const bf16x8*)(rp + it * 1024);
}

template <int MI, int LD, bool DOST = true>
__device__ __forceinline__ void tile_store_fp8(const char* wl, int lane, unsigned char* dst) {
  if (!DOST) return;
  asm volatile("" : "+v"(lane));
  const char* rp = tile_rd_ptr(wl, lane); unsigned char* d = dst + (size_t)(lane >> 3) * LD + (lane & 7) * 8;
#pragma unroll
  for (int it = 0; it < 4 * MI; ++it) { const u32x4 w = *(const u32x4*)(rp + it * 1024); u32x2 o;
    o[0] = pk4_fp8(__uint_as_float(w[0] << 16), __uint_as_float(w[0] & 0xffff0000u), __uint_as_float(w[1] << 16), __uint_as_float(w[1] & 0xffff0000u));
    o[1] = pk4_fp8(__uint_as_float(w[2] << 16), __uint_as_float(w[2] & 0xffff0000u), __uint_as_float(w[3] << 16), __uint_as_float(w[3] & 0xffff0000u));
    *(u32x2*)(d + (size_t)it * 8 * LD) = o; }
}
template <int GM_ = 0>
__device__ void g1_phase(const Params& p, char* lds) {
  const unsigned char* hmod = p.ws + OFF_HMOD; const unsigned char* wt = p.ws + OFF_WINT; const float* rope = (const float*)(p.ws + OFF_ROPE);
  unsigned char* QA = p.ws + OFF_QA; unsigned char* KA = p.ws + OFF_KA; unsigned char* VAT = p.ws + OFF_VAT; unsigned char* KR = p.ws + OFF_KROPE;
  bf16_t* QL = (bf16_t*)(p.ws + OFF_QLAT); bf16_t* KVL = (bf16_t*)(p.ws + OFF_KVLAT); unsigned char* GT = (unsigned char*)p.out;
  const int tid = opaque_tid(), wid = __builtin_amdgcn_readfirstlane(tid >> 6), lane = tid & 63, r32 = lane & 31, hi = lane >> 5, wm = wid >> 2, wn = wid & 3;
  const int G = gridDim.x, nx = (G % 8 == 0) ? 8 : 1, xg = blockIdx.x % nx, lb = blockIdx.x / nx, nlb = G / nx;
  float* ropel = (float*)(lds + GT2<256>::LDS + 1024);
  for (int i = tid; i < 2048; i += NTHR) ropel[i] = rope[i];
  __syncthreads();
  const int nlat = 128 / nx, nctx = 8 / nx, njobs = nlat * 23 + nctx * 10;
  for (int j = lb; j < njobs; j += nlb) {
    int mt, nt;
    if (j < nlat * 23) { mt = xg + nx * (j / 23); nt = j % 23; } else { const int jj = j - nlat * 23; mt = 128 + xg + nx * (jj / 10); nt = 13 + jj % 10; }
    const bool isctx = mt >= 128;
    const int b = isctx ? mt - 128 : mt >> 4, pos0 = isctx ? 0 : (mt & 15) * 256;
    f32x16 acc[4][2];
    RowLoader8 al{hmod + (size_t)mt * 256 * 1024, 1024}, bl{wt + (size_t)nt * 256 * 1024, 1024};
    gemm_tile8(acc, al, bl, 8, lds);
#pragma unroll
    for (int i = 0; i < 4; ++i)
#pragma unroll
      for (int jn = 0; jn < 2; ++jn) acc[i][jn] *= (1.f / W8S);
    if (GM_ == 1) { asm volatile("" :: "v"(acc[0][0]), "v"(acc[0][1]), "v"(acc[1][0]), "v"(acc[1][1])); asm volatile("" :: "v"(acc[2][0]), "v"(acc[2][1]), "v"(acc[3][0]), "v"(acc[3][1])); __syncthreads(); continue; }
    const int col0 = nt * 256 + wn * 64;
    const int rw0 = wm * 128;
    const int keyb = isctx ? 0 : 256 + pos0;
    char* wl = lds + wid * 16384;
    int ln = lane; asm volatile("" : "+v"(ln));
    const int r32e = ln & 31, hie = ln >> 5; const bool lo = r32e < 16;
    const float* rp = ropel + (lo ? (((pos0 + rw0) >> 6) << 5) : 4 * hie * 32) + (r32e & 15) * 2;
    const int sA = lo ? 32 : 0, sB = lo ? 0 : 32;
    auto plain = [&](int i, int r, float& x1, float& x2) { x1 = acc[i][0][r]; x2 = acc[i][1][r]; };
    auto sigm = [&](int i, int r, float& x1, float& x2) { x1 = sigmoid_f(acc[i][0][r]); x2 = sigmoid_f(acc[i][1][r]); };
    auto rot = [&](int i, int r, float& x1, float& x2) {
      const int rr = i * 32 + (r & 3) + 8 * (r >> 2); const float* e = rp + (rr >> 6) * sA + (rr & 63) * sB; const float cs = e[0], sn = e[1];
      const float a = acc[i][0][r], bq = acc[i][1][r]; x1 = a * cs - bq * sn; x2 = a * sn + bq * cs; };
    if (col0 < 1024) {
      const int h = col0 >> 7, mp = (col0 >> 6) & 1;
      constexpr float QS = 0.125f * 1.4426950408889634f;
      auto rotq = [&](int i, int r, float& x1, float& x2) { float a, bq; rot(i, r, a, bq); x1 = a * QS; x2 = bq * QS; };
      tile_stage<4>(wl, lane, rotq); tile_store_fp8<4, 128, GM_ != 2>(wl, lane, QA + ((size_t)(b * 8 + h) * 4096 + pos0 + rw0) * 128 + mp * 64);
    } else if (col0 < 1280) {
      tile_stage<4>(wl, lane, plain); tile_store_bf16<4, 256, GM_ != 2>(wl, lane, QL + (size_t)(mt * 256 + rw0) * 256 + (col0 - 1024));
    } else if (col0 < 3328) {
      tile_stage<4>(wl, lane, sigm); tile_store_fp8<4, 2048, GM_ != 2>(wl, lane, GT + (size_t)(mt * 256 + rw0) * 2048 + (col0 - 1280));
    } else if (col0 < 4352) {
      const int cc = col0 - 3328, h = cc >> 7, mp = (cc >> 6) & 1;
      if (isctx) tile_stage<4>(wl, lane, plain); else tile_stage<4>(wl, lane, rot);
      tile_store_fp8<4, 128, GM_ != 2>(wl, lane, KA + ((size_t)(b * 8 + h) * NKEY + keyb + rw0) * 128 + mp * 64);
    } else if (col0 < 5376) {
      const int cc = col0 - 4352;
      if (GM_ != 2) {
        unsigned char* vb_ = VAT + ((size_t)(b * 8 + (cc >> 7)) * 128 + (cc & 127) + r32e) * NKEY + (keyb + rw0) + 32 * hie;
#pragma unroll
        for (int jn = 0; jn < 2; ++jn)
#pragma unroll
          for (int t2 = 0; t2 < 2; ++t2) { u32x4 w0_, w1_;
#pragma unroll
            for (int q = 0; q < 4; ++q) { w0_[q] = pk4_fp8(acc[2 * t2][jn][4 * q], acc[2 * t2][jn][4 * q + 1], acc[2 * t2][jn][4 * q + 2], acc[2 * t2][jn][4 * q + 3]);
              w1_[q] = pk4_fp8(acc[2 * t2 + 1][jn][4 * q], acc[2 * t2 + 1][jn][4 * q + 1], acc[2 * t2 + 1][jn][4 * q + 2], acc[2 * t2 + 1][jn][4 * q + 3]); }
            unsigned char* d_ = vb_ + (size_t)(32 * jn) * NKEY + 64 * t2; *(u32x4*)d_ = w0_; *(u32x4*)(d_ + 16) = w1_; }
      }
    } else if (col0 < 5632) {
      tile_stage<4>(wl, lane, plain); tile_store_bf16<4, 256, GM_ != 2>(wl, lane, KVL + ((size_t)b * NKEY + keyb + rw0) * 256 + (col0 - 5376));
    } else if (col0 < IN_COLS) {
      if (isctx) tile_stage<4>(wl, lane, plain); else tile_stage<4>(wl, lane, rot);
      tile_store_fp8<4, 64, GM_ != 2>(wl, lane, KR + ((size_t)b * NKEY + keyb + rw0) * 64);
    }
    __syncthreads();
  }
}

__device__ void g2_phase(const Params& p, char* lds) {
  const bf16_t* QL = (const bf16_t*)(p.ws + OFF_QLAT); const bf16_t* KVL = (const bf16_t*)(p.ws + OFF_KVLAT);
  const bf16_t* WQ = (const bf16_t*)(p.ws + OFF_WQUPT); const bf16_t* WKV = (const bf16_t*)(p.ws + OFF_WKVUPT); const float* rope = (const float*)(p.ws + OFF_ROPE);
  unsigned char* QB = p.ws + OFF_QB; unsigned char* KN = p.ws + OFF_KNOPE; unsigned char* VBT = p.ws + OFF_VBT;
  float* rstd_l = (float*)(lds + GT2<256>::LDS);
  float* ropel = (float*)(lds + GT2<256>::LDS + 1024);
  const int tid = opaque_tid(), wid = __builtin_amdgcn_readfirstlane(tid >> 6), lane = tid & 63, r32 = lane & 31, hi = lane >> 5, wm = wid >> 2, wn = wid & 3;
  const int G = gridDim.x, nx = (G % 8 == 0) ? 8 : 1, xg = blockIdx.x % nx, lb = blockIdx.x / nx, nlb = G / nx;
  const int na = (128 / nx) * 6, nb = (136 / nx) * 8;
  for (int i = opaque_tid(); i < 2048; i += NTHR) ropel[i] = rope[i];
  __syncthreads();
  for (int j = lb; j < na + nb; j += nlb) {
    const bool isq = j < na; int mt, nt;
    if (isq) { mt = xg + nx * (j / 6); nt = j % 6; } else { const int jj = j - na; mt = xg + nx * (jj >> 3); nt = jj & 7; }
    const bf16_t* Ab = (isq ? QL : KVL) + (size_t)mt * 256 * 256;
    f32x16 acc[4][2]; float ssq = 0.f;
    RowLoader al{Ab, 256}, bl{(isq ? WQ : WKV) + (size_t)nt * 256 * 256, 256};
    gemm_tile2<256, 0, true>(acc, al, bl, 4, lds, &ssq);
    ssq += __shfl_xor(ssq, 1); if ((tid & 1) == 0) rstd_l[tid >> 1] = rsqrtf(ssq * (1.f / 256.f) + EPS);
    __syncthreads();
    const int rw0 = wm * 128;
    int ln = lane; asm volatile("" : "+v"(ln));
    const int r32e = ln & 31, hie = ln >> 5; const bool lo = r32e < 16;
    const float* rsp = rstd_l + rw0 + 4 * hie;
    char* wl = lds + wid * 16384;
    auto scaled = [&](int i, int r, float& x1, float& x2) { const float s = rsp[i * 32 + (r & 3) + 8 * (r >> 2)]; x1 = acc[i][0][r] * s; x2 = acc[i][1][r] * s; };
    if (isq) {
      const int b = mt >> 4, pos0 = (mt & 15) * 256, gidx = nt * 4 + wn, h = gidx / 3, part = gidx % 3;
      const float* rp = ropel + (lo ? (((pos0 + rw0) >> 6) << 5) : 4 * hie * 32) + (r32e & 15) * 2;
      const int sA = lo ? 32 : 0, sB = lo ? 0 : 32;
      auto rot = [&](int i, int r, float& x1, float& x2) {
        const int rr = i * 32 + (r & 3) + 8 * (r >> 2); const float* e = rp + (rr >> 6) * sA + (rr & 63) * sB; const float cs = e[0], sn = e[1], s = rsp[rr];
        const float a = acc[i][0][r] * s, bq = acc[i][1][r] * s; x1 = a * cs - bq * sn; x2 = a * sn + bq * cs; };
      if (part == 2) tile_stage<4>(wl, lane, rot); else tile_stage<4>(wl, lane, scaled);
      tile_store_fp8<4, 192>(wl, lane, QB + ((size_t)(b * 8 + h) * 4096 + pos0 + rw0) * 192 + part * 64);
    } else {
      const int b = mt / 17, key0 = (mt % 17) * 256, col0 = nt * 256 + wn * 64, h = col0 >> 8, part = (col0 >> 7) & 1;
      if (part == 0) { tile_stage<4>(wl, lane, scaled); tile_store_fp8<4, 128>(wl, lane, KN + ((size_t)(b * 8 + h) * NKEY + key0 + rw0) * 128 + (col0 & 127)); }
      else {
        unsigned char* vb_ = VBT + ((size_t)(b * 8 + h) * 128 + (col0 & 127) + r32e) * NKEY + (key0 + rw0) + 32 * hie;
#pragma unroll
        for (int jn = 0; jn < 2; ++jn)
#pragma unroll
          for (int t2 = 0; t2 < 2; ++t2) { u32x4 w0_, w1_;
#pragma unroll
            for (int q = 0; q < 4; ++q) { float e_[8];
#pragma unroll
              for (int k = 0; k < 4; ++k) { const int r = 4 * q + k, rr = (r & 3) + 8 * (r >> 2); e_[k] = acc[2 * t2][jn][r] * rsp[(2 * t2) * 32 + rr]; e_[4 + k] = acc[2 * t2 + 1][jn][r] * rsp[(2 * t2 + 1) * 32 + rr]; }
              w0_[q] = pk4_fp8(e_[0], e_[1], e_[2], e_[3]); w1_[q] = pk4_fp8(e_[4], e_[5], e_[6], e_[7]); }
            unsigned char* d_ = vb_ + (size_t)(32 * jn) * NKEY + 64 * t2; *(u32x4*)d_ = w0_; *(u32x4*)(d_ + 16) = w1_; }
      }
    }
    __syncthreads();
  }
}

#define SBAR() __builtin_amdgcn_sched_barrier(0)
constexpr int A_SHV = 64 * 128 * 2;
constexpr float ATT_THR = 5.5f;
template <int SCALE_ID> struct AttScale;
template <> struct AttScale<0> { static constexpr float v = 0.125f; };
template <> struct AttScale<1> { static constexpr float v = 0.07216878364870322f; };
template <int SID>
__device__ __forceinline__ void partialSM(f32x16& p0, f32x16& p1, float& m_reg, float& mn, float& alpha) {
  constexpr float SC = AttScale<SID>::v; constexpr float C = SC * 1.4426950408889634f;
  float pmax = p0[0];
#pragma unroll
  for (int r = 1; r < 16; ++r) pmax = fmaxf(pmax, p0[r]);
#pragma unroll
  for (int r = 0; r < 16; ++r) pmax = fmaxf(pmax, p1[r]);
  { auto rr = __builtin_amdgcn_permlane32_swap(__float_as_uint(pmax), __float_as_uint(pmax), false, false);
    pmax = fmaxf(__uint_as_float(rr[0]), __uint_as_float(rr[1])); }
  if (__builtin_expect(__all(pmax - m_reg <= ATT_THR / SC), 1)) { mn = m_reg; alpha = 1.f; }
  else { mn = fmaxf(m_reg, pmax); alpha = __builtin_amdgcn_exp2f((m_reg - mn) * C); m_reg = mn; }
  const float mnC = -mn * C;
#pragma unroll
  for (int r = 0; r < 16; ++r) p0[r] = fmaf(p0[r], C, mnC);
#pragma unroll
  for (int r = 0; r < 16; ++r) p1[r] = fmaf(p1[r], C, mnC);
#pragma unroll
  for (int r = 0; r < 16; ++r) p0[r] = __builtin_amdgcn_exp2f(p0[r]);
}
template <bool FIRST>
__device__ __forceinline__ void partialSM_c(f32x16& p0, f32x16& p1, float& M, f32x16& cinit, float& alpha) {
  constexpr float THRL = ATT_THR * 1.4426950408889634f;
  float pmax = p0[0];
#pragma unroll
  for (int r = 1; r < 16; ++r) pmax = fmaxf(pmax, p0[r]);
#pragma unroll
  for (int r = 0; r < 16; ++r) pmax = fmaxf(pmax, p1[r]);
  { auto rr = __builtin_amdgcn_permlane32_swap(__float_as_uint(pmax), __float_as_uint(pmax), false, false);
    pmax = fmaxf(__uint_as_float(rr[0]), __uint_as_float(rr[1])); }
  if (!FIRST && __builtin_expect(__all(pmax <= THRL), 1)) { alpha = 1.f; }
  else { const float d = FIRST ? pmax : fmaxf(pmax, 0.f); alpha = FIRST ? 1.f : __builtin_amdgcn_exp2f(-d); M += d;
#pragma unroll
    for (int r = 0; r < 16; ++r) { p0[r] -= d; p1[r] -= d; }
#pragma unroll
    for (int r = 0; r < 16; ++r) cinit[r] = -M; }
#pragma unroll
  for (int r = 0; r < 16; ++r) p0[r] = __builtin_amdgcn_exp2f(p0[r]);
}
__device__ __forceinline__ void finishSM(f32x16& p0, f32x16& p1, float alpha, float& l_reg, bf16x8& pa0, bf16x8& pa1, bf16x8& pa2, bf16x8& pa3) {
#pragma unroll
  for (int r = 0; r < 16; ++r) p1[r] = __builtin_amdgcn_exp2f(p1[r]);
  float ps = 0;
#pragma unroll
  for (int r = 0; r < 16; ++r) ps += p0[r];
#pragma unroll
  for (int r = 0; r < 16; ++r) ps += p1[r];
  { auto rr = __builtin_amdgcn_permlane32_swap(__float_as_uint(ps), __float_as_uint(ps), false, false);
    ps = __uint_as_float(rr[0]) + __uint_as_float(rr[1]); }
  l_reg = l_reg * alpha + ps;
#define PK4(P, BASE, OUT) do { unsigned a0 = cvtpk(P[BASE + 0], P[BASE + 1]), a1 = cvtpk(P[BASE + 2], P[BASE + 3]);   \
    unsigned b0 = cvtpk(P[BASE + 4], P[BASE + 5]), b1 = cvtpk(P[BASE + 6], P[BASE + 7]);                              \
    auto r0 = __builtin_amdgcn_permlane32_swap(a0, b0, false, false); auto r1 = __builtin_amdgcn_permlane32_swap(a1, b1, false, false); \
    u32x4 w = {r0[0], r1[0], r0[1], r1[1]}; OUT = *reinterpret_cast<bf16x8*>(&w); } while (0)
  PK4(p0, 0, pa0); PK4(p0, 8, pa1); PK4(p1, 0, pa2); PK4(p1, 8, pa3);
#undef PK4
}
__device__ __forceinline__ int v_st(int k, int c) { const int kk = (k & ~0xC) | ((k & 4) << 1) | ((k & 8) >> 1); return ((kk >> 3) * 4 + (c >> 5)) * 512 + ((kk & 7) * 32 + (c & 31)) * 2; }
__device__ __forceinline__ int v_rd_base(int lane) { return ((lane & 3) << 3) | (((lane >> 2) & 3) << 6) | (((lane >> 4) & 1) << 5) | (((lane >> 5) & 1) << 8); }
constexpr int v_rd_off(int d0, int ks, int half) { return d0 * 512 + ks * 4096 + half * 2048; }
template <int OFF> __device__ __forceinline__ s16x4 tr_read(int vb) {
  s16x4 r; asm volatile("ds_read_b64_tr_b16 %0, %1 offset:%2" : "=&v"(r) : "v"(vb), "i"(OFF) : "memory"); return r;
}
template <int D0> __device__ __forceinline__ void pv_one(f32x16& od, int vb, bf16x8 pa0, bf16x8 pa1, bf16x8 pa2, bf16x8 pa3) {
  const s16x4 l0 = tr_read<v_rd_off(D0, 0, 0)>(vb), h0 = tr_read<v_rd_off(D0, 0, 1)>(vb), l1 = tr_read<v_rd_off(D0, 1, 0)>(vb), h1 = tr_read<v_rd_off(D0, 1, 1)>(vb);
  const s16x4 l2 = tr_read<v_rd_off(D0, 2, 0)>(vb), h2 = tr_read<v_rd_off(D0, 2, 1)>(vb), l3 = tr_read<v_rd_off(D0, 3, 0)>(vb), h3 = tr_read<v_rd_off(D0, 3, 1)>(vb);
  asm volatile("s_waitcnt lgkmcnt(0)" ::: "memory"); SBAR();
#define PK(L, H) (bf16x8){L[0], L[1], L[2], L[3], H[0], H[1], H[2], H[3]}
  od = __builtin_amdgcn_mfma_f32_32x32x16_bf16(pa0, PK(l0, h0), od, 0, 0, 0);
  od = __builtin_amdgcn_mfma_f32_32x32x16_bf16(pa1, PK(l1, h1), od, 0, 0, 0);
  od = __builtin_amdgcn_mfma_f32_32x32x16_bf16(pa2, PK(l2, h2), od, 0, 0, 0);
  od = __builtin_amdgcn_mfma_f32_32x32x16_bf16(pa3, PK(l3, h3), od, 0, 0, 0);
#undef PK
}
__device__ __forceinline__ void pv_d0(f32x16* o, int vb, bf16x8 pa0, bf16x8 pa1, bf16x8 pa2, bf16x8 pa3) {
  pv_one<0>(o[0], vb, pa0, pa1, pa2, pa3); pv_one<1>(o[1], vb, pa0, pa1, pa2, pa3); pv_one<2>(o[2], vb, pa0, pa1, pa2, pa3); pv_one<3>(o[3], vb, pa0, pa1, pa2, pa3);
}
template <bool MLA, bool STORE = true, int GH = 0>
__device__ __forceinline__ void attn_job(bf16_t* Qb, const bf16_t* __restrict__ Kh, const bf16_t* __restrict__ Kr, const bf16_t* __restrict__ Vh, float lam, const float* __restrict__ subln, char* lds) {
  constexpr int NQ = MLA ? 12 : 4, KROW = MLA ? 384 : 256, SHK = 64 * KROW, LDQ = MLA ? 192 : 128, SID = MLA ? 1 : 0;
  constexpr int NQR = MLA ? 8 : 4;
  constexpr int L_V = 0, L_K = 3 * A_SHV, L_W = L_K + 2 * SHK, L_Q = L_W + 2048;
  const int tid = opaque_tid(), wid = tid >> 6, lane = tid & 63, r32 = lane & 31, hi = lane >> 5;
  const int mp = MLA ? 0 : (wid >> 2), wrow = MLA ? wid * 32 : (wid & 3) * 32;
  char* V_lds = lds + L_V; char* K_lds = lds + L_K;
  float* wsf = (float*)(lds + L_W) + wid * 64; float* li_l = wsf; float* al_l = wsf + 32;
  char* qsp = lds + L_Q + wid * 4096 + lane * 16;
  float m_reg = MLA ? -1e30f : 0.f, l_reg = 0; f32x16 o[4] = {}; bf16x8 qr[NQR];
  f32x16 cinit = {};
  { const bf16_t* Qw = Qb + (size_t)(wrow + r32) * LDQ + mp * 64 + hi * 8;
#pragma unroll
    for (int d0 = 0; d0 < NQR; ++d0) qr[d0] = *(const bf16x8*)(Qw + d0 * 16);
    if (MLA) {
#pragma unroll
      for (int d0 = NQR; d0 < 12; ++d0) *(bf16x8*)(qsp + (d0 - NQR) * 1024) = *(const bf16x8*)(Qw + d0 * 16); } }
  const bf16_t* vsrc[2]; const bf16_t* ksrc[MLA ? 3 : 2]; bool kr_[MLA ? 3 : 2];
#pragma unroll
  for (int i = 0; i < 2; ++i) { const int sub = 2 * (wid * 2 + i) + (lane >> 5), kk = (sub >> 2) * 8 + ((lane & 31) >> 2), k = (kk & ~0xC) | ((kk & 4) << 1) | ((kk & 8) >> 1);
    vsrc[i] = Vh + (size_t)k * 128 + (sub & 3) * 32 + (lane & 3) * 8; }
#pragma unroll
  for (int i = 0; i < (MLA ? 3 : 2); ++i) { const int off = (wid * (MLA ? 3 : 2) + i) * 1024 + lane * 16, row = off / KROW, ch = ((off % KROW) >> 4) ^ (row & 7);
    if (MLA && ch >= 16) { ksrc[i] = Kr + (size_t)row * 64 + (ch - 16) * 8; kr_[i] = true; } else { ksrc[i] = Kh + (size_t)row * 128 + ch * 8; kr_[i] = false; } }
  auto issue = [&](int tile, int kb, int vbuf) {
    if (GH & 8) return;
#pragma unroll
    for (int i = 0; i < 2; ++i) __builtin_amdgcn_global_load_lds((const unsigned*)(vsrc[i] + (size_t)tile * 64 * 128), (unsigned*)(V_lds + vbuf * A_SHV + (wid * 2 + i) * 1024), 16, 0, 0);
#pragma unroll
    for (int i = 0; i < (MLA ? 3 : 2); ++i) __builtin_amdgcn_global_load_lds((const unsigned*)(ksrc[i] + (size_t)tile * 64 * (kr_[i] ? 64 : 128)), (unsigned*)(K_lds + kb * SHK + (wid * (MLA ? 3 : 2) + i) * 1024), 16, 0, 0);
  };
  const int vb0 = (int)(uintptr_t)V_lds + v_rd_base(lane);
  const int kq0 = r32 * KROW, kxor = (r32 & 7) << 4;
#define TBAR() do { asm volatile("s_waitcnt vmcnt(0)" ::: "memory"); __syncthreads(); } while (0)
#define RESC(a) do { if (__any((a) < 1.f)) { if (hi == 0) al_l[r32] = (a); asm volatile("s_waitcnt lgkmcnt(0)" ::: "memory"); \
    _Pragma("unroll") for (int d = 0; d < 4; ++d) _Pragma("unroll") for (int r = 0; r < 16; ++r) o[d][r] *= al_l[crow(r, hi)]; } } while (0)
#define QKT(P0, P1, bb) do { P0 = f32x16{}; P1 = f32x16{}; if (GH & 4) { asm volatile("" : "+v"(P0), "+v"(P1)); break; } const char* Ks = K_lds + (bb) * SHK;                                                     \
    _Pragma("unroll") for (int d0 = 0; d0 < NQ; ++d0) { const int cb = ((mp * 64 + d0 * 16 + hi * 8) * 2) ^ kxor;                                       \
      const bf16x8 b0 = *(const bf16x8*)(Ks + kq0 + cb), b1 = *(const bf16x8*)(Ks + kq0 + 32 * KROW + cb);                                          \
      const bf16x8 qv = d0 < NQR ? qr[d0 < NQR ? d0 : 0] : *(const bf16x8*)(qsp + (d0 - NQR) * 1024);                                                  \
      P0 = __builtin_amdgcn_mfma_f32_32x32x16_bf16(b0, qv, (!MLA && d0 == 0) ? cinit : P0, 0, 0, 0); P1 = __builtin_amdgcn_mfma_f32_32x32x16_bf16(b1, qv, (!MLA && d0 == 0) ? cinit : P1, 0, 0, 0); } } while (0)
#define PSM(p0_, p1_, m_, mn_, al_) do { if (GH & 1) { mn_ = m_; al_ = 1.f; } else if (MLA) partialSM<SID>(p0_, p1_, m_, mn_, al_); else partialSM_c<false>(p0_, p1_, m_, cinit, al_); } while (0)
#define PSM1(p0_, p1_, m_, mn_, al_) do { if (GH & 1) { mn_ = m_; al_ = 1.f; } else if (MLA) partialSM<SID>(p0_, p1_, m_, mn_, al_); else partialSM_c<true>(p0_, p1_, m_, cinit, al_); } while (0)
#define FSM(p0_, p1_, al_, l_, a0_, a1_, a2_, a3_) do { if (GH & 1) { u32x4 w0_ = {__float_as_uint(p0_[0]), __float_as_uint(p0_[5]), __float_as_uint(p0_[10]), __float_as_uint(p0_[15])}, w1_ = {__float_as_uint(p1_[0]), __float_as_uint(p1_[5]), __float_as_uint(p1_[10]), __float_as_uint(p1_[15])}; \
    a0_ = *reinterpret_cast<bf16x8*>(&w0_); a1_ = *reinterpret_cast<bf16x8*>(&w1_); a2_ = a0_; a3_ = a1_; l_ += al_; } else finishSM(p0_, p1_, al_, l_, a0_, a1_, a2_, a3_); } while (0)
#define PVD(o_, vb_, a0_, a1_, a2_, a3_) do { if (GH & 2) { asm volatile("" :: "v"(a0_), "v"(a1_), "v"(a2_), "v"(a3_)); } else pv_d0(o_, vb_, a0_, a1_, a2_, a3_); } while (0)
  f32x16 pA0, pA1, pB0, pB1; float mnA, mnB, alA, alB; bf16x8 pa0, pa1, pa2, pa3; constexpr int NT = NKEY / 64;
  if (__builtin_amdgcn_readfirstlane(wid) >= 4) __builtin_amdgcn_s_setprio(1);
  issue(0, 0, 0); TBAR(); issue(1, 1, 1);
  QKT(pA0, pA1, 0); PSM1(pA0, pA1, m_reg, mnA, alA);
  int vcur = 0, vnext = 2;
  for (int j = 1; j + 1 < NT; j += 2) {
    TBAR(); issue(j + 1, 0, vnext);
    SBAR(); QKT(pB0, pB1, 1);
    FSM(pA0, pA1, alA, l_reg, pa0, pa1, pa2, pa3); SBAR();
    PVD(o, vb0 + vcur * A_SHV, pa0, pa1, pa2, pa3); PSM(pB0, pB1, m_reg, mnB, alB);
    RESC(alB);
    vcur = vcur == 2 ? 0 : vcur + 1; vnext = vnext == 2 ? 0 : vnext + 1;
    TBAR(); if (j + 2 < NT) issue(j + 2, 1, vnext);
    SBAR(); QKT(pA0, pA1, 0);
    FSM(pB0, pB1, alB, l_reg, pa0, pa1, pa2, pa3); SBAR();
    PVD(o, vb0 + vcur * A_SHV, pa0, pa1, pa2, pa3); PSM(pA0, pA1, m_reg, mnA, alA);
    RESC(alA);
    vcur = vcur == 2 ? 0 : vcur + 1; vnext = vnext == 2 ? 0 : vnext + 1;
  }
  TBAR();
  SBAR(); QKT(pB0, pB1, 1);
  FSM(pA0, pA1, alA, l_reg, pa0, pa1, pa2, pa3); SBAR();
  PVD(o, vb0 + vcur * A_SHV, pa0, pa1, pa2, pa3); PSM(pB0, pB1, m_reg, mnB, alB);
  RESC(alB);
  vcur = vcur == 2 ? 0 : vcur + 1;
  FSM(pB0, pB1, alB, l_reg, pa0, pa1, pa2, pa3); SBAR();
  PVD(o, vb0 + vcur * A_SHV, pa0, pa1, pa2, pa3);
  __builtin_amdgcn_s_setprio(0);
  if (hi == 0) li_l[r32] = l_reg; asm volatile("s_waitcnt lgkmcnt(0)" ::: "memory");
  float rli[16];
#pragma unroll
  for (int r = 0; r < 16; ++r) rli[r] = __builtin_amdgcn_rcpf(li_l[crow(r, hi)]);
  bf16_t* Ow = Qb + (size_t)(wrow + 4 * hi) * LDQ + r32;
  if (MLA) {
#pragma unroll
    for (int r = 0; r < 16; ++r) { const int rr = (r & 3) + 8 * (r >> 2);
#pragma unroll
      for (int d0 = 0; d0 < 4; ++d0) { const bf16_t v = f2bf(o[d0][r] * rli[r]); if (STORE) Ow[rr * LDQ + d0 * 32] = v; else asm volatile("" :: "v"(v)); } }
    __syncthreads();
  } else {
    __syncthreads();
    float* X = (float*)lds + (size_t)((wid & 3) * 32 + 4 * hi) * 128 + r32;
    if (mp == 1) {
#pragma unroll
      for (int r = 0; r < 16; ++r) { const int rr = (r & 3) + 8 * (r >> 2);
#pragma unroll
        for (int d0 = 0; d0 < 4; ++d0) X[rr * 128 + d0 * 32] = lam * o[d0][r] * rli[r]; }
    }
    __syncthreads();
    if (mp == 0) {
      float g[4];
#pragma unroll
      for (int d0 = 0; d0 < 4; ++d0) g[d0] = subln[d0 * 32 + r32] * (1.f - LAMBDA_INIT);
#pragma unroll
      for (int r = 0; r < 16; ++r) { const int rr = (r & 3) + 8 * (r >> 2); float od[4]; float s = 0.f;
#pragma unroll
        for (int d0 = 0; d0 < 4; ++d0) { od[d0] = o[d0][r] * rli[r] - X[rr * 128 + d0 * 32]; s = fmaf(od[d0], od[d0], s); }
        s += __shfl_xor(s, 1); s += __shfl_xor(s, 2); s += __shfl_xor(s, 4); s += __shfl_xor(s, 8); s += __shfl_xor(s, 16);
        const float rs = rsqrtf(s * (1.f / 128.f) + EPS);
#pragma unroll
        for (int d0 = 0; d0 < 4; ++d0) { const bf16_t v = f2bf(od[d0] * rs * g[d0]); if (STORE) Ow[rr * LDQ + d0 * 32] = v; else asm volatile("" :: "v"(v)); } }
    }
    __syncthreads();
  }
#undef TBAR
#undef RESC
#undef QKT
#undef PSM
#undef PSM1
#undef FSM
#undef PVD
}
template <bool STORE = true>
__device__ __forceinline__ void attn_diff8(const unsigned char* __restrict__ Q8, const unsigned char* __restrict__ K8, const unsigned char* __restrict__ VT, unsigned char* __restrict__ Y, float lam, const float* __restrict__ subln, char* lds) {
  constexpr int SHK8 = 64 * 128, SHV8 = 128 * 64, L_V = 0, L_K = 3 * SHV8, L_W = L_K + 2 * SHK8;
  const int tid = opaque_tid(), wid = tid >> 6, lane = tid & 63, r32 = lane & 31, hi = lane >> 5;
  const int mp = wid >> 2, wrow = (wid & 3) * 32;
  char* V_lds = lds + L_V; char* K_lds = lds + L_K;
  float* wsf = (float*)(lds + L_W) + wid * 64; float* al_l = wsf + 32;
  float m_reg = 0.f; f32x16 o[4] = {}, ol = {}; f32x16 cinit = {};
  const i32x8 ones = {0x38383838, 0x38383838, 0x38383838, 0x38383838, 0x38383838, 0x38383838, 0x38383838, 0x38383838};
  i32x8 qf;
  { const unsigned char* qp = Q8 + (size_t)(wrow + r32) * 128 + mp * 64 + hi * 32; const u32x4 a = *(const u32x4*)qp, b = *(const u32x4*)(qp + 16);
    qf = (i32x8){(int)a[0], (int)a[1], (int)a[2], (int)a[3], (int)b[0], (int)b[1], (int)b[2], (int)b[3]}; }
  const unsigned char* ksrc; const unsigned char* vsrc;
  { const int row = wid * 8 + (lane >> 3), c = (lane & 7) ^ ((row >> 1) & 7); ksrc = K8 + (size_t)row * 128 + c * 16; }
  { const int d = wid * 16 + (lane >> 2), c = (lane & 3) ^ ((d >> 2) & 3); vsrc = VT + (size_t)d * NKEY + c * 16; }
  auto issue = [&](int tile, int kb, int vbuf) {
    __builtin_amdgcn_global_load_lds((const unsigned*)(vsrc + (size_t)tile * 64), (unsigned*)(V_lds + vbuf * SHV8 + wid * 1024), 16, 0, 0);
    __builtin_amdgcn_global_load_lds((const unsigned*)(ksrc + (size_t)tile * 64 * 128), (unsigned*)(K_lds + kb * SHK8 + wid * 1024), 16, 0, 0);
  };
  const int kro = r32 * 128, kc0 = ((mp * 4 + 2 * hi) ^ ((r32 >> 1) & 7)) << 4, kc1 = ((mp * 4 + 2 * hi + 1) ^ ((r32 >> 1) & 7)) << 4;
  const int vro = r32 * 64, vc0 = ((2 * hi) ^ ((r32 >> 2) & 3)) << 4, vc1 = ((2 * hi + 1) ^ ((r32 >> 2) & 3)) << 4;
#define TBAR() do { asm volatile("s_waitcnt vmcnt(0)" ::: "memory"); __syncthreads(); } while (0)
#define RESC(a) do { if (__any((a) < 1.f)) { if (hi == 0) al_l[r32] = (a); asm volatile("s_waitcnt lgkmcnt(0)" ::: "memory"); \
    _Pragma("unroll") for (int d = 0; d < 4; ++d) _Pragma("unroll") for (int r = 0; r < 16; ++r) o[d][r] *= al_l[crow(r, hi)]; _Pragma("unroll") for (int r = 0; r < 16; ++r) ol[r] *= al_l[crow(r, hi)]; } } while (0)
#define MF8(A_, B_, C_) __builtin_amdgcn_mfma_scale_f32_32x32x64_f8f6f4(A_, B_, C_, 0, 0, 0, 0x7f7f7f7f, 0, 0x7f7f7f7f)
#define RD32(P0_, P1_) ({ const u32x4 a_ = *(const u32x4*)(P0_), b_ = *(const u32x4*)(P1_); (i32x8){(int)a_[0], (int)a_[1], (int)a_[2], (int)a_[3], (int)b_[0], (int)b_[1], (int)b_[2], (int)b_[3]}; })
#define QKT(P0, P1, bb) do { const char* Ks = K_lds + (bb) * SHK8 + kro; const i32x8 k0_ = RD32(Ks + kc0, Ks + kc1), k1_ = RD32(Ks + 32 * 128 + kc0, Ks + 32 * 128 + kc1); \
    P0 = MF8(k0_, qf, cinit); P1 = MF8(k1_, qf, cinit); } while (0)
#define FSM8(p0_, p1_, al_, pf_) do {                                                                                                                          \
    _Pragma("unroll") for (int r = 0; r < 16; ++r) p1_[r] = __builtin_amdgcn_exp2f(p1_[r]);                                                                      \
    _Pragma("unroll") for (int q = 0; q < 4; ++q) { pf_[q] = (int)pk4_fp8(p0_[4 * q], p0_[4 * q + 1], p0_[4 * q + 2], p0_[4 * q + 3]); pf_[4 + q] = (int)pk4_fp8(p1_[4 * q], p1_[4 * q + 1], p1_[4 * q + 2], p1_[4 * q + 3]); } } while (0)
#define PV8(vb_, pf_) do { const char* Vs = V_lds + (vb_) * SHV8 + vro;                                                                                          \
    _Pragma("unroll") for (int d0 = 0; d0 < 4; ++d0) { const i32x8 v_ = RD32(Vs + d0 * 2048 + vc0, Vs + d0 * 2048 + vc1); o[d0] = MF8(pf_, v_, o[d0]); } ol = MF8(pf_, ones, ol); } while (0)
  f32x16 pA0, pA1, pB0, pB1; float alA, alB; i32x8 pf; constexpr int NT = NKEY / 64;
  if (__builtin_amdgcn_readfirstlane(wid) >= 4) __builtin_amdgcn_s_setprio(1);
  issue(0, 0, 0); TBAR(); issue(1, 1, 1);
  QKT(pA0, pA1, 0); partialSM_c<true>(pA0, pA1, m_reg, cinit, alA);
  int vcur = 0, vnext = 2;
  for (int j = 1; j + 1 < NT; j += 2) {
    TBAR(); issue(j + 1, 0, vnext);
    SBAR(); QKT(pB0, pB1, 1);
    FSM8(pA0, pA1, alA, pf); SBAR();
    PV8(vcur, pf); partialSM_c<false>(pB0, pB1, m_reg, cinit, alB);
    RESC(alB);
    vcur = vcur == 2 ? 0 : vcur + 1; vnext = vnext == 2 ? 0 : vnext + 1;
    TBAR(); if (j + 2 < NT) issue(j + 2, 1, vnext);
    SBAR(); QKT(pA0, pA1, 0);
    FSM8(pB0, pB1, alB, pf); SBAR();
    PV8(vcur, pf); partialSM_c<false>(pA0, pA1, m_reg, cinit, alA);
    RESC(alA);
    vcur = vcur == 2 ? 0 : vcur + 1; vnext = vnext == 2 ? 0 : vnext + 1;
  }
  TBAR();
  SBAR(); QKT(pB0, pB1, 1);
  FSM8(pA0, pA1, alA, pf); SBAR();
  PV8(vcur, pf); partialSM_c<false>(pB0, pB1, m_reg, cinit, alB);
  RESC(alB);
  vcur = vcur == 2 ? 0 : vcur + 1;
  FSM8(pB0, pB1, alB, pf); SBAR();
  PV8(vcur, pf);
  __builtin_amdgcn_s_setprio(0);
#undef TBAR
#undef RESC
#undef MF8
#undef RD32
#undef QKT
#undef FSM8
#undef PV8
  float rli[16];
#pragma unroll
  for (int r = 0; r < 16; ++r) rli[r] = __builtin_amdgcn_rcpf(ol[r]);
  unsigned char* Ow = Y + (size_t)(wrow + 4 * hi) * 128 + r32;
  __syncthreads();
  float* X = (float*)lds + (size_t)((wid & 3) * 32 + 4 * hi) * 128 + r32;
  if (mp == 1) {
#pragma unroll
    for (int r = 0; r < 16; ++r) { const int rr = (r & 3) + 8 * (r >> 2);
#pragma unroll
      for (int d0 = 0; d0 < 4; ++d0) X[rr * 128 + d0 * 32] = lam * o[d0][r] * rli[r]; }
  }
  __syncthreads();
  if (mp == 0) {
    float g[4];
#pragma unroll
    for (int d0 = 0; d0 < 4; ++d0) g[d0] = subln[d0 * 32 + r32] * (1.f - LAMBDA_INIT);
#pragma unroll
    for (int r = 0; r < 16; ++r) { const int rr = (r & 3) + 8 * (r >> 2); float od[4]; float s_ = 0.f;
#pragma unroll
      for (int d0 = 0; d0 < 4; ++d0) { od[d0] = o[d0][r] * rli[r] - X[rr * 128 + d0 * 32]; s_ = fmaf(od[d0], od[d0], s_); }
      s_ += __shfl_xor(s_, 1); s_ += __shfl_xor(s_, 2); s_ += __shfl_xor(s_, 4); s_ += __shfl_xor(s_, 8); s_ += __shfl_xor(s_, 16);
      const float rs = rsqrtf(s_ * (1.f / 128.f) + EPS);
#pragma unroll
      for (int d0 = 0; d0 < 4; ++d0) { const float vf_ = od[d0] * rs * g[d0]; const unsigned char v = (unsigned char)pk4_fp8(vf_, vf_, vf_, vf_); if (STORE) Ow[rr * 128 + d0 * 32] = v; else asm volatile("" :: "v"(v)); } }
  }
  __syncthreads();
}
template <bool STORE = true>
__device__ __forceinline__ void attn_mla8(const unsigned char* __restrict__ Q8, const unsigned char* __restrict__ KN, const unsigned char* __restrict__ KR, const unsigned char* __restrict__ VT, unsigned char* __restrict__ Y, char* lds) {
  constexpr int SHK8 = 64 * 128, SHR8 = 64 * 64, SHV8 = 128 * 64, L_V = 0, L_K = 3 * SHV8, L_R = L_K + 2 * SHK8, L_W = L_R + 2 * SHR8;
  const int tid = opaque_tid(), wid = tid >> 6, lane = tid & 63, r32 = lane & 31, hi = lane >> 5;
  const int wrow = wid * 32;
  char* V_lds = lds + L_V; char* K_lds = lds + L_K; char* R_lds = lds + L_R;
  float* wsf = (float*)(lds + L_W) + wid * 64; float* al_l = wsf + 32;
  float m_reg = -1e30f; f32x16 o[4] = {}, ol = {};
  const i32x8 ones = {0x38383838, 0x38383838, 0x38383838, 0x38383838, 0x38383838, 0x38383838, 0x38383838, 0x38383838};
#define RD32(P0_, P1_) ({ const u32x4 a_ = *(const u32x4*)(P0_), b_ = *(const u32x4*)(P1_); (i32x8){(int)a_[0], (int)a_[1], (int)a_[2], (int)a_[3], (int)b_[0], (int)b_[1], (int)b_[2], (int)b_[3]}; })
  i32x8 qf[3];
  { const unsigned char* qp = Q8 + (size_t)(wrow + r32) * 192 + hi * 32;
#pragma unroll
    for (int s3 = 0; s3 < 3; ++s3) qf[s3] = RD32(qp + s3 * 64, qp + s3 * 64 + 16); }
  const unsigned char* ksrc; const unsigned char* rsrc; const unsigned char* vsrc;
  { const int row = wid * 8 + (lane >> 3), c = (lane & 7) ^ ((row >> 1) & 7); ksrc = KN + (size_t)row * 128 + c * 16; }
  { const int row = (wid & 3) * 16 + (lane >> 2), c = (lane & 3) ^ ((row >> 2) & 3); rsrc = KR + (size_t)row * 64 + c * 16; }
  { const int d = wid * 16 + (lane >> 2), c = (lane & 3) ^ ((d >> 2) & 3); vsrc = VT + (size_t)d * NKEY + c * 16; }
  const bool rw_ = __builtin_amdgcn_readfirstlane(wid) < 4;
  auto issue = [&](int tile, int kb, int vbuf) {
    __builtin_amdgcn_global_load_lds((const unsigned*)(vsrc + (size_t)tile * 64), (unsigned*)(V_lds + vbuf * SHV8 + wid * 1024), 16, 0, 0);
    __builtin_amdgcn_global_load_lds((const unsigned*)(ksrc + (size_t)tile * 64 * 128), (unsigned*)(K_lds + kb * SHK8 + wid * 1024), 16, 0, 0);
    if (rw_) __builtin_amdgcn_global_load_lds((const unsigned*)(rsrc + (size_t)tile * 64 * 64), (unsigned*)(R_lds + kb * SHR8 + (wid & 3) * 1024), 16, 0, 0);
  };
  const int kro = r32 * 128, ksw = (r32 >> 1) & 7;
  const int vro = r32 * 64, vc0 = ((2 * hi) ^ ((r32 >> 2) & 3)) << 4, vc1 = ((2 * hi + 1) ^ ((r32 >> 2) & 3)) << 4;
#define TBAR() do { asm volatile("s_waitcnt vmcnt(0)" ::: "memory"); __syncthreads(); } while (0)
#define RESC(a) do { if (__any((a) < 1.f)) { if (hi == 0) al_l[r32] = (a); asm volatile("s_waitcnt lgkmcnt(0)" ::: "memory"); \
    _Pragma("unroll") for (int d = 0; d < 4; ++d) _Pragma("unroll") for (int r = 0; r < 16; ++r) o[d][r] *= al_l[crow(r, hi)]; _Pragma("unroll") for (int r = 0; r < 16; ++r) ol[r] *= al_l[crow(r, hi)]; } } while (0)
#define MF8(A_, B_, C_) __builtin_amdgcn_mfma_scale_f32_32x32x64_f8f6f4(A_, B_, C_, 0, 0, 0, 0x7f7f7f7f, 0, 0x7f7f7f7f)
#define QKB(P, Ks, Rs) do { P = f32x16{};                                                                                                                       \
    _Pragma("unroll") for (int s3 = 0; s3 < 2; ++s3) { const i32x8 k_ = RD32((Ks) + (((4 * s3 + 2 * hi) ^ ksw) << 4), (Ks) + (((4 * s3 + 2 * hi + 1) ^ ksw) << 4)); P = MF8(k_, qf[s3], P); } \
    { const i32x8 k_ = RD32((Rs) + vc0, (Rs) + vc1); P = MF8(k_, qf[2], P); } } while (0)
#define QKT(P0, P1, bb) do { const char* Ks = K_lds + (bb) * SHK8 + kro; const char* Rs = R_lds + (bb) * SHR8 + vro; QKB(P0, Ks, Rs); QKB(P1, Ks + 32 * 128, Rs + 32 * 64); } while (0)
#define FSM8(p0_, p1_, al_, pf_) do {                                                                                                                          \
    _Pragma("unroll") for (int r = 0; r < 16; ++r) p1_[r] = __builtin_amdgcn_exp2f(p1_[r]);                                                                      \
    _Pragma("unroll") for (int q = 0; q < 4; ++q) { pf_[q] = (int)pk4_fp8(p0_[4 * q], p0_[4 * q + 1], p0_[4 * q + 2], p0_[4 * q + 3]); pf_[4 + q] = (int)pk4_fp8(p1_[4 * q], p1_[4 * q + 1], p1_[4 * q + 2], p1_[4 * q + 3]); } } while (0)
#define PV8(vb_, pf_) do { const char* Vs = V_lds + (vb_) * SHV8 + vro;                                                                                          \
    _Pragma("unroll") for (int d0 = 0; d0 < 4; ++d0) { const i32x8 v_ = RD32(Vs + d0 * 2048 + vc0, Vs + d0 * 2048 + vc1); o[d0] = MF8(pf_, v_, o[d0]); } ol = MF8(pf_, ones, ol); } while (0)
  f32x16 pA0, pA1, pB0, pB1; float mnA, mnB, alA, alB; i32x8 pf; constexpr int NT = NKEY / 64;
  if (__builtin_amdgcn_readfirstlane(wid) >= 4) __builtin_amdgcn_s_setprio(1);
  issue(0, 0, 0); TBAR(); issue(1, 1, 1);
  QKT(pA0, pA1, 0); partialSM<1>(pA0, pA1, m_reg, mnA, alA);
  int vcur = 0, vnext = 2;
  for (int j = 1; j + 1 < NT; j += 2) {
    TBAR(); issue(j + 1, 0, vnext);
    SBAR(); QKT(pB0, pB1, 1);
    FSM8(pA0, pA1, alA, pf); SBAR();
    PV8(vcur, pf); partialSM<1>(pB0, pB1, m_reg, mnB, alB);
    RESC(alB);
    vcur = vcur == 2 ? 0 : vcur + 1; vnext = vnext == 2 ? 0 : vnext + 1;
    TBAR(); if (j + 2 < NT) issue(j + 2, 1, vnext);
    SBAR(); QKT(pA0, pA1, 0);
    FSM8(pB0, pB1, alB, pf); SBAR();
    PV8(vcur, pf); partialSM<1>(pA0, pA1, m_reg, mnA, alA);
    RESC(alA);
    vcur = vcur == 2 ? 0 : vcur + 1; vnext = vnext == 2 ? 0 : vnext + 1;
  }
  TBAR();
  SBAR(); QKT(pB0, pB1, 1);
  FSM8(pA0, pA1, alA, pf); SBAR();
  PV8(vcur, pf); partialSM<1>(pB0, pB1, m_reg, mnB, alB);
  RESC(alB);
  vcur = vcur == 2 ? 0 : vcur + 1;
  FSM8(pB0, pB1, alB, pf); SBAR();
  PV8(vcur, pf);
  __builtin_amdgcn_s_setprio(0);
#undef TBAR
#undef RESC
#undef MF8
#undef RD32
#undef QKB
#undef QKT
#undef FSM8
#undef PV8
  float rli[16];
#pragma unroll
  for (int r = 0; r < 16; ++r) rli[r] = __builtin_amdgcn_rcpf(ol[r]);
  unsigned char* Ow = Y + (size_t)(wrow + 4 * hi) * 128 + r32;
#pragma unroll
  for (int r = 0; r < 16; ++r) { const int rr = (r & 3) + 8 * (r >> 2);
#pragma unroll
    for (int d0 = 0; d0 < 4; ++d0) { const float vf_ = o[d0][r] * rli[r]; const unsigned char v = (unsigned char)pk4_fp8(vf_, vf_, vf_, vf_); if (STORE) Ow[rr * 128 + d0 * 32] = v; else asm volatile("" :: "v"(v)); } }
  __syncthreads();
}
template <bool STORE, int WHICH = 3, int GH = 0>
__device__ void att_phase(const Params& p, char* lds) {
  const unsigned char* QA = p.ws + OFF_QA; const unsigned char* KA = p.ws + OFF_KA; const unsigned char* VAT = p.ws + OFF_VAT; unsigned char* YA = p.ws + OFF_YA;
  const unsigned char* QB = p.ws + OFF_QB; const unsigned char* KN = p.ws + OFF_KNOPE; const unsigned char* KR = p.ws + OFF_KROPE; const unsigned char* VBT = p.ws + OFF_VBT; unsigned char* YB = p.ws + OFF_YB;
  const float lam = *(const float*)(p.ws + OFF_LAM);
  for (int vb = blockIdx.x; vb < 256; vb += gridDim.x) {
    const int b = vb & 7, lb = vb >> 3, h = lb >> 2, sub = lb & 3; const size_t bh = (size_t)(b * 8 + h);
    if (WHICH & 1) for (int q = 0; q < 4; ++q) attn_mla8<STORE>(QB + (bh * 4096 + (sub * 4 + q) * 256) * 192, KN + bh * NKEY * 128, KR + (size_t)b * NKEY * 64, VBT + bh * 128 * NKEY, YB + (bh * 4096 + (sub * 4 + q) * 256) * 128, lds);
    if (WHICH & 2) for (int q = 0; q < 8; ++q) attn_diff8<STORE>(QA + (bh * 4096 + (sub * 8 + q) * 128) * 128, KA + bh * NKEY * 128, VAT + bh * 128 * NKEY, YA + (bh * 4096 + (sub * 8 + q) * 128) * 128, lam, p.subln_g, lds);
  }
}

__device__ __forceinline__ void fp8x8_to_f32(u32x2 w, float* f) {
  f[0] = __builtin_amdgcn_cvt_f32_fp8((int)w[0], 0); f[1] = __builtin_amdgcn_cvt_f32_fp8((int)w[0], 1); f[2] = __builtin_amdgcn_cvt_f32_fp8((int)w[0], 2); f[3] = __builtin_amdgcn_cvt_f32_fp8((int)w[0], 3);
  f[4] = __builtin_amdgcn_cvt_f32_fp8((int)w[1], 0); f[5] = __builtin_amdgcn_cvt_f32_fp8((int)w[1], 1); f[6] = __builtin_amdgcn_cvt_f32_fp8((int)w[1], 2); f[7] = __builtin_amdgcn_cvt_f32_fp8((int)w[1], 3);
}
__device__ void g3_phase(const Params& p, char* lds) {
  const unsigned char* YA = p.ws + OFF_YA; const unsigned char* YB = p.ws + OFF_YB;
  const unsigned char* WA = p.ws + OFF_WPAT; const unsigned char* WBt = p.ws + OFF_WPBT; const unsigned char* GT = (const unsigned char*)p.out; bf16_t* Z = (bf16_t*)(p.ws + OFF_Z); unsigned char* Z8 = p.ws + OFF_Z8;
  const int tid = opaque_tid(), wid = __builtin_amdgcn_readfirstlane(tid >> 6), lane = tid & 63, wm = wid >> 2, wn = wid & 3;
  const int G = gridDim.x, nx = (G % 8 == 0) ? 8 : 1, xg = blockIdx.x % nx, lb = blockIdx.x / nx, nlb = G / nx;
  for (int j = lb; j < (128 / nx) * 4; j += nlb) {
    const int mt = xg + nx * (j >> 2), nt = j & 3, b = mt >> 4, pos0 = (mt & 15) * 256;
    f32x16 acc[4][2];
    int ln = lane; asm volatile("" : "+v"(ln));
    char* wl = lds + wid * 16384; const char* rdp = tile_rd_ptr(wl, ln);
    const size_t t0 = (size_t)mt * 256 + wm * 128 + (ln >> 3); const int n0 = nt * 256 + wn * 64 + (ln & 7) * 8;
    auto plain = [&](int i, int r, float& x1, float& x2) { x1 = acc[i][0][r] * (1.f / W8S); x2 = acc[i][1][r] * (1.f / W8S); };
    { HeadLoader8 al{YA + ((size_t)(b * 8) * 4096 + pos0) * 128}; RowLoader8 bl{WA + (size_t)nt * 256 * 1024, 1024}; gemm_tile8(acc, al, bl, 8, lds); }
    tile_stage<4>(wl, ln, plain);
#pragma unroll
    for (int it = 0; it < 16; ++it) { const bf16x8 v = *(const bf16x8*)(rdp + it * 1024); float g[8], f[8]; fp8x8_to_f32(*(const u32x2*)(GT + (t0 + it * 8) * 2048 + n0), g);
#pragma unroll
      for (int k = 0; k < 8; ++k) f[k] = bf2f((bf16_t)v[k]) * g[k];
      *(bf16x8*)(Z + (t0 + it * 8) * 1024 + n0) = pack8(f);
      if ((it & 3) == 3) asm volatile("" ::: "memory"); }
    __syncthreads();
    { HeadLoader8 al{YB + ((size_t)(b * 8) * 4096 + pos0) * 128}; RowLoader8 bl{WBt + (size_t)nt * 256 * 1024, 1024}; gemm_tile8(acc, al, bl, 8, lds); }
    int ln2 = lane; asm volatile("" : "+v"(ln2));
    const char* rdp2 = tile_rd_ptr(wl, ln2); const size_t t2 = (size_t)mt * 256 + wm * 128 + (ln2 >> 3); const int n2 = nt * 256 + wn * 64 + (ln2 & 7) * 8;
    tile_stage<4>(wl, ln2, plain);
#pragma unroll
    for (int it = 0; it < 16; ++it) { const bf16x8 v = *(const bf16x8*)(rdp2 + it * 1024); float g[8], f[8]; fp8x8_to_f32(*(const u32x2*)(GT + (t2 + it * 8) * 2048 + 1024 + n2), g);
      const bf16x8 zo = *(const bf16x8*)(Z + (t2 + it * 8) * 1024 + n2);
#pragma unroll
      for (int k = 0; k < 8; ++k) f[k] = bf2f((bf16_t)zo[k]) + bf2f((bf16_t)v[k]) * g[k];
      u32x2 w = {pk4_fp8(f[0], f[1], f[2], f[3]), pk4_fp8(f[4], f[5], f[6], f[7])};
      *(u32x2*)(Z8 + (t2 + it * 8) * 1024 + n2) = w;
      if ((it & 1) == 1) asm volatile("" ::: "memory"); }
    __syncthreads();
  }
}
__device__ void g4_phase(const Params& p, char* lds) {
  const unsigned char* Z = p.ws + OFF_Z8; const unsigned char* WO = p.ws + OFF_WOUTT; const float* mod = (const float*)(p.ws + OFF_MOD);
  const int tid = opaque_tid(), wid = __builtin_amdgcn_readfirstlane(tid >> 6), lane = tid & 63, r32 = lane & 31, hi = lane >> 5, wm = wid >> 2, wn = wid & 3;
  const int G = gridDim.x, nx = (G % 8 == 0) ? 8 : 1, xg = blockIdx.x % nx, lb = blockIdx.x / nx, nlb = G / nx;
  for (int j = lb; j < (128 / nx) * 4; j += nlb) {
    const int mt = xg + nx * (j >> 2), nt = j & 3, b = mt >> 4;
    f32x16 acc[4][2];
    RowLoader8 al{Z + (size_t)mt * 256 * 1024, 1024}, bl{WO + (size_t)nt * 256 * 1024, 1024};
    gemm_tile8(acc, al, bl, 8, lds);
    int ln = lane; asm volatile("" : "+v"(ln));
    char* wl = lds + wid * 16384; const char* rdp = tile_rd_ptr(wl, ln);
    auto plain = [&](int i, int r, float& x1, float& x2) { x1 = acc[i][0][r] * (1.f / W8S); x2 = acc[i][1][r] * (1.f / W8S); };
    tile_stage<4>(wl, ln, plain);
    const size_t t0 = (size_t)mt * 256 + wm * 128 + (ln >> 3); const int n0 = nt * 256 + wn * 64 + (ln & 7) * 8;
    const f32x8 gt = *(const f32x8*)(mod + b * 6144 + 2048 + n0);
#pragma unroll
    for (int it = 0; it < 16; ++it) { const bf16x8 v = *(const bf16x8*)(rdp + it * 1024); const size_t off = (t0 + it * 8) * 1024 + n0; const f32x8 xv = *(const f32x8*)(p.x + off); f32x8 o;
#pragma unroll
      for (int k = 0; k < 8; ++k) o[k] = fmaf(gt[k], bf2f((bf16_t)v[k]), ALPHA * xv[k]);
      *(f32x8*)(p.out + off) = o; }
    __syncthreads();
  }
}

template <bool NOATT>
__device__ void ln1_phase(const Params& p) {
  const float* mod = (const float*)(p.ws + OFF_MOD); bf16_t* H2 = (bf16_t*)(p.ws + OFF_H2);
  const int tid = opaque_tid(), wid = tid >> 6, lane = tid & 63;
  { const int gw = blockIdx.x * 8 + wid, nw = gridDim.x * 8;
    f32x4 g[4], bb[4];
#pragma unroll
    for (int j = 0; j < 4; ++j) { const int col = j * 256 + lane * 4; g[j] = *(const f32x4*)(p.ln1_g + col); bb[j] = *(const f32x4*)(p.ln1_b + col); }
    for (int b = 0; b < NB; ++b) {
      f32x4 sh[4], sc[4];
#pragma unroll
      for (int j = 0; j < 4; ++j) { const int col = j * 256 + lane * 4; sh[j] = *(const f32x4*)(mod + b * 6144 + 3072 + col); sc[j] = *(const f32x4*)(mod + b * 6144 + 4096 + col) + 1.f; }
      for (int r = 2 * gw; r < SEQ; r += 2 * nw) {
        f32x4 v[2][4];
#pragma unroll
        for (int u = 0; u < 2; ++u)
#pragma unroll
          for (int j = 0; j < 4; ++j) { const size_t off = (size_t)(b * SEQ + r + u) * 1024 + j * 256 + lane * 4;
            if (NOATT) v[u][j] = *(const f32x4*)(p.x + off) * ALPHA; else v[u][j] = *(const f32x4*)(p.out + off); }
#pragma unroll
        for (int u = 0; u < 2; ++u) {
          float s = 0.f;
#pragma unroll
          for (int j = 0; j < 4; ++j) s += (v[u][j][0] + v[u][j][1]) + (v[u][j][2] + v[u][j][3]);
          const float mean = wave_sum(s) * (1.f / 1024.f); float q = 0.f;
#pragma unroll
          for (int j = 0; j < 4; ++j) { const f32x4 d = v[u][j] - mean; q += (d[0] * d[0] + d[1] * d[1]) + (d[2] * d[2] + d[3] * d[3]); }
          const float rstd = rsqrtf(wave_sum(q) * (1.f / 1024.f) + EPS);
#pragma unroll
          for (int j = 0; j < 4; ++j) { const f32x4 x1 = (v[u][j] - mean) * rstd * g[j] + bb[j];
            const f32x4 h = x1 * sc[j] + sh[j]; u32x2 w = {cvtpk(h[0], h[1]), cvtpk(h[2], h[3])}; *(u32x2*)(H2 + (size_t)(b * SEQ + r + u) * 1024 + j * 256 + lane * 4) = w; }
        }
      }
    }
  }
  signed char* U8 = (signed char*)(p.ws + OFF_U8); unsigned char* V8 = (unsigned char*)(p.ws + OFF_V8);
  float* SU = (float*)(p.ws + OFF_SU); float* SV = (float*)(p.ws + OFF_SV); float* SR = (float*)(p.ws + OFF_SR);
  for (int row0 = 2 * (blockIdx.x * 8 + wid); row0 < 2 * 16384; row0 += 2 * gridDim.x * 8) {
    f32x4 v[2][4];
#pragma unroll
    for (int u = 0; u < 2; ++u) { const int row = row0 + u; const float* sp = (row < 16384 ? p.peer_u + (size_t)row * 1024 : p.peer_v + (size_t)(row - 16384) * 1024) + lane * 16;
#pragma unroll
      for (int j = 0; j < 4; ++j) v[u][j] = *(const f32x4*)(sp + 4 * j); }
#pragma unroll
    for (int u = 0; u < 2; ++u) { const int row = row0 + u; const bool isu = row < 16384; const int e = isu ? row : row - 16384; float am = 0.f;
#pragma unroll
      for (int j = 0; j < 4; ++j) am = fmaxf(am, fmaxf(fmaxf(fabsf(v[u][j][0]), fabsf(v[u][j][1])), fmaxf(fabsf(v[u][j][2]), fabsf(v[u][j][3]))));
#pragma unroll
      for (int o = 32; o > 0; o >>= 1) am = fmaxf(am, __shfl_xor(am, o));
      {
        float ss = 0.f;
#pragma unroll
        for (int j = 0; j < 4; ++j) ss += (v[u][j][0] * v[u][j][0] + v[u][j][1] * v[u][j][1]) + (v[u][j][2] * v[u][j][2] + v[u][j][3] * v[u][j][3]);
        ss = wave_sum(ss);
        const float step = fminf(am * (1.f / 7.5f), 0.3352f * sqrtf(ss * (1.f / 1024.f))); const float inv = step > 0.f ? 1.f / step : 0.f; u32x2 w; int nsum = 0;
#pragma unroll
        for (int dd = 0; dd < 2; ++dd) { unsigned pk = 0;
#pragma unroll
          for (int k = 0; k < 4; ++k) { int lo_ = (int)floorf(fmaf(v[u][2 * dd][k], inv, 8.f)), hi_ = (int)floorf(fmaf(v[u][2 * dd + 1][k], inv, 8.f));
            lo_ = lo_ < 0 ? 0 : (lo_ > 15 ? 15 : lo_); hi_ = hi_ < 0 ? 0 : (hi_ > 15 ? 15 : hi_); nsum += lo_ + hi_ - 16; pk |= (unsigned)(lo_ | (hi_ << 4)) << (8 * k); }
          w[dd] = pk ^ (isu ? 0x88888888u : 0x80808080u); }
        *(u32x2*)((isu ? (unsigned char*)U8 : V8) + (size_t)e * 512 + lane * 8) = w;
        const float rs_ = wave_sum((float)nsum);
        if (lane == 0) { (isu ? SU : SV)[e] = step; if (isu) SR[e] = rs_; }
      } }
  }
}

__device__ __forceinline__ int f2key(float f) { const int b = (int)__float_as_uint(f); return b ^ ((b >> 31) & 0x7fffffff); }
__device__ __forceinline__ float key2f(int k) { const int y = k & ~127; return __uint_as_float((unsigned)(y ^ ((y >> 31) & 0x7fffffff))); }
__device__ __forceinline__ void ce_desc(int& a, int& b) { const int hi_ = a > b ? a : b, lo_ = a > b ? b : a; a = hi_; b = lo_; }
__device__ __forceinline__ void bitonic16_desc(int (&x)[16]) {
#pragma unroll
  for (int k = 2; k <= 16; k <<= 1)
#pragma unroll
    for (int j = k >> 1; j > 0; j >>= 1)
#pragma unroll
      for (int i = 0; i < 16; ++i) { const int l = i ^ j; if (l > i) { if ((i & k) == 0) ce_desc(x[i], x[l]); else ce_desc(x[l], x[i]); } }
}
__device__ __forceinline__ void merge16_desc(int (&a)[16], const int (&b)[16]) {
#pragma unroll
  for (int i = 0; i < 16; ++i) a[i] = a[i] > b[15 - i] ? a[i] : b[15 - i];
#pragma unroll
  for (int j = 8; j > 0; j >>= 1)
#pragma unroll
    for (int i = 0; i < 16; ++i) { const int l = i ^ j; if (l > i) ce_desc(a[i], a[l]); }
}
template <int GM_>
__device__ void g5_phase(const Params& p, char* lds) {
  constexpr int GM = GM_ == 3 ? 0 : GM_;
  const bf16_t* wt = (const bf16_t*)(p.ws + OFF_WEFFT); const bf16_t* H2 = (const bf16_t*)(p.ws + OFF_H2); int* IDX = (int*)(p.ws + OFF_IDX); float* WGT = (float*)(p.ws + OFF_WGT);
  const int tid = opaque_tid(), wid = __builtin_amdgcn_readfirstlane(tid >> 6), lane = tid & 63, wm = wid >> 2, wn = wid & 3;
  const int G = gridDim.x, nx = (G % 8 == 0) ? 8 : 1, xg = blockIdx.x % nx, lb = blockIdx.x / nx, nlb = G / nx;
  const int njobs = (128 / nx) * 8;
  int* xl = (int*)lds;
  for (int j = lb; j < njobs; j += nlb) {
    const int nt = xg + nx * (j >> 3), mt = j & 7;
    f32x16 acc[4][2];
    RowLoader al{wt + (size_t)mt * 256 * 1024, 1024}, bl{H2 + (size_t)nt * 256 * 1024, 1024};
    gemm_tile2<256, GM>(acc, al, bl, 16, lds);
    if (GM_ != 0) { asm volatile("" :: "v"(acc[0][0]), "v"(acc[0][1]), "v"(acc[1][0]), "v"(acc[1][1])); asm volatile("" :: "v"(acc[2][0]), "v"(acc[2][1]), "v"(acc[3][0]), "v"(acc[3][1])); continue; }
    int ln = lane; asm volatile("" : "+v"(ln));
    const int r32 = ln & 31, hi64 = (ln >> 5) << 6;
#pragma unroll
    for (int jb = 0; jb < 2; ++jb) {
      int top[16];
#pragma unroll
      for (int i = 0; i < 4; ++i) {
        int x[16];
#pragma unroll
        for (int r = 0; r < 16; ++r) x[r] = (f2key(acc[i][jb][r]) & ~127) | (i * 16 + r);
        bitonic16_desc(x);
        if (i == 0) {
#pragma unroll
          for (int r = 0; r < 16; ++r) top[r] = x[r]; }
        else merge16_desc(top, x);
      }
      int oth[16];
#pragma unroll
      for (int r = 0; r < 16; ++r) { const unsigned v = (unsigned)(top[r] | hi64);
        const auto rr = __builtin_amdgcn_permlane32_swap(v, v, false, false); top[r] = (int)rr[0]; oth[r] = (int)rr[1]; }
      merge16_desc(top, oth);
      int* xp = xl + (wm * 16 + (hi64 ? 8 : 0)) * 256 + wn * 64 + jb * 32 + r32;
#pragma unroll
      for (int r = 0; r < 8; ++r) xp[r * 256] = hi64 ? top[8 + r] : top[r];
    }
    __syncthreads();
    if (tid < 256) {
      int tk = tid; asm volatile("" : "+v"(tk));
      float A[16], B[16]; int KA[16], KB[16];
#pragma unroll
      for (int r = 0; r < 16; ++r) { const int a = xl[r * 256 + tk], bq = xl[(16 + r) * 256 + tk];
        A[r] = key2f(a); B[r] = key2f(bq);
        const int ia = a & 63, ib = bq & 63;
        KA[r] = 32 * (ia >> 4) + (ia & 3) + 8 * ((ia >> 2) & 3) + ((a >> 6) & 1) * 4;
        KB[r] = 32 * (ib >> 4) + (ib & 3) + 8 * ((ib >> 2) & 3) + ((bq >> 6) & 1) * 4; }
      float S[16]; int E[16];
#pragma unroll
      for (int r = 0; r < 16; ++r) { S[r] = -3.0e38f; E[r] = 0; }
#pragma unroll
      for (int i = 0; i < 16; ++i)
#pragma unroll
        for (int jn = 0; jn < 16; ++jn) {
          if ((i + 1) * (jn + 1) > 16) continue;
          float x = A[i] + B[jn]; int e = KA[i] * 128 + KB[jn];
#pragma unroll
          for (int r = 0; r < 16; ++r) { const bool gt = x > S[r]; const float ts = gt ? S[r] : x; const int te = gt ? E[r] : e; S[r] = gt ? x : S[r]; E[r] = gt ? e : E[r]; x = ts; e = te; }
        }
      const float mx = S[0]; float den = 0.f;
#pragma unroll
      for (int r = 0; r < 16; ++r) { S[r] = __expf(S[r] - mx); den += S[r]; }
      const float rden = 1.f / den;
      const size_t t = (size_t)nt * 256 + tk; int* ip = IDX + t * 128 + mt * 16; float* wp = WGT + t * 128 + mt * 16;
#pragma unroll
      for (int r = 0; r < 16; r += 4) { *(int4*)(ip + r) = make_int4(E[r], E[r + 1], E[r + 2], E[r + 3]); *(float4*)(wp + r) = make_float4(S[r] * rden, S[r + 1] * rden, S[r + 2] * rden, S[r + 3] * rden); }
    }
    __syncthreads();
  }
}

__device__ __forceinline__ float gelu_tanh(float x) { const float u = 0.7978845608028654f * (x + 0.044715f * x * x * x); const float e = __builtin_amdgcn_exp2f(2.885390081777927f * u); const float th = 1.f - 2.f * __builtin_amdgcn_rcpf(e + 1.f); return 0.5f * x * (1.f + th); }
__device__ __forceinline__ int sel2(bool hi, int a, int b) { return hi ? b : a; }
__device__ __forceinline__ int rl_at(int v, int k) { asm volatile("" : "+s"(k)); return __builtin_amdgcn_readlane(v, k); }
template <bool STORE, int GP = 0>
__device__ void gather_phase(const Params& p) {
  const float* mod = (const float*)(p.ws + OFF_MOD); const bf16_t* H2 = (const bf16_t*)(p.ws + OFF_H2);
  const unsigned char* U8 = (const unsigned char*)(p.ws + OFF_U8); const unsigned char* V8 = (const unsigned char*)(p.ws + OFF_V8);
  const float* SU = (const float*)(p.ws + OFF_SU); const float* SV = (const float*)(p.ws + OFF_SV); const float* SR = (const float*)(p.ws + OFF_SR);
  const int* IDX = (const int*)(p.ws + OFF_IDX); const float* WGT = (const float*)(p.ws + OFF_WGT);
  const int tid = opaque_tid(), wid = __builtin_amdgcn_readfirstlane(tid >> 6), lane0 = tid & 63;
  const int tstride = gridDim.x * 8;
  int t = blockIdx.x * 8 + wid;
  int e0 = 0, e1 = 0;
  bf16x8 hxn[4] = {}; float w0n = 0.f, w1n = 0.f;
  if (t < T) { e0 = IDX[(size_t)t * 128 + lane0]; e1 = IDX[(size_t)t * 128 + 64 + lane0]; w0n = WGT[(size_t)t * 128 + lane0]; w1n = WGT[(size_t)t * 128 + 64 + lane0];
#pragma unroll
    for (int q = 0; q < 4; ++q) hxn[q] = *(const bf16x8*)(H2 + (size_t)t * 1024 + (lane0 & 31) * 32 + q * 8); }
#define GSB() do { asm volatile("" ::: "memory"); __builtin_amdgcn_sched_barrier(0); } while (0)
  for (; t < T; t += tstride) {
    const int b = t >> 12;
    int lane = lane0; asm volatile("" : "+v"(lane));
    const int l31 = lane & 31; const bool hiH = lane >= 32;
    const unsigned char* urow = U8 + l31 * 16; const unsigned char* vrow = V8 + l31 * 16;
    int e0v = e0, e1v = e1; asm volatile("" : "+v"(e0v), "+v"(e1v));
    bf16x8 hx[4];
#pragma unroll
    for (int q = 0; q < 4; ++q) hx[q] = hxn[q];
    const float w0 = w0n, w1 = w1n;
    const float su0 = SU[e0], su1 = SU[e1], sv0 = SV[e0], sv1 = SV[e1], sr0 = SR[e0], sr1 = SR[e1];
#define ROW2(ev, k) sel2(hiH, rl_at(ev, (k)), rl_at(ev, 32 + (k)))
    u32x4 uu[16];
#pragma unroll
    for (int k = 0; k < 16; ++k) uu[k] = *(const u32x4*)(urow + (size_t)ROW2(e0, k) * 512);
    GSB();
    int XH[4], XL[4]; float sh, hcorr;
    { float hv[32]; float am = 0.f;
#pragma unroll
      for (int q = 0; q < 4; ++q)
#pragma unroll
        for (int k = 0; k < 8; ++k) { hv[8 * q + k] = bf2f((bf16_t)hx[q][k]); am = fmaxf(am, fabsf(hv[8 * q + k])); }
      am = wave_max(am);
      const float inv = am > 0.f ? 127.f / am : 0.f; sh = am * (1.f / 127.f); int qs = 0;
#pragma unroll
      for (int d = 0; d < 4; ++d) { unsigned ph = 0, pl = 0;
#pragma unroll
        for (int k = 0; k < 4; ++k) { const int qa = (int)rintf(hv[8 * d + k] * inv), qb = (int)rintf(hv[8 * d + 4 + k] * inv); qs += qa + qb;
          ph |= (unsigned)(((qa >> 4) & 15) | (((qb >> 4) & 15) << 4)) << (8 * k); pl |= (unsigned)((qa & 15) | ((qb & 15) << 4)) << (8 * k); }
        XH[d] = (int)ph; XL[d] = (int)(pl ^ 0x88888888u); }
      hcorr = 0.5f * wave_sum(hiH ? 0.f : (float)qs); }
    GSB();
    u32x4 vv[16]; float cc[2]; int part[32];
#define TRSTEP(S, CTRL) do { const bool up = (lane & (S)) != 0;                                                                                                            \
      _Pragma("unroll") for (int i = 0; i < (S); ++i) { const int give = up ? part[i] : part[i + (S)], keep = up ? part[i + (S)] : part[i]; part[i] = keep + __builtin_amdgcn_update_dpp(0, give, CTRL, 0xF, 0xF, true); } } while (0)
#define TREDUCE() do { _Pragma("unroll") for (int i = 0; i < 16; ++i) { auto r_ = __builtin_amdgcn_permlane16_swap((unsigned)part[i], (unsigned)part[i + 16], false, false); part[i] = (int)r_[0] + (int)r_[1]; } \
      TRSTEP(8, 0x140); TRSTEP(4, 0x141); TRSTEP(2, 0x4E); TRSTEP(1, 0xB1); } while (0)
#define UINS(i) do { const u32x4 u = uu[(i) & 15]; int a_ = 0, b_ = 0;                                                                                                      \
      _Pragma("unroll") for (int d = 0; d < 4; ++d) { if (GP & 2) { asm volatile("" :: "v"(u[d])); continue; } a_ = __builtin_amdgcn_sdot8((int)u[d], XH[d], a_, false); b_ = __builtin_amdgcn_sdot8((int)u[d], XL[d], b_, false); } \
      a_ = a_ * 16 + b_;                                                                                                                                                      \
      part[(i) & 31] = a_;                                                                                                                                                    \
      if ((i) + 16 < 64) uu[(i) & 15] = *(const u32x4*)(urow + (size_t)ROW2(((i) + 16) < 32 ? e0 : e1, ((i) + 16) & 31) * 512);                                                  \
      else vv[(i) - 48] = *(const u32x4*)(vrow + (size_t)ROW2(e0v, (i) - 48) * 512);                                                                                          \
      GSB(); } while (0)
#pragma unroll
    for (int i = 0; i < 32; ++i) UINS(i);
    TREDUCE(); cc[0] = w0 * gelu_tanh(sh * su0 * ((float)part[0] + 8.f * sr0 + hcorr)) * sv0; GSB();
#pragma unroll
    for (int i = 32; i < 64; ++i) UINS(i);
#undef UINS
    TREDUCE(); cc[1] = w1 * gelu_tanh(sh * su1 * ((float)part[0] + 8.f * sr1 + hcorr)) * sv1;
#undef TREDUCE
#undef TRSTEP
    const int tn = t + tstride < T ? t + tstride : t;
    const int e0n = IDX[(size_t)tn * 128 + lane], e1n = IDX[(size_t)tn * 128 + 64 + lane];
    w0n = WGT[(size_t)tn * 128 + lane]; w1n = WGT[(size_t)tn * 128 + 64 + lane];
#pragma unroll
    for (int q = 0; q < 4; ++q) hxn[q] = *(const bf16x8*)(H2 + (size_t)tn * 1024 + l31 * 32 + q * 8);
    const float cm = wave_max(fmaxf(fabsf(cc[0]), fabsf(cc[1])));
    const float cinv = cm > 0.f ? 127.f / cm : 0.f;
    const int cq0 = (int)rintf(cc[0] * cinv), cq1 = (int)rintf(cc[1] * cinv);
    const float csum = wave_sum((float)(cq0 + cq1));
    int accL[16], accB[16];
#pragma unroll
    for (int k = 0; k < 16; ++k) { accL[k] = 0; accB[k] = 0; }
    int cb = l31 * 32 + (lane >> 5) * 16; asm volatile("" : "+v"(cb));
    f32x4 r1v[4];
    GSB();
#pragma unroll
    for (int i = 0; i < 64; ++i) {
      const int c0_ = ROW2(i < 32 ? cq0 : cq1, i & 31) & 0xff, c1_ = c0_ << 8, c2_ = c0_ << 16, c3_ = c0_ << 24;
#pragma unroll
      for (int d = 0; d < 4; ++d) { const int x = (int)vv[i & 15][d]; const int lo_ = x & 0x0f0f0f0f; if (GP & 1) { asm volatile("" :: "v"(lo_), "s"(c1_), "s"(c2_), "s"(c3_)); continue; }
        accL[4 * d + 0] = __builtin_amdgcn_sdot4(lo_, c0_, accL[4 * d + 0], false); accL[4 * d + 1] = __builtin_amdgcn_sdot4(lo_, c1_, accL[4 * d + 1], false);
        accL[4 * d + 2] = __builtin_amdgcn_sdot4(lo_, c2_, accL[4 * d + 2], false); accL[4 * d + 3] = __builtin_amdgcn_sdot4(lo_, c3_, accL[4 * d + 3], false);
        accB[4 * d + 0] = __builtin_amdgcn_sdot4(x, c0_, accB[4 * d + 0], false); accB[4 * d + 1] = __builtin_amdgcn_sdot4(x, c1_, accB[4 * d + 1], false);
        accB[4 * d + 2] = __builtin_amdgcn_sdot4(x, c2_, accB[4 * d + 2], false); accB[4 * d + 3] = __builtin_amdgcn_sdot4(x, c3_, accB[4 * d + 3], false); }
      if (i + 16 < 64) vv[i & 15] = *(const u32x4*)(vrow + (size_t)ROW2((i + 16) < 32 ? e0v : e1v, (i + 16) & 31) * 512);
      else if (i < 52) r1v[i - 48] = *(const f32x4*)(p.out + (size_t)t * 1024 + cb + (i - 48) * 4);
      GSB();
    }
#undef ROW2
    float fin[16];
    { const float cs = cm * (1.f / 127.f);
#pragma unroll
      for (int m = 0; m < 8; ++m) { auto rl_ = __builtin_amdgcn_permlane32_swap((unsigned)accL[m], (unsigned)accL[m + 8], false, false); auto rb_ = __builtin_amdgcn_permlane32_swap((unsigned)accB[m], (unsigned)accB[m + 8], false, false);
        const int L_ = (int)rl_[0] + (int)rl_[1], B_ = (int)rb_[0] + (int)rb_[1];
        fin[8 * (m >> 2) + (m & 3)] = cs * ((float)L_ - 7.5f * csum); fin[8 * (m >> 2) + 4 + (m & 3)] = cs * ((float)(B_ - L_) * 0.0625f + 0.5f * csum); } }
    float r2[16]; float s = 0.f;
    { float s1 = 0.f;
#pragma unroll
      for (int q = 0; q < 4; ++q) s1 += (r1v[q][0] + r1v[q][1]) + (r1v[q][2] + r1v[q][3]);
      const float m1 = wave_sum(s1) * (1.f / 1024.f); float q1 = 0.f;
#pragma unroll
      for (int q = 0; q < 4; ++q) { const f32x4 d = r1v[q] - m1; q1 += (d[0] * d[0] + d[1] * d[1]) + (d[2] * d[2] + d[3] * d[3]); }
      const float rs1 = rsqrtf(wave_sum(q1) * (1.f / 1024.f) + EPS);
#pragma unroll
      for (int q = 0; q < 4; ++q) { const int col = cb + q * 4; const f32x4 g1 = *(const f32x4*)(p.ln1_g + col), b1 = *(const f32x4*)(p.ln1_b + col), g2 = *(const f32x4*)(mod + b * 6144 + 5120 + col);
#pragma unroll
        for (int k = 0; k < 4; ++k) { const float x1 = (r1v[q][k] - m1) * rs1 * g1[k] + b1[k]; r2[q * 4 + k] = fmaf(g2[k], fin[q * 4 + k], ALPHA * x1); s += r2[q * 4 + k]; } } }
    const float mean = wave_sum(s) * (1.f / 1024.f); float qq = 0.f;
#pragma unroll
    for (int k = 0; k < 16; ++k) { const float d = r2[k] - mean; qq = fmaf(d, d, qq); }
    const float rstd = rsqrtf(wave_sum(qq) * (1.f / 1024.f) + EPS);
#pragma unroll
    for (int q = 0; q < 4; ++q) { const int col = cb + q * 4; const f32x4 g = *(const f32x4*)(p.ln2_g + col), bb = *(const f32x4*)(p.ln2_b + col); f32x4 o;
#pragma unroll
      for (int k = 0; k < 4; ++k) o[k] = (r2[q * 4 + k] - mean) * rstd * g[k] + bb[k];
      if (STORE) *(f32x4*)(p.out + (size_t)t * 1024 + col) = o; else asm volatile("" :: "v"(o)); }
    e0 = e0n; e1 = e1n;
  }
#undef GSB
}

#define REPEAT(id, call) do { int nrep_ = (PROBE_DUP == (id)) ? 2 : 1; asm volatile("" : "+s"(nrep_)); for (int rep_ = 0; rep_ < nrep_; ++rep_) { call; } } while (0)
__global__ void __launch_bounds__(NTHR) fwd_mega(Params p) {
  extern __shared__ __attribute__((aligned(16))) char lds[];
  cg::grid_group grid = cg::this_grid();
  volatile LAS unsigned* xst = (volatile LAS unsigned*)(lds + LDS_BYTES - 16);
  if (threadIdx.x == 0) { xst[0] = 0u; xst[1] = 0u; }
  __syncthreads();
  const XcdBarrier xb = xcd_barrier_post((unsigned*)(p.ws + OFF_BAR), xst);
  { int nrep0_ = (PROBE_DUP == 30) ? 2 : 1; asm volatile("" : "+s"(nrep0_)); for (int rep0_ = 0; rep0_ < nrep0_; ++rep0_) {
  p0_misc(p);
  REPEAT(32, p0_mod(p, lds));
  { int nrt_ = (PROBE_DUP == 33) ? 2 : 1; asm volatile("" : "+s"(nrt_)); for (int rt_ = 0; rt_ < nrt_; ++rt_) { int jc = 0;
    p0_transpose(p.w_in, 1024, IN_COLS, IN_PAD, (bf16_t*)(p.ws + OFF_WINT), nullptr, lds, jc, jc, W8S);
    p0_transpose(p.w_q_up, 256, 1536, 1536, (bf16_t*)(p.ws + OFF_WQUPT), p.q_norm_g, lds, jc, jc);
    p0_transpose(p.w_kv_up, 256, 2048, 2048, (bf16_t*)(p.ws + OFF_WKVUPT), p.kv_norm_g, lds, jc, jc);
    p0_transpose(p.w_pa, 1024, 1024, 1024, (bf16_t*)(p.ws + OFF_WPAT), nullptr, lds, jc, jc, W8S);
    p0_transpose(p.w_pb, 1024, 1024, 1024, (bf16_t*)(p.ws + OFF_WPBT), nullptr, lds, jc, jc, W8S);
    p0_transpose(p.w_out, 1024, 1024, 1024, (bf16_t*)(p.ws + OFF_WOUTT), nullptr, lds, jc, jc, W8S); } }
  REPEAT(34, p0_weff(p, lds));
  } }
  grid.sync();
  p0_mod_reduce(p);
  xcd_barrier(xb);
  REPEAT(8, p0b_hmod(p));
  xcd_barrier(xb);
#if PROBE_DUP == 16
  g1_phase<1>(p, lds);
#elif PROBE_DUP == 17
  g1_phase<2>(p, lds);
#endif
  REPEAT(3, g1_phase<0>(p, lds));
  xcd_barrier(xb);
  REPEAT(4, g2_phase(p, lds));
  xcd_barrier(xb);
#if PROBE_DUP == 1
  att_phase<false>(p, lds);
#elif PROBE_DUP == 14
  att_phase<false, 1>(p, lds);
#elif PROBE_DUP == 15
  att_phase<false, 2>(p, lds);
#elif PROBE_DUP >= 100 && PROBE_DUP < 200
  att_phase<false, 2, PROBE_DUP - 100>(p, lds);
#elif PROBE_DUP >= 200 && PROBE_DUP < 300
  att_phase<false, 1, PROBE_DUP - 200>(p, lds);
#endif
  att_phase<true>(p, lds);
  xcd_barrier(xb);
  REPEAT(5, g3_phase(p, lds));
  xcd_barrier(xb);
  REPEAT(9, g4_phase(p, lds));
  xcd_barrier(xb);
  ln1_phase<false>(p);
  xcd_barrier(xb);
#if PROBE_DUP == 11
  g5_phase<1>(p, lds);
#elif PROBE_DUP == 12
  g5_phase<2>(p, lds);
#elif PROBE_DUP == 13
  g5_phase<3>(p, lds);
#endif
  REPEAT(6, g5_phase<0>(p, lds));
  xcd_barrier(xb);
#if PROBE_DUP == 2
  gather_phase<false>(p);
#elif PROBE_DUP >= 20 && PROBE_DUP < 24
  gather_phase<false, PROBE_DUP - 20>(p);
#endif
  gather_phase<true>(p);
}

extern "C" void kernel_launch(void* const* d_in, const int* in_sizes, int n_in, void* d_out, int out_size, void* d_ws, size_t ws_size, hipStream_t stream) {
  static int grid_blocks = 0;
  if (grid_blocks == 0) {
    if (n_in != 27 || out_size != T * DM || ws_size < WS_END) { fprintf(stderr, "kernel_launch: unexpected shapes n_in %d out %d ws %zu (need %zu)\n", n_in, out_size, ws_size, (size_t)WS_END); grid_blocks = -1; return; }
    int dev = 0, cus = 0, per_cu = 0;
    hipGetDevice(&dev); hipDeviceGetAttribute(&cus, hipDeviceAttributeMultiprocessorCount, dev);
    if (hipFuncSetAttribute((const void*)fwd_mega, hipFuncAttributeMaxDynamicSharedMemorySize, LDS_BYTES) != hipSuccess) { fprintf(stderr, "kernel_launch: hipFuncSetAttribute failed\n"); grid_blocks = -1; return; }
    if (hipOccupancyMaxActiveBlocksPerMultiprocessor(&per_cu, (const void*)fwd_mega, NTHR, LDS_BYTES) != hipSuccess || per_cu < 1) { fprintf(stderr, "kernel_launch: occupancy query failed (%d)\n", per_cu); grid_blocks = -1; return; }
    grid_blocks = cus;
    fprintf(stderr, "kernel_launch: cus %d per_cu %d grid %d\n", cus, per_cu, grid_blocks);
  }
  if (grid_blocks < 0) return;
  Params p{};
  const float** f = (const float**)&p;
  for (int i = 0; i < 27; ++i) f[i] = (const float*)d_in[i];
  p.out = (float*)d_out; p.ws = (unsigned char*)d_ws;
  if (hipMemsetAsync((char*)d_ws + OFF_BAR, 0, XCD_BAR_WORDS * 4, stream) != hipSuccess) { fprintf(stderr, "kernel_launch: memset failed\n"); return; }
  void* args[] = {&p};
  hipError_t e = hipLaunchCooperativeKernel((const void*)fwd_mega, dim3(grid_blocks), dim3(NTHR), args, LDS_BYTES, stream);
  if (e != hipSuccess) fprintf(stderr, "kernel_launch: cooperative launch failed: %s (grid %d)\n", hipGetErrorString(e), grid_blocks);
}
```

```cpp
#include <hip/hip_runtime.h>
#include <hip/hip_cooperative_groups.h>
#include <cstdio>
#include <cstdint>
namespace cg = cooperative_groups;
#ifndef PROBE_DUP
#define PROBE_DUP 0
#endif

typedef unsigned short bf16_t;
typedef short bf16x8 __attribute__((ext_vector_type(8)));
typedef short s16x4 __attribute__((ext_vector_type(4)));
typedef float f32x16 __attribute__((ext_vector_type(16)));
typedef float f32x8 __attribute__((ext_vector_type(8)));
typedef float f32x4 __attribute__((ext_vector_type(4)));
typedef unsigned u32x4 __attribute__((ext_vector_type(4)));
typedef int i32x8 __attribute__((ext_vector_type(8)));
typedef unsigned u32x2 __attribute__((ext_vector_type(2)));

constexpr int DM = 1024, NB = 8, SEQ = 4096, CTXL = 256, T = NB * SEQ, TC = NB * CTXL, NKEY = SEQ + CTXL, TK = NB * NKEY;
constexpr int Q_COLS = 3328, IN_COLS = 5696, IN_PAD = 5888;
constexpr float EPS = 1e-6f;
constexpr float ALPHA = 1.189207115002721f;
constexpr float LAMBDA_INIT = 0.2f;
constexpr int NTHR = 512;
constexpr float W8S = 64.f;
constexpr int LDS_BYTES = 152 * 1024;

constexpr size_t MiB = 1u << 20;
constexpr size_t WS_MODP = (25 + 374 + 80) * MiB;
constexpr size_t OFF_MOD = 0;
constexpr size_t OFF_ROPE = 256 * 1024;
constexpr size_t OFF_LAM = 300 * 1024;
constexpr size_t OFF_BAR = 512 * 1024;
constexpr size_t OFF_SR = 800 * 1024;
constexpr size_t OFF_SU = 600 * 1024, OFF_SV = 700 * 1024;
constexpr size_t OFF_MODP = WS_MODP;
constexpr size_t OFF_WINT = 1 * MiB;
constexpr size_t OFF_WQUPT = 13 * MiB;
constexpr size_t OFF_WKVUPT = 14 * MiB;
constexpr size_t OFF_WPAT = 15 * MiB, OFF_WPBT = 17 * MiB, OFF_WOUTT = 19 * MiB;
constexpr size_t OFF_WEFFT = 21 * MiB;
constexpr size_t WB = 25 * MiB;
constexpr size_t OFF_KA = WB, OFF_VA = WB + 68 * MiB, OFF_KNOPE = WB + 136 * MiB, OFF_VB = WB + 204 * MiB, OFF_KROPE = WB + 272 * MiB;
constexpr size_t OFF_QLAT = WB + 277 * MiB, OFF_KVLAT = WB + 293 * MiB, OFF_QA = WB + 310 * MiB, OFF_QB = WB + 374 * MiB, WS_END = WB + 470 * MiB;
constexpr size_t OFF_HMOD = OFF_QB;
constexpr size_t OFF_VAT = OFF_KA + 34 * MiB;
constexpr size_t OFF_VBT = OFF_KNOPE + 34 * MiB, OFF_YB = OFF_VB;
constexpr size_t OFF_Z8 = OFF_KNOPE;
constexpr size_t OFF_YA = OFF_VA;
constexpr size_t OFF_Z = OFF_KA, OFF_H2 = OFF_VA, OFF_U8 = OFF_KNOPE, OFF_V8 = OFF_KNOPE + 16 * MiB;
constexpr size_t OFF_IDX = OFF_Z, OFF_WGT = OFF_Z + 16 * MiB;

struct Params {
  const float *x, *c, *ctx, *c_ctx, *w_mod, *b_mod, *w_in, *w_q_up, *q_norm_g, *w_kv_up, *kv_norm_g, *lq1, *lk1, *lq2, *lk2, *subln_g, *w_pa, *w_pb, *w_out,
      *ln1_g, *ln1_b, *w_pq, *peer_keys, *peer_u, *peer_v, *ln2_g, *ln2_b;
  float* out; unsigned char* ws;
};

__device__ __forceinline__ unsigned cvtpk(float lo, float hi) { unsigned r; asm volatile("v_cvt_pk_bf16_f32 %0, %1, %2" : "=v"(r) : "v"(lo), "v"(hi)); return r; }
__device__ __forceinline__ bf16_t f2bf(float x) { return (bf16_t)(cvtpk(x, x) & 0xffffu); }
__device__ __forceinline__ float bf2f(bf16_t v) { return __uint_as_float(((unsigned)v) << 16); }
__device__ __forceinline__ int crow(int r, int hi) { return (r & 3) + 8 * (r >> 2) + 4 * hi; }
__device__ __forceinline__ unsigned pk4_fp8(float a, float b, float c, float d) { return (unsigned)__builtin_amdgcn_cvt_pk_fp8_f32(c, d, __builtin_amdgcn_cvt_pk_fp8_f32(a, b, 0, false), true); }
__device__ __forceinline__ bf16x8 pack8(const float* v) { u32x4 w = {cvtpk(v[0], v[1]), cvtpk(v[2], v[3]), cvtpk(v[4], v[5]), cvtpk(v[6], v[7])}; return *reinterpret_cast<bf16x8*>(&w); }
__device__ __forceinline__ float sigmoid_f(float v) { return __builtin_amdgcn_rcpf(1.f + __builtin_amdgcn_exp2f(-1.4426950408889634f * v)); }
__device__ __forceinline__ float silu_f(float v) { return v * sigmoid_f(v); }
template <int CTRL> __device__ __forceinline__ float dppf(float v) { return __uint_as_float((unsigned)__builtin_amdgcn_update_dpp(0, (int)__float_as_uint(v), CTRL, 0xF, 0xF, true)); }
__device__ __forceinline__ float wave_sum(float v) {
  v += dppf<0xB1>(v); v += dppf<0x4E>(v); v += dppf<0x141>(v); v += dppf<0x140>(v);
  { auto r = __builtin_amdgcn_permlane16_swap(__float_as_uint(v), __float_as_uint(v), false, false); v = __uint_as_float(r[0]) + __uint_as_float(r[1]); }
  { auto r = __builtin_amdgcn_permlane32_swap(__float_as_uint(v), __float_as_uint(v), false, false); v = __uint_as_float(r[0]) + __uint_as_float(r[1]); }
  return v;
}
__device__ __forceinline__ float wave_max(float v) {
  v = fmaxf(v, dppf<0xB1>(v)); v = fmaxf(v, dppf<0x4E>(v)); v = fmaxf(v, dppf<0x141>(v)); v = fmaxf(v, dppf<0x140>(v));
  { auto r = __builtin_amdgcn_permlane16_swap(__float_as_uint(v), __float_as_uint(v), false, false); v = fmaxf(__uint_as_float(r[0]), __uint_as_float(r[1])); }
  { auto r = __builtin_amdgcn_permlane32_swap(__float_as_uint(v), __float_as_uint(v), false, false); v = fmaxf(__uint_as_float(r[0]), __uint_as_float(r[1])); }
  return v;
}

__device__ __forceinline__ int opaque_tid() { int t = threadIdx.x; asm volatile("" : "+v"(t)); return t; }


#define XB_TMO      128
#define XB_XCNT(j)  (256  + 64 * (j))
#define XB_XSUB(j)  (1280 + 64 * (j))
#define XB_XGEN(j)  (2304 + 64 * (j))
#define XB_TOP      3328
#define XB_TOPGEN   3392
#define XCD_BAR_WORDS 3456
#define XB_SPIN_CAP (1u << 20)
#define LAS __attribute__((address_space(3)))
__device__ __forceinline__ unsigned xb_ld(unsigned* p)              { return __hip_atomic_load(p, __ATOMIC_RELAXED, __HIP_MEMORY_SCOPE_AGENT); }
__device__ __forceinline__ unsigned xb_add(unsigned* p, unsigned v) { return __hip_atomic_fetch_add(p, v, __ATOMIC_RELAXED, __HIP_MEMORY_SCOPE_AGENT); }
__device__ __forceinline__ unsigned xb_xcc_id() { return (unsigned)__builtin_amdgcn_s_getreg((3 << 11) | 20) & 0xFu; }
#define XB_SPIN(cond, bar) do { unsigned _sp = 0; while (cond) { __builtin_amdgcn_s_sleep(1); \
    if ((++_sp & 255u) == 0u) { if (xb_ld(&(bar)[XB_TMO])) break; if (_sp > XB_SPIN_CAP) { atomicAdd(&(bar)[XB_TMO], 1u); break; } } } } while (0)
struct XcdBarrier { unsigned* bar; unsigned x; volatile LAS unsigned* st; };
__device__ __forceinline__ XcdBarrier xcd_barrier_post(unsigned* bar, volatile LAS unsigned* st) {
    XcdBarrier b; b.bar = bar; b.x = xb_xcc_id(); b.st = st;
    if (threadIdx.x == 0) (void)xb_add(&bar[XB_XCNT(b.x)], 1u);
    return b;
}
__device__ __forceinline__ void xcd_barrier_complete(unsigned* bar, unsigned x, unsigned& nloc, unsigned& nx) {
    const unsigned G = gridDim.x * gridDim.y * gridDim.z;
    unsigned sum, cnt, mine, sp = 0u;
    for (;;) {
        sum = 0u; cnt = 0u; mine = 0u;
#pragma unroll
        for (unsigned j = 0; j < 16; ++j) { const unsigned c = xb_ld(&bar[XB_XCNT(j)]); sum += c; cnt += (c > 0u) ? 1u : 0u; mine = (j == x) ? c : mine; }
        if (sum == G) break;
        __builtin_amdgcn_s_sleep(1);
        if ((++sp & 255u) == 0u) { if (xb_ld(&bar[XB_TMO])) break; if (sp > XB_SPIN_CAP) { atomicAdd(&bar[XB_TMO], 1u); break; } }
    }
    nloc = mine > 0u ? mine : 1u; nx = cnt > 0u ? cnt : 1u;
}
__device__ __forceinline__ void xcd_barrier(const XcdBarrier& b) {
    asm volatile("s_waitcnt vmcnt(0)" ::: "memory");
    __syncthreads();
    if (threadIdx.x == 0) {
        unsigned* bar = b.bar;
        __builtin_amdgcn_s_waitcnt(0);
        unsigned nloc = b.st[0], nx = b.st[1];
        if (nloc == 0u) { xcd_barrier_complete(bar, b.x, nloc, nx); b.st[0] = nloc; b.st[1] = nx; }
        const unsigned old = xb_add(&bar[XB_XSUB(b.x)], 1u);
        const unsigned gen = old / nloc;
        if (old + 1u == (gen + 1u) * nloc) {
            __builtin_amdgcn_fence(__ATOMIC_RELEASE, "agent");
            asm volatile("s_waitcnt vmcnt(0)" ::: "memory");
            const unsigned og = xb_add(&bar[XB_TOP], 1u);
            const unsigned tg = og / nx;
            if (og + 1u == (tg + 1u) * nx) xb_add(&bar[XB_TOPGEN], 1u);
            else XB_SPIN(xb_ld(&bar[XB_TOPGEN]) == tg, bar);
            __builtin_amdgcn_fence(__ATOMIC_ACQUIRE, "agent");
            xb_add(&bar[XB_XGEN(b.x)], 1u);
            asm volatile("s_waitcnt vmcnt(0)" ::: "memory");
        } else {
            XB_SPIN(xb_ld(&bar[XB_XGEN(b.x)]) == gen, bar);
            __builtin_amdgcn_fence(__ATOMIC_ACQUIRE, "agent");
            asm volatile("s_waitcnt vmcnt(0)" ::: "memory");
        }
    }
    __syncthreads();
}

__device__ void p0_mod(const Params& p, char* lds) {
  float* s_l = (float*)lds;
  float* red = (float*)(lds + 9 * 64 * 4);
  const int tid = opaque_tid();
  float* MODP = (float*)(p.ws + OFF_MODP);
  for (int job = blockIdx.x; job < 256; job += gridDim.x) {
    const int kg = job >> 4, cg = job & 15, k0 = kg * 64, c0 = cg * 384;
    for (int i = tid; i < 9 * 64; i += NTHR) { const int r = i >> 6, k = k0 + (i & 63); const float v = r < 8 ? p.c[r * 1024 + k] : p.c_ctx[k]; s_l[i] = silu_f(v); }
    __syncthreads();
    const int cq = tid % 96, kr = tid / 96;
    if (kr < 5) {
      f32x4 w[13];
#pragma unroll
      for (int i = 0; i < 13; ++i) { const int kk = kr + 5 * i; w[i] = kk < 64 ? *(const f32x4*)(p.w_mod + (size_t)(k0 + kk) * 6144 + c0 + cq * 4) : (f32x4){0.f, 0.f, 0.f, 0.f}; }
      f32x4 acc[9];
#pragma unroll
      for (int r = 0; r < 9; ++r) acc[r] = (f32x4){0.f, 0.f, 0.f, 0.f};
#pragma unroll
      for (int i = 0; i < 13; ++i) { const int kk = kr + 5 * i; if (kk < 64) {
#pragma unroll
        for (int r = 0; r < 9; ++r) acc[r] += w[i] * s_l[r * 64 + kk]; } }
#pragma unroll
      for (int r = 0; r < 9; ++r) *(f32x4*)(red + ((kr * 96 + cq) * 9 + r) * 4) = acc[r];
    }
    __syncthreads();
    for (int i = tid; i < 96 * 9; i += NTHR) { const int cq2 = i / 9, r = i % 9; f32x4 s = {0.f, 0.f, 0.f, 0.f};
#pragma unroll
      for (int q = 0; q < 5; ++q) s += *(const f32x4*)(red + ((q * 96 + cq2) * 9 + r) * 4);
      *(f32x4*)(MODP + ((size_t)kg * 9 + r) * 6144 + c0 + cq2 * 4) = s; }
    __syncthreads();
  }
}
__device__ void p0_mod_reduce(const Params& p) {
  const float* MODP = (const float*)(p.ws + OFF_MODP); float* mod = (float*)(p.ws + OFF_MOD);
  for (int i = blockIdx.x * NTHR + threadIdx.x; i < 9 * 6144 / 4; i += gridDim.x * NTHR) {
    f32x4 s = *(const f32x4*)(p.b_mod + (i % 1536) * 4);
#pragma unroll
    for (int kg = 0; kg < 16; ++kg) s += *(const f32x4*)(MODP + (size_t)kg * 9 * 6144 + (size_t)i * 4);
    *(f32x4*)(mod + (size_t)i * 4) = s; }
}
__device__ void p0_transpose(const float* __restrict__ src, int K, int N, int Npad, bf16_t* __restrict__ dst, const float* __restrict__ gk, char* lds, int job0, int& jobctr, float f8scale = 0.f) {
  float* tile = (float*)lds;
  const int tid = opaque_tid(), nkt = K / 64, nnt = Npad / 64, ntile = nkt * nnt;
  const int Gd = (int)gridDim.x, first = (((int)blockIdx.x - job0) % Gd + Gd) % Gd;
  for (int tI = first; tI < ntile; tI += Gd) {
    const int kt = tI % nkt, nt = tI / nkt;
    { const int kk = tid >> 3, nc = (tid & 7) * 8; const int n0 = nt * 64 + nc; const float* sp = src + (size_t)(kt * 64 + kk) * N + n0;
      float v[8];
      if (n0 + 8 <= N) { const f32x4 a = *(const f32x4*)sp, b = *(const f32x4*)(sp + 4); v[0] = a[0]; v[1] = a[1]; v[2] = a[2]; v[3] = a[3]; v[4] = b[0]; v[5] = b[1]; v[6] = b[2]; v[7] = b[3]; }
      else { for (int j = 0; j < 8; ++j) v[j] = (n0 + j < N) ? sp[j] : 0.f; }
      const float g = gk ? gk[kt * 64 + kk] : 1.f;
      for (int j = 0; j < 8; ++j) tile[kk * 65 + nc + j] = v[j] * g; }
    __syncthreads();
    { const int n = tid >> 3, kc = (tid & 7) * 8; float v[8];
      for (int j = 0; j < 8; ++j) v[j] = tile[(kc + j) * 65 + n];
      if (f8scale != 0.f) { u32x2 w = {pk4_fp8(v[0] * f8scale, v[1] * f8scale, v[2] * f8scale, v[3] * f8scale), pk4_fp8(v[4] * f8scale, v[5] * f8scale, v[6] * f8scale, v[7] * f8scale)};
        *(u32x2*)((unsigned char*)dst + (size_t)(nt * 64 + n) * K + kt * 64 + kc) = w; }
      else *(bf16x8*)(dst + (size_t)(nt * 64 + n) * K + kt * 64 + kc) = pack8(v); }
    __syncthreads();
  }
  jobctr = job0 + ntile;
}
__device__ void p0_weff(const Params& p, char* lds) {
  float* ks = (float*)lds;
  float* wq = (float*)(lds + 128 * 129 * 4);
  bf16_t* dst = (bf16_t*)(p.ws + OFF_WEFFT);
  const int tid = opaque_tid();
  for (int job = blockIdx.x; job < 256; job += gridDim.x) {
    const int g = job >> 4, kc = job & 15;
#pragma unroll
    for (int it = 0; it < 8; ++it) { const int i = (it * NTHR + tid) * 4, key = i >> 7, d = i & 127; const f32x4 v = *(const f32x4*)(p.peer_keys + (size_t)g * 16384 + i);
      ks[key * 129 + d] = v[0]; ks[key * 129 + d + 1] = v[1]; ks[key * 129 + d + 2] = v[2]; ks[key * 129 + d + 3] = v[3]; }
#pragma unroll
    for (int it = 0; it < 4; ++it) { const int i = (it * NTHR + tid) * 4, kk = i >> 7, d = i & 127; *(f32x4*)(wq + i) = *(const f32x4*)(p.w_pq + (size_t)(kc * 64 + kk) * 2048 + g * 128 + d); }
    __syncthreads();
    const int key0 = tid & 63, ksub = tid >> 6; float a0[8], a1[8];
#pragma unroll
    for (int j = 0; j < 8; ++j) { a0[j] = 0.f; a1[j] = 0.f; }
    for (int d = 0; d < 128; ++d) { const float k0v = ks[key0 * 129 + d], k1v = ks[(key0 + 64) * 129 + d];
#pragma unroll
      for (int j = 0; j < 8; ++j) { const float wv = wq[(ksub * 8 + j) * 128 + d]; a0[j] = fmaf(k0v, wv, a0[j]); a1[j] = fmaf(k1v, wv, a1[j]); } }
    *(bf16x8*)(dst + (size_t)(g * 128 + key0) * 1024 + kc * 64 + ksub * 8) = pack8(a0);
    *(bf16x8*)(dst + (size_t)(g * 128 + key0 + 64) * 1024 + kc * 64 + ksub * 8) = pack8(a1);
    __syncthreads();
  }
}
__device__ void p0_misc(const Params& p) {
  if (blockIdx.x == 0) {
    float* rope = (float*)(p.ws + OFF_ROPE);
    for (int i = threadIdx.x; i < 1024; i += NTHR) { const int pos = i >> 4, q = i & 15; const float inv = powf(10000.f, -(float)q / 16.f); const float ang = (float)pos * inv; rope[i * 2] = cosf(ang); rope[i * 2 + 1] = sinf(ang); }
    if (threadIdx.x < 64) { const int l = threadIdx.x; float a = wave_sum(p.lq1[l] * p.lk1[l]), b = wave_sum(p.lq2[l] * p.lk2[l]);
      if (l == 0) *(float*)(p.ws + OFF_LAM) = expf(a) - expf(b) + LAMBDA_INIT; }
  }
}
__device__ void p0b_hmod(const Params& p) {
  const float* mod = (const float*)(p.ws + OFF_MOD); unsigned char* h = p.ws + OFF_HMOD;
  const size_t nchunk = (size_t)(T + TC) * 128;
  for (size_t i = (size_t)blockIdx.x * NTHR + threadIdx.x; i < nchunk; i += (size_t)gridDim.x * NTHR) {
    const int row = (int)(i >> 7), k = (int)(i & 127) * 8; const float* src; int mr;
    if (row < T) { src = p.x + (size_t)row * 1024 + k; mr = row >> 12; } else { src = p.ctx + (size_t)(row - T) * 1024 + k; mr = 8; }
    const f32x8 xv = *(const f32x8*)src, sh = *(const f32x8*)(mod + mr * 6144 + k), sc = *(const f32x8*)(mod + mr * 6144 + 1024 + k);
    float v[8];
#pragma unroll
    for (int j = 0; j < 8; ++j) v[j] = fmaf(xv[j], 1.f + sc[j], sh[j]);
    u32x2 w = {pk4_fp8(v[0], v[1], v[2], v[3]), pk4_fp8(v[4], v[5], v[6], v[7])};
    *(u32x2*)(h + (size_t)row * 1024 + k) = w;
  }
}

template <int BN> struct GT2 { static constexpr int MI = BN == 256 ? 4 : 2, A_B = 32768, B_B = BN * 128, STAGE = A_B + B_B, LDS = 2 * STAGE; };
template <int BN, int GM = 0, bool SUMSQ = false, class AL, class BL>
__device__ __forceinline__ void gemm_tile2(f32x16 (&acc)[GT2<BN>::MI][2], const AL& al, const BL& bl, int nk, char* lds, float* ssq = nullptr) {
  constexpr int MI = GT2<BN>::MI, STAGE = GT2<BN>::STAGE, A_B = GT2<BN>::A_B, NBI = BN / 64;
  const int tid = opaque_tid(), wid = __builtin_amdgcn_readfirstlane(tid >> 6), lane = tid & 63, r32 = lane & 31, hi = lane >> 5;
  const int wm = BN == 256 ? wid >> 2 : wid >> 1, wn = BN == 256 ? wid & 3 : wid & 1;
  const int srow = 8 * wid + (lane >> 3), sch = (lane & 7) ^ ((srow >> 1) & 7);
  const int swz = ((hi ^ ((r32 >> 1) & 7)) << 4);
  const int aoff = (wm * (MI * 32) + r32) * 128, boff = A_B + (wn * 64 + r32) * 128;
#pragma unroll
  for (int i = 0; i < MI; ++i)
#pragma unroll
    for (int j = 0; j < 2; ++j) acc[i][j] = f32x16{};
  auto stage1 = [&](int s, int kt, int n) {
    char* S = lds + s * STAGE + wid * 1024;
    if (n < 4) __builtin_amdgcn_global_load_lds((const unsigned*)al(srow + 64 * n, kt, sch), (unsigned*)(S + n * 8192), 16, 0, 0);
    else if (n - 4 < NBI) __builtin_amdgcn_global_load_lds((const unsigned*)bl(srow + 64 * (n - 4), kt, sch), (unsigned*)(S + A_B + (n - 4) * 8192), 16, 0, 0);
  };
  auto ldfr = [&](const char* S, int ks, bf16x8 (&fa)[MI], bf16x8 (&fb)[2]) {
    const int co = swz ^ (ks << 5);
#pragma unroll
    for (int i = 0; i < MI; ++i) fa[i] = *(const bf16x8*)(S + aoff + i * 4096 + co);
    fb[0] = *(const bf16x8*)(S + boff + co); fb[1] = *(const bf16x8*)(S + boff + 4096 + co);
  };
#define SB_() __builtin_amdgcn_sched_barrier(0)
  auto mm = [&](const bf16x8 (&fa)[MI], const bf16x8 (&fb)[2], bool pf, int s, int kt, int n0) {
    acc[0][0] = __builtin_amdgcn_mfma_f32_32x32x16_bf16(fa[0], fb[0], acc[0][0], 0, 0, 0);
    acc[0][1] = __builtin_amdgcn_mfma_f32_32x32x16_bf16(fa[0], fb[1], acc[0][1], 0, 0, 0);
    SB_(); if (GM != 1 && pf) stage1(s, kt, n0); SB_();
    acc[1][0] = __builtin_amdgcn_mfma_f32_32x32x16_bf16(fa[1], fb[0], acc[1][0], 0, 0, 0);
    acc[1][1] = __builtin_amdgcn_mfma_f32_32x32x16_bf16(fa[1], fb[1], acc[1][1], 0, 0, 0);
    SB_(); if (GM != 1 && pf) stage1(s, kt, n0 + 1); SB_();
#pragma unroll
    for (int i = 2; i < MI; ++i) {
      acc[i][0] = __builtin_amdgcn_mfma_f32_32x32x16_bf16(fa[i], fb[0], acc[i][0], 0, 0, 0);
      acc[i][1] = __builtin_amdgcn_mfma_f32_32x32x16_bf16(fa[i], fb[1], acc[i][1], 0, 0, 0);
    }
  };
  if (GM != 1) {
#pragma unroll
    for (int n = 0; n < 8; ++n) stage1(0, 0, n); }
  asm volatile("s_waitcnt vmcnt(0)" ::: "memory"); __syncthreads();
  for (int kt = 0; kt < nk; ++kt) {
    const char* S = lds + (kt & 1) * STAGE; const int ns = (kt + 1) & 1; const bool pf = kt + 1 < nk;
    if (GM == 2) { if (pf) {
#pragma unroll
      for (int n = 0; n < 8; ++n) stage1(ns, kt + 1, n); } asm volatile("s_waitcnt vmcnt(0)" ::: "memory"); __syncthreads(); continue; }
    bf16x8 a0[MI], b0[2], a1[MI], b1[2];
    ldfr(S, 0, a0, b0);
    if (SUMSQ) {
      const char* rp_ = S + (tid >> 1) * 128 + (tid & 1) * 64; float s_ = *ssq;
#pragma unroll
      for (int q = 0; q < 4; ++q) { const bf16x8 v_ = *(const bf16x8*)(rp_ + q * 16);
#pragma unroll
        for (int k = 0; k < 8; ++k) { const float f_ = bf2f((bf16_t)v_[k]); s_ = fmaf(f_, f_, s_); } }
      *ssq = s_; }
    ldfr(S, 1, a1, b1); SB_(); mm(a0, b0, pf, ns, kt + 1, 0);
    ldfr(S, 2, a0, b0); SB_(); mm(a1, b1, pf, ns, kt + 1, 2);
    ldfr(S, 3, a1, b1); SB_(); mm(a0, b0, pf, ns, kt + 1, 4);
    SB_(); mm(a1, b1, pf, ns, kt + 1, 6);
    asm volatile("s_waitcnt vmcnt(0)" ::: "memory"); __syncthreads();
  }
#undef SB_
}
template <int GM = 0, class AL, class BL>
__device__ __forceinline__ void gemm_tile8(f32x16 (&acc)[4][2], const AL& al, const BL& bl, int nk, char* lds) {
  constexpr int MI = 4, STAGE = GT2<256>::STAGE, A_B = GT2<256>::A_B;
  const int tid = opaque_tid(), wid = __builtin_amdgcn_readfirstlane(tid >> 6), lane = tid & 63, r32 = lane & 31, hi = lane >> 5;
  const int wm = wid >> 2, wn = wid & 3;
  const int srow = 8 * wid + (lane >> 3), sch = (lane & 7) ^ ((srow >> 1) & 7);
  const int sw = (r32 >> 1) & 7;
  const int aoff = (wm * (MI * 32) + r32) * 128, boff = A_B + (wn * 64 + r32) * 128;
#pragma unroll
  for (int i = 0; i < MI; ++i)
#pragma unroll
    for (int j = 0; j < 2; ++j) acc[i][j] = f32x16{};
  auto stage1 = [&](int s, int kt, int n) {
    char* S = lds + s * STAGE + wid * 1024;
    if (n < 4) __builtin_amdgcn_global_load_lds((const unsigned*)al(srow + 64 * n, kt, sch), (unsigned*)(S + n * 8192), 16, 0, 0);
    else __builtin_amdgcn_global_load_lds((const unsigned*)bl(srow + 64 * (n - 4), kt, sch), (unsigned*)(S + A_B + (n - 4) * 8192), 16, 0, 0);
  };
  auto rd32 = [&](const char* rowp, int ks) { const int c0 = ((4 * ks + 2 * hi) ^ sw) << 4, c1 = ((4 * ks + 2 * hi + 1) ^ sw) << 4;
    const u32x4 lo_ = *(const u32x4*)(rowp + c0), hi_ = *(const u32x4*)(rowp + c1);
    return (i32x8){(int)lo_[0], (int)lo_[1], (int)lo_[2], (int)lo_[3], (int)hi_[0], (int)hi_[1], (int)hi_[2], (int)hi_[3]}; };
#define SB_() __builtin_amdgcn_sched_barrier(0)
#define MF8(A_, B_, C_) C_ = __builtin_amdgcn_mfma_scale_f32_32x32x64_f8f6f4(A_, B_, C_, 0, 0, 0, 0x7f7f7f7f, 0, 0x7f7f7f7f)
  if (GM != 1) {
#pragma unroll
    for (int n = 0; n < 8; ++n) stage1(0, 0, n); }
  asm volatile("s_waitcnt vmcnt(0)" ::: "memory"); __syncthreads();
  for (int kt = 0; kt < nk; ++kt) {
    const char* S = lds + (kt & 1) * STAGE; const int ns = (kt + 1) & 1; const bool pf = kt + 1 < nk;
    i32x8 fa[MI], fb0[2], fb1[2];
#pragma unroll
    for (int i = 0; i < MI; ++i) fa[i] = rd32(S + aoff + i * 4096, 0);
    fb0[0] = rd32(S + boff, 0); fb0[1] = rd32(S + boff + 4096, 0); fb1[0] = rd32(S + boff, 1); fb1[1] = rd32(S + boff + 4096, 1);
    SB_();
#pragma unroll
    for (int i = 0; i < MI; ++i) { MF8(fa[i], fb0[0], acc[i][0]); MF8(fa[i], fb0[1], acc[i][1]); SB_(); fa[i] = rd32(S + aoff + i * 4096, 1); if (GM != 1 && pf) stage1(ns, kt + 1, i); SB_(); }
#pragma unroll
    for (int i = 0; i < MI; ++i) { MF8(fa[i], fb1[0], acc[i][0]); MF8(fa[i], fb1[1], acc[i][1]); SB_(); if (GM != 1 && pf) stage1(ns, kt + 1, 4 + i); SB_(); }
    asm volatile("s_waitcnt vmcnt(0)" ::: "memory"); __syncthreads();
  }
#undef MF8
#undef SB_
}
struct HeadLoader8 {
  const unsigned char* base;
  __device__ __forceinline__ const unsigned char* operator()(int r, int kt, int c) const { return base + ((size_t)kt * 4096 + r) * 128 + c * 16; }
};
struct RowLoader8 {
  const unsigned char* base; int ld;
  __device__ __forceinline__ const unsigned char* operator()(int r, int kt, int c) const { return base + (size_t)r * ld + kt * 128 + c * 16; }
};
struct RowLoader {
  const bf16_t* base; int ld;
  __device__ __forceinline__ const bf16_t* operator()(int r, int kt, int c) const { return base + (size_t)r * ld + kt * 64 + c * 8; }
};
struct HeadLoader {
  const bf16_t* base; int rs;
  __device__ __forceinline__ const bf16_t* operator()(int r, int kt, int c) const { return base + ((size_t)(kt >> 1) * 4096 + r) * rs + (kt & 1) * 64 + c * 8; }
};

__device__ __forceinline__ float dpp_xor1(float v) { return __uint_as_float((unsigned)__builtin_amdgcn_update_dpp(0, (int)__float_as_uint(v), 0xB1, 0xF, 0xF, true)); }
template <int MI, class G>
__device__ __forceinline__ void tile_stage(char* wl, int lane, G get) {
  asm volatile("" : "+v"(lane));
  const int c = lane & 31, hh = lane >> 5; const bool odd = (c & 1) != 0;
  char* lp = wl + ((odd ? 1 : 0) + 4 * hh) * 128 + ((c >> 3) << 4) + ((c & 6) << 1);
  const int oj0 = odd ? 64 : 0, oj1 = 64 - oj0;
#pragma unroll
  for (int i = 0; i < MI; ++i)
#pragma unroll
    for (int rq = 0; rq < 4; ++rq)
#pragma unroll
      for (int kp = 0; kp < 2; ++kp) {
        const int r = rq * 4 + 2 * kp, rowc = i * 32 + 8 * rq + 2 * kp;
        asm volatile("" ::: "memory");
        float a1, a2, b1, b2; get(i, r, a1, a2); get(i, r + 1, b1, b2);
        { const float t = dpp_xor1(odd ? a1 : b1); *(unsigned*)(lp + rowc * 128 + oj0) = cvtpk(odd ? t : a1, odd ? b1 : t); }
        { const float t = dpp_xor1(odd ? a2 : b2); *(unsigned*)(lp + rowc * 128 + oj1) = cvtpk(odd ? t : a2, odd ? b2 : t); }
      }
  asm volatile("s_waitcnt lgkmcnt(0)" ::: "memory");
}
__device__ __forceinline__ const char* tile_rd_ptr(const char* wl, int lane) { asm volatile("" : "+v"(lane)); return wl + (lane >> 3) * 128 + (((lane & 7) ^ (((lane >> 3) & 1) << 2)) << 4); }
template <int MI, int LD, bool DOST = true>
__device__ __forceinline__ void tile_store_bf16(const char* wl, int lane, bf16_t* dst) {
  if (!DOST) return;
  asm volatile("" : "+v"(lane));
  const char* rp = tile_rd_ptr(wl, lane); bf16_t* d = dst + (size_t)(lane >> 3) * LD + (lane & 7) * 8;
#pragma unroll
  for (int it = 0; it < 4 * MI; ++it) *(bf16x8*)(d + (size_t)it * 8 * LD) = *(const bf16x8*)(rp + it * 1024);
}

template <int MI, int LD, bool DOST = true>
__device__ __forceinline__ void tile_store_fp8(const char* wl, int lane, unsigned char* dst) {
  if (!DOST) return;
  asm volatile("" : "+v"(lane));
  const char* rp = tile_rd_ptr(wl, lane); unsigned char* d = dst + (size_t)(lane >> 3) * LD + (lane & 7) * 8;
#pragma unroll
  for (int it = 0; it < 4 * MI; ++it) { const u32x4 w = *(const u32x4*)(rp + it * 1024); u32x2 o;
    o[0] = pk4_fp8(__uint_as_float(w[0] << 16), __uint_as_float(w[0] & 0xffff0000u), __uint_as_float(w[1] << 16), __uint_as_float(w[1] & 0xffff0000u));
    o[1] = pk4_fp8(__uint_as_float(w[2] << 16), __uint_as_float(w[2] & 0xffff0000u), __uint_as_float(w[3] << 16), __uint_as_float(w[3] & 0xffff0000u));
    *(u32x2*)(d + (size_t)it * 8 * LD) = o; }
}
template <int GM_ = 0>
__device__ void g1_phase(const Params& p, char* lds) {
  const unsigned char* hmod = p.ws + OFF_HMOD; const unsigned char* wt = p.ws + OFF_WINT; const float* rope = (const float*)(p.ws + OFF_ROPE);
  unsigned char* QA = p.ws + OFF_QA; unsigned char* KA = p.ws + OFF_KA; unsigned char* VAT = p.ws + OFF_VAT; unsigned char* KR = p.ws + OFF_KROPE;
  bf16_t* QL = (bf16_t*)(p.ws + OFF_QLAT); bf16_t* KVL = (bf16_t*)(p.ws + OFF_KVLAT); unsigned char* GT = (unsigned char*)p.out;
  const int tid = opaque_tid(), wid = __builtin_amdgcn_readfirstlane(tid >> 6), lane = tid & 63, r32 = lane & 31, hi = lane >> 5, wm = wid >> 2, wn = wid & 3;
  const int G = gridDim.x, nx = (G % 8 == 0) ? 8 : 1, xg = blockIdx.x % nx, lb = blockIdx.x / nx, nlb = G / nx;
  float* ropel = (float*)(lds + GT2<256>::LDS + 1024);
  for (int i = tid; i < 2048; i += NTHR) ropel[i] = rope[i];
  __syncthreads();
  const int nlat = 128 / nx, nctx = 8 / nx, njobs = nlat * 23 + nctx * 10;
  for (int j = lb; j < njobs; j += nlb) {
    int mt, nt;
    if (j < nlat * 23) { mt = xg + nx * (j / 23); nt = j % 23; } else { const int jj = j - nlat * 23; mt = 128 + xg + nx * (jj / 10); nt = 13 + jj % 10; }
    const bool isctx = mt >= 128;
    const int b = isctx ? mt - 128 : mt >> 4, pos0 = isctx ? 0 : (mt & 15) * 256;
    f32x16 acc[4][2];
    RowLoader8 al{hmod + (size_t)mt * 256 * 1024, 1024}, bl{wt + (size_t)nt * 256 * 1024, 1024};
    gemm_tile8(acc, al, bl, 8, lds);
#pragma unroll
    for (int i = 0; i < 4; ++i)
#pragma unroll
      for (int jn = 0; jn < 2; ++jn) acc[i][jn] *= (1.f / W8S);
    if (GM_ == 1) { asm volatile("" :: "v"(acc[0][0]), "v"(acc[0][1]), "v"(acc[1][0]), "v"(acc[1][1])); asm volatile("" :: "v"(acc[2][0]), "v"(acc[2][1]), "v"(acc[3][0]), "v"(acc[3][1])); __syncthreads(); continue; }
    const int col0 = nt * 256 + wn * 64;
    const int rw0 = wm * 128;
    const int keyb = isctx ? 0 : 256 + pos0;
    char* wl = lds + wid * 16384;
    int ln = lane; asm volatile("" : "+v"(ln));
    const int r32e = ln & 31, hie = ln >> 5; const bool lo = r32e < 16;
    const float* rp = ropel + (lo ? (((pos0 + rw0) >> 6) << 5) : 4 * hie * 32) + (r32e & 15) * 2;
    const int sA = lo ? 32 : 0, sB = lo ? 0 : 32;
    auto plain = [&](int i, int r, float& x1, float& x2) { x1 = acc[i][0][r]; x2 = acc[i][1][r]; };
    auto sigm = [&](int i, int r, float& x1, float& x2) { x1 = sigmoid_f(acc[i][0][r]); x2 = sigmoid_f(acc[i][1][r]); };
    auto rot = [&](int i, int r, float& x1, float& x2) {
      const int rr = i * 32 + (r & 3) + 8 * (r >> 2); const float* e = rp + (rr >> 6) * sA + (rr & 63) * sB; const float cs = e[0], sn = e[1];
      const float a = acc[i][0][r], bq = acc[i][1][r]; x1 = a * cs - bq * sn; x2 = a * sn + bq * cs; };
    if (col0 < 1024) {
      const int h = col0 >> 7, mp = (col0 >> 6) & 1;
      constexpr float QS = 0.125f * 1.4426950408889634f;
      auto rotq = [&](int i, int r, float& x1, float& x2) { float a, bq; rot(i, r, a, bq); x1 = a * QS; x2 = bq * QS; };
      tile_stage<4>(wl, lane, rotq); tile_store_fp8<4, 128, GM_ != 2>(wl, lane, QA + ((size_t)(b * 8 + h) * 4096 + pos0 + rw0) * 128 + mp * 64);
    } else if (col0 < 1280) {
      tile_stage<4>(wl, lane, plain); tile_store_bf16<4, 256, GM_ != 2>(wl, lane, QL + (size_t)(mt * 256 + rw0) * 256 + (col0 - 1024));
    } else if (col0 < 3328) {
      tile_stage<4>(wl, lane, sigm); tile_store_fp8<4, 2048, GM_ != 2>(wl, lane, GT + (size_t)(mt * 256 + rw0) * 2048 + (col0 - 1280));
    } else if (col0 < 4352) {
      const int cc = col0 - 3328, h = cc >> 7, mp = (cc >> 6) & 1;
      if (isctx) tile_stage<4>(wl, lane, plain); else tile_stage<4>(wl, lane, rot);
      tile_store_fp8<4, 128, GM_ != 2>(wl, lane, KA + ((size_t)(b * 8 + h) * NKEY + keyb + rw0) * 128 + mp * 64);
    } else if (col0 < 5376) {
      const int cc = col0 - 4352;
      if (GM_ != 2) {
        unsigned char* vb_ = VAT + ((size_t)(b * 8 + (cc >> 7)) * 128 + (cc & 127) + r32e) * NKEY + (keyb + rw0) + 32 * hie;
#pragma unroll
        for (int jn = 0; jn < 2; ++jn)
#pragma unroll
          for (int t2 = 0; t2 < 2; ++t2) { u32x4 w0_, w1_;
#pragma unroll
            for (int q = 0; q < 4; ++q) { w0_[q] = pk4_fp8(acc[2 * t2][jn][4 * q], acc[2 * t2][jn][4 * q + 1], acc[2 * t2][jn][4 * q + 2], acc[2 * t2][jn][4 * q + 3]);
              w1_[q] = pk4_fp8(acc[2 * t2 + 1][jn][4 * q], acc[2 * t2 + 1][jn][4 * q + 1], acc[2 * t2 + 1][jn][4 * q + 2], acc[2 * t2 + 1][jn][4 * q + 3]); }
            unsigned char* d_ = vb_ + (size_t)(32 * jn) * NKEY + 64 * t2; *(u32x4*)d_ = w0_; *(u32x4*)(d_ + 16) = w1_; }
      }
    } else if (col0 < 5632) {
      tile_stage<4>(wl, lane, plain); tile_store_bf16<4, 256, GM_ != 2>(wl, lane, KVL + ((size_t)b * NKEY + keyb + rw0) * 256 + (col0 - 5376));
    } else if (col0 < IN_COLS) {
      if (isctx) tile_stage<4>(wl, lane, plain); else tile_stage<4>(wl, lane, rot);
      tile_store_fp8<4, 64, GM_ != 2>(wl, lane, KR + ((size_t)b * NKEY + keyb + rw0) * 64);
    }
    __syncthreads();
  }
}

__device__ void g2_phase(const Params& p, char* lds) {
  const bf16_t* QL = (const bf16_t*)(p.ws + OFF_QLAT); const bf16_t* KVL = (const bf16_t*)(p.ws + OFF_KVLAT);
  const bf16_t* WQ = (const bf16_t*)(p.ws + OFF_WQUPT); const bf16_t* WKV = (const bf16_t*)(p.ws + OFF_WKVUPT); const float* rope = (const float*)(p.ws + OFF_ROPE);
  unsigned char* QB = p.ws + OFF_QB; unsigned char* KN = p.ws + OFF_KNOPE; unsigned char* VBT = p.ws + OFF_VBT;
  float* rstd_l = (float*)(lds + GT2<256>::LDS);
  float* ropel = (float*)(lds + GT2<256>::LDS + 1024);
  const int tid = opaque_tid(), wid = __builtin_amdgcn_readfirstlane(tid >> 6), lane = tid & 63, r32 = lane & 31, hi = lane >> 5, wm = wid >> 2, wn = wid & 3;
  const int G = gridDim.x, nx = (G % 8 == 0) ? 8 : 1, xg = blockIdx.x % nx, lb = blockIdx.x / nx, nlb = G / nx;
  const int na = (128 / nx) * 6, nb = (136 / nx) * 8;
  for (int i = opaque_tid(); i < 2048; i += NTHR) ropel[i] = rope[i];
  __syncthreads();
  for (int j = lb; j < na + nb; j += nlb) {
    const bool isq = j < na; int mt, nt;
    if (isq) { mt = xg + nx * (j / 6); nt = j % 6; } else { const int jj = j - na; mt = xg + nx * (jj >> 3); nt = jj & 7; }
    const bf16_t* Ab = (isq ? QL : KVL) + (size_t)mt * 256 * 256;
    f32x16 acc[4][2]; float ssq = 0.f;
    RowLoader al{Ab, 256}, bl{(isq ? WQ : WKV) + (size_t)nt * 256 * 256, 256};
    gemm_tile2<256, 0, true>(acc, al, bl, 4, lds, &ssq);
    ssq += __shfl_xor(ssq, 1); if ((tid & 1) == 0) rstd_l[tid >> 1] = rsqrtf(ssq * (1.f / 256.f) + EPS);
    __syncthreads();
    const int rw0 = wm * 128;
    int ln = lane; asm volatile("" : "+v"(ln));
    const int r32e = ln & 31, hie = ln >> 5; const bool lo = r32e < 16;
    const float* rsp = rstd_l + rw0 + 4 * hie;
    char* wl = lds + wid * 16384;
    auto scaled = [&](int i, int r, float& x1, float& x2) { const float s = rsp[i * 32 + (r & 3) + 8 * (r >> 2)]; x1 = acc[i][0][r] * s; x2 = acc[i][1][r] * s; };
    if (isq) {
      const int b = mt >> 4, pos0 = (mt & 15) * 256, gidx = nt * 4 + wn, h = gidx / 3, part = gidx % 3;
      const float* rp = ropel + (lo ? (((pos0 + rw0) >> 6) << 5) : 4 * hie * 32) + (r32e & 15) * 2;
      const int sA = lo ? 32 : 0, sB = lo ? 0 : 32;
      auto rot = [&](int i, int r, float& x1, float& x2) {
        const int rr = i * 32 + (r & 3) + 8 * (r >> 2); const float* e = rp + (rr >> 6) * sA + (rr & 63) * sB; const float cs = e[0], sn = e[1], s = rsp[rr];
        const float a = acc[i][0][r] * s, bq = acc[i][1][r] * s; x1 = a * cs - bq * sn; x2 = a * sn + bq * cs; };
      if (part == 2) tile_stage<4>(wl, lane, rot); else tile_stage<4>(wl, lane, scaled);
      tile_store_fp8<4, 192>(wl, lane, QB + ((size_t)(b * 8 + h) * 4096 + pos0 + rw0) * 192 + part * 64);
    } else {
      const int b = mt / 17, key0 = (mt % 17) * 256, col0 = nt * 256 + wn * 64, h = col0 >> 8, part = (col0 >> 7) & 1;
      if (part == 0) { tile_stage<4>(wl, lane, scaled); tile_store_fp8<4, 128>(wl, lane, KN + ((size_t)(b * 8 + h) * NKEY + key0 + rw0) * 128 + (col0 & 127)); }
      else {
        unsigned char* vb_ = VBT + ((size_t)(b * 8 + h) * 128 + (col0 & 127) + r32e) * NKEY + (key0 + rw0) + 32 * hie;
#pragma unroll
        for (int jn = 0; jn < 2; ++jn)
#pragma unroll
          for (int t2 = 0; t2 < 2; ++t2) { u32x4 w0_, w1_;
#pragma unroll
            for (int q = 0; q < 4; ++q) { float e_[8];
#pragma unroll
              for (int k = 0; k < 4; ++k) { const int r = 4 * q + k, rr = (r & 3) + 8 * (r >> 2); e_[k] = acc[2 * t2][jn][r] * rsp[(2 * t2) * 32 + rr]; e_[4 + k] = acc[2 * t2 + 1][jn][r] * rsp[(2 * t2 + 1) * 32 + rr]; }
              w0_[q] = pk4_fp8(e_[0], e_[1], e_[2], e_[3]); w1_[q] = pk4_fp8(e_[4], e_[5], e_[6], e_[7]); }
            unsigned char* d_ = vb_ + (size_t)(32 * jn) * NKEY + 64 * t2; *(u32x4*)d_ = w0_; *(u32x4*)(d_ + 16) = w1_; }
      }
    }
    __syncthreads();
  }
}

#define SBAR() __builtin_amdgcn_sched_barrier(0)
constexpr int A_SHV = 64 * 128 * 2;
constexpr float ATT_THR = 5.5f;
template <int SCALE_ID> struct AttScale;
template <> struct AttScale<0> { static constexpr float v = 0.125f; };
template <> struct AttScale<1> { static constexpr float v = 0.07216878364870322f; };
template <int SID>
__device__ __forceinline__ void partialSM(f32x16& p0, f32x16& p1, float& m_reg, float& mn, float& alpha) {
  constexpr float SC = AttScale<SID>::v; constexpr float C = SC * 1.4426950408889634f;
  float pmax = p0[0];
#pragma unroll
  for (int r = 1; r < 16; ++r) pmax = fmaxf(pmax, p0[r]);
#pragma unroll
  for (int r = 0; r < 16; ++r) pmax = fmaxf(pmax, p1[r]);
  { auto rr = __builtin_amdgcn_permlane32_swap(__float_as_uint(pmax), __float_as_uint(pmax), false, false);
    pmax = fmaxf(__uint_as_float(rr[0]), __uint_as_float(rr[1])); }
  if (__builtin_expect(__all(pmax - m_reg <= ATT_THR / SC), 1)) { mn = m_reg; alpha = 1.f; }
  else { mn = fmaxf(m_reg, pmax); alpha = __builtin_amdgcn_exp2f((m_reg - mn) * C); m_reg = mn; }
  const float mnC = -mn * C;
#pragma unroll
  for (int r = 0; r < 16; ++r) p0[r] = fmaf(p0[r], C, mnC);
#pragma unroll
  for (int r = 0; r < 16; ++r) p1[r] = fmaf(p1[r], C, mnC);
#pragma unroll
  for (int r = 0; r < 16; ++r) p0[r] = __builtin_amdgcn_exp2f(p0[r]);
}
template <bool FIRST>
__device__ __forceinline__ void partialSM_c(f32x16& p0, f32x16& p1, float& M, f32x16& cinit, float& alpha) {
  constexpr float THRL = ATT_THR * 1.4426950408889634f;
  float pmax = p0[0];
#pragma unroll
  for (int r = 1; r < 16; ++r) pmax = fmaxf(pmax, p0[r]);
#pragma unroll
  for (int r = 0; r < 16; ++r) pmax = fmaxf(pmax, p1[r]);
  { auto rr = __builtin_amdgcn_permlane32_swap(__float_as_uint(pmax), __float_as_uint(pmax), false, false);
    pmax = fmaxf(__uint_as_float(rr[0]), __uint_as_float(rr[1])); }
  if (!FIRST && __builtin_expect(__all(pmax <= THRL), 1)) { alpha = 1.f; }
  else { const float d = FIRST ? pmax : fmaxf(pmax, 0.f); alpha = FIRST ? 1.f : __builtin_amdgcn_exp2f(-d); M += d;
#pragma unroll
    for (int r = 0; r < 16; ++r) { p0[r] -= d; p1[r] -= d; }
#pragma unroll
    for (int r = 0; r < 16; ++r) cinit[r] = -M; }
#pragma unroll
  for (int r = 0; r < 16; ++r) p0[r] = __builtin_amdgcn_exp2f(p0[r]);
}
__device__ __forceinline__ void finishSM(f32x16& p0, f32x16& p1, float alpha, float& l_reg, bf16x8& pa0, bf16x8& pa1, bf16x8& pa2, bf16x8& pa3) {
#pragma unroll
  for (int r = 0; r < 16; ++r) p1[r] = __builtin_amdgcn_exp2f(p1[r]);
  float ps = 0;
#pragma unroll
  for (int r = 0; r < 16; ++r) ps += p0[r];
#pragma unroll
  for (int r = 0; r < 16; ++r) ps += p1[r];
  { auto rr = __builtin_amdgcn_permlane32_swap(__float_as_uint(ps), __float_as_uint(ps), false, false);
    ps = __uint_as_float(rr[0]) + __uint_as_float(rr[1]); }
  l_reg = l_reg * alpha + ps;
#define PK4(P, BASE, OUT) do { unsigned a0 = cvtpk(P[BASE + 0], P[BASE + 1]), a1 = cvtpk(P[BASE + 2], P[BASE + 3]);   \
    unsigned b0 = cvtpk(P[BASE + 4], P[BASE + 5]), b1 = cvtpk(P[BASE + 6], P[BASE + 7]);                              \
    auto r0 = __builtin_amdgcn_permlane32_swap(a0, b0, false, false); auto r1 = __builtin_amdgcn_permlane32_swap(a1, b1, false, false); \
    u32x4 w = {r0[0], r1[0], r0[1], r1[1]}; OUT = *reinterpret_cast<bf16x8*>(&w); } while (0)
  PK4(p0, 0, pa0); PK4(p0, 8, pa1); PK4(p1, 0, pa2); PK4(p1, 8, pa3);
#undef PK4
}
__device__ __forceinline__ int v_st(int k, int c) { const int kk = (k & ~0xC) | ((k & 4) << 1) | ((k & 8) >> 1); return ((kk >> 3) * 4 + (c >> 5)) * 512 + ((kk & 7) * 32 + (c & 31)) * 2; }
__device__ __forceinline__ int v_rd_base(int lane) { return ((lane & 3) << 3) | (((lane >> 2) & 3) << 6) | (((lane >> 4) & 1) << 5) | (((lane >> 5) & 1) << 8); }
constexpr int v_rd_off(int d0, int ks, int half) { return d0 * 512 + ks * 4096 + half * 2048; }
template <int OFF> __device__ __forceinline__ s16x4 tr_read(int vb) {
  s16x4 r; asm volatile("ds_read_b64_tr_b16 %0, %1 offset:%2" : "=&v"(r) : "v"(vb), "i"(OFF) : "memory"); return r;
}
template <int D0> __device__ __forceinline__ void pv_one(f32x16& od, int vb, bf16x8 pa0, bf16x8 pa1, bf16x8 pa2, bf16x8 pa3) {
  const s16x4 l0 = tr_read<v_rd_off(D0, 0, 0)>(vb), h0 = tr_read<v_rd_off(D0, 0, 1)>(vb), l1 = tr_read<v_rd_off(D0, 1, 0)>(vb), h1 = tr_read<v_rd_off(D0, 1, 1)>(vb);
  const s16x4 l2 = tr_read<v_rd_off(D0, 2, 0)>(vb), h2 = tr_read<v_rd_off(D0, 2, 1)>(vb), l3 = tr_read<v_rd_off(D0, 3, 0)>(vb), h3 = tr_read<v_rd_off(D0, 3, 1)>(vb);
  asm volatile("s_waitcnt lgkmcnt(0)" ::: "memory"); SBAR();
#define PK(L, H) (bf16x8){L[0], L[1], L[2], L[3], H[0], H[1], H[2], H[3]}
  od = __builtin_amdgcn_mfma_f32_32x32x16_bf16(pa0, PK(l0, h0), od, 0, 0, 0);
  od = __builtin_amdgcn_mfma_f32_32x32x16_bf16(pa1, PK(l1, h1), od, 0, 0, 0);
  od = __builtin_amdgcn_mfma_f32_32x32x16_bf16(pa2, PK(l2, h2), od, 0, 0, 0);
  od = __builtin_amdgcn_mfma_f32_32x32x16_bf16(pa3, PK(l3, h3), od, 0, 0, 0);
#undef PK
}
__device__ __forceinline__ void pv_d0(f32x16* o, int vb, bf16x8 pa0, bf16x8 pa1, bf16x8 pa2, bf16x8 pa3) {
  pv_one<0>(o[0], vb, pa0, pa1, pa2, pa3); pv_one<1>(o[1], vb, pa0, pa1, pa2, pa3); pv_one<2>(o[2], vb, pa0, pa1, pa2, pa3); pv_one<3>(o[3], vb, pa0, pa1, pa2, pa3);
}
template <bool MLA, bool STORE = true, int GH = 0>
__device__ __forceinline__ void attn_job(bf16_t* Qb, const bf16_t* __restrict__ Kh, const bf16_t* __restrict__ Kr, const bf16_t* __restrict__ Vh, float lam, const float* __restrict__ subln, char* lds) {
  constexpr int NQ = MLA ? 12 : 4, KROW = MLA ? 384 : 256, SHK = 64 * KROW, LDQ = MLA ? 192 : 128, SID = MLA ? 1 : 0;
  constexpr int NQR = MLA ? 8 : 4;
  constexpr int L_V = 0, L_K = 3 * A_SHV, L_W = L_K + 2 * SHK, L_Q = L_W + 2048;
  const int tid = opaque_tid(), wid = tid >> 6, lane = tid & 63, r32 = lane & 31, hi = lane >> 5;
  const int mp = MLA ? 0 : (wid >> 2), wrow = MLA ? wid * 32 : (wid & 3) * 32;
  char* V_lds = lds + L_V; char* K_lds = lds + L_K;
  float* wsf = (float*)(lds + L_W) + wid * 64; float* li_l = wsf; float* al_l = wsf + 32;
  char* qsp = lds + L_Q + wid * 4096 + lane * 16;
  float m_reg = MLA ? -1e30f : 0.f, l_reg = 0; f32x16 o[4] = {}; bf16x8 qr[NQR];
  f32x16 cinit = {};
  { const bf16_t* Qw = Qb + (size_t)(wrow + r32) * LDQ + mp * 64 + hi * 8;
#pragma unroll
    for (int d0 = 0; d0 < NQR; ++d0) qr[d0] = *(const bf16x8*)(Qw + d0 * 16);
    if (MLA) {
#pragma unroll
      for (int d0 = NQR; d0 < 12; ++d0) *(bf16x8*)(qsp + (d0 - NQR) * 1024) = *(const bf16x8*)(Qw + d0 * 16); } }
  const bf16_t* vsrc[2]; const bf16_t* ksrc[MLA ? 3 : 2]; bool kr_[MLA ? 3 : 2];
#pragma unroll
  for (int i = 0; i < 2; ++i) { const int sub = 2 * (wid * 2 + i) + (lane >> 5), kk = (sub >> 2) * 8 + ((lane & 31) >> 2), k = (kk & ~0xC) | ((kk & 4) << 1) | ((kk & 8) >> 1);
    vsrc[i] = Vh + (size_t)k * 128 + (sub & 3) * 32 + (lane & 3) * 8; }
#pragma unroll
  for (int i = 0; i < (MLA ? 3 : 2); ++i) { const int off = (wid * (MLA ? 3 : 2) + i) * 1024 + lane * 16, row = off / KROW, ch = ((off % KROW) >> 4) ^ (row & 7);
    if (MLA && ch >= 16) { ksrc[i] = Kr + (size_t)row * 64 + (ch - 16) * 8; kr_[i] = true; } else { ksrc[i] = Kh + (size_t)row * 128 + ch * 8; kr_[i] = false; } }
  auto issue = [&](int tile, int kb, int vbuf) {
    if (GH & 8) return;
#pragma unroll
    for (int i = 0; i < 2; ++i) __builtin_amdgcn_global_load_lds((const unsigned*)(vsrc[i] + (size_t)tile * 64 * 128), (unsigned*)(V_lds + vbuf * A_SHV + (wid * 2 + i) * 1024), 16, 0, 0);
#pragma unroll
    for (int i = 0; i < (MLA ? 3 : 2); ++i) __builtin_amdgcn_global_load_lds((const unsigned*)(ksrc[i] + (size_t)tile * 64 * (kr_[i] ? 64 : 128)), (unsigned*)(K_lds + kb * SHK + (wid * (MLA ? 3 : 2) + i) * 1024), 16, 0, 0);
  };
  const int vb0 = (int)(uintptr_t)V_lds + v_rd_base(lane);
  const int kq0 = r32 * KROW, kxor = (r32 & 7) << 4;
#define TBAR() do { asm volatile("s_waitcnt vmcnt(0)" ::: "memory"); __syncthreads(); } while (0)
#define RESC(a) do { if (__any((a) < 1.f)) { if (hi == 0) al_l[r32] = (a); asm volatile("s_waitcnt lgkmcnt(0)" ::: "memory"); \
    _Pragma("unroll") for (int d = 0; d < 4; ++d) _Pragma("unroll") for (int r = 0; r < 16; ++r) o[d][r] *= al_l[crow(r, hi)]; } } while (0)
#define QKT(P0, P1, bb) do { P0 = f32x16{}; P1 = f32x16{}; if (GH & 4) { asm volatile("" : "+v"(P0), "+v"(P1)); break; } const char* Ks = K_lds + (bb) * SHK;                                                     \
    _Pragma("unroll") for (int d0 = 0; d0 < NQ; ++d0) { const int cb = ((mp * 64 + d0 * 16 + hi * 8) * 2) ^ kxor;                                       \
      const bf16x8 b0 = *(const bf16x8*)(Ks + kq0 + cb), b1 = *(const bf16x8*)(Ks + kq0 + 32 * KROW + cb);                                          \
      const bf16x8 qv = d0 < NQR ? qr[d0 < NQR ? d0 : 0] : *(const bf16x8*)(qsp + (d0 - NQR) * 1024);                                                  \
      P0 = __builtin_amdgcn_mfma_f32_32x32x16_bf16(b0, qv, (!MLA && d0 == 0) ? cinit : P0, 0, 0, 0); P1 = __builtin_amdgcn_mfma_f32_32x32x16_bf16(b1, qv, (!MLA && d0 == 0) ? cinit : P1, 0, 0, 0); } } while (0)
#define PSM(p0_, p1_, m_, mn_, al_) do { if (GH & 1) { mn_ = m_; al_ = 1.f; } else if (MLA) partialSM<SID>(p0_, p1_, m_, mn_, al_); else partialSM_c<false>(p0_, p1_, m_, cinit, al_); } while (0)
#define PSM1(p0_, p1_, m_, mn_, al_) do { if (GH & 1) { mn_ = m_; al_ = 1.f; } else if (MLA) partialSM<SID>(p0_, p1_, m_, mn_, al_); else partialSM_c<true>(p0_, p1_, m_, cinit, al_); } while (0)
#define FSM(p0_, p1_, al_, l_, a0_, a1_, a2_, a3_) do { if (GH & 1) { u32x4 w0_ = {__float_as_uint(p0_[0]), __float_as_uint(p0_[5]), __float_as_uint(p0_[10]), __float_as_uint(p0_[15])}, w1_ = {__float_as_uint(p1_[0]), __float_as_uint(p1_[5]), __float_as_uint(p1_[10]), __float_as_uint(p1_[15])}; \
    a0_ = *reinterpret_cast<bf16x8*>(&w0_); a1_ = *reinterpret_cast<bf16x8*>(&w1_); a2_ = a0_; a3_ = a1_; l_ += al_; } else finishSM(p0_, p1_, al_, l_, a0_, a1_, a2_, a3_); } while (0)
#define PVD(o_, vb_, a0_, a1_, a2_, a3_) do { if (GH & 2) { asm volatile("" :: "v"(a0_), "v"(a1_), "v"(a2_), "v"(a3_)); } else pv_d0(o_, vb_, a0_, a1_, a2_, a3_); } while (0)
  f32x16 pA0, pA1, pB0, pB1; float mnA, mnB, alA, alB; bf16x8 pa0, pa1, pa2, pa3; constexpr int NT = NKEY / 64;
  if (__builtin_amdgcn_readfirstlane(wid) >= 4) __builtin_amdgcn_s_setprio(1);
  issue(0, 0, 0); TBAR(); issue(1, 1, 1);
  QKT(pA0, pA1, 0); PSM1(pA0, pA1, m_reg, mnA, alA);
  int vcur = 0, vnext = 2;
  for (int j = 1; j + 1 < NT; j += 2) {
    TBAR(); issue(j + 1, 0, vnext);
    SBAR(); QKT(pB0, pB1, 1);
    FSM(pA0, pA1, alA, l_reg, pa0, pa1, pa2, pa3); SBAR();
    PVD(o, vb0 + vcur * A_SHV, pa0, pa1, pa2, pa3); PSM(pB0, pB1, m_reg, mnB, alB);
    RESC(alB);
    vcur = vcur == 2 ? 0 : vcur + 1; vnext = vnext == 2 ? 0 : vnext + 1;
    TBAR(); if (j + 2 < NT) issue(j + 2, 1, vnext);
    SBAR(); QKT(pA0, pA1, 0);
    FSM(pB0, pB1, alB, l_reg, pa0, pa1, pa2, pa3); SBAR();
    PVD(o, vb0 + vcur * A_SHV, pa0, pa1, pa2, pa3); PSM(pA0, pA1, m_reg, mnA, alA);
    RESC(alA);
    vcur = vcur == 2 ? 0 : vcur + 1; vnext = vnext == 2 ? 0 : vnext + 1;
  }
  TBAR();
  SBAR(); QKT(pB0, pB1, 1);
  FSM(pA0, pA1, alA, l_reg, pa0, pa1, pa2, pa3); SBAR();
  PVD(o, vb0 + vcur * A_SHV, pa0, pa1, pa2, pa3); PSM(pB0, pB1, m_reg, mnB, alB);
  RESC(alB);
  vcur = vcur == 2 ? 0 : vcur + 1;
  FSM(pB0, pB1, alB, l_reg, pa0, pa1, pa2, pa3); SBAR();
  PVD(o, vb0 + vcur * A_SHV, pa0, pa1, pa2, pa3);
  __builtin_amdgcn_s_setprio(0);
  if (hi == 0) li_l[r32] = l_reg; asm volatile("s_waitcnt lgkmcnt(0)" ::: "memory");
  float rli[16];
#pragma unroll
  for (int r = 0; r < 16; ++r) rli[r] = __builtin_amdgcn_rcpf(li_l[crow(r, hi)]);
  bf16_t* Ow = Qb + (size_t)(wrow + 4 * hi) * LDQ + r32;
  if (MLA) {
#pragma unroll
    for (int r = 0; r < 16; ++r) { const int rr = (r & 3) + 8 * (r >> 2);
#pragma unroll
      for (int d0 = 0; d0 < 4; ++d0) { const bf16_t v = f2bf(o[d0][r] * rli[r]); if (STORE) Ow[rr * LDQ + d0 * 32] = v; else asm volatile("" :: "v"(v)); } }
    __syncthreads();
  } else {
    __syncthreads();
    float* X = (float*)lds + (size_t)((wid & 3) * 32 + 4 * hi) * 128 + r32;
    if (mp == 1) {
#pragma unroll
      for (int r = 0; r < 16; ++r) { const int rr = (r & 3) + 8 * (r >> 2);
#pragma unroll
        for (int d0 = 0; d0 < 4; ++d0) X[rr * 128 + d0 * 32] = lam * o[d0][r] * rli[r]; }
    }
    __syncthreads();
    if (mp == 0) {
      float g[4];
#pragma unroll
      for (int d0 = 0; d0 < 4; ++d0) g[d0] = subln[d0 * 32 + r32] * (1.f - LAMBDA_INIT);
#pragma unroll
      for (int r = 0; r < 16; ++r) { const int rr = (r & 3) + 8 * (r >> 2); float od[4]; float s = 0.f;
#pragma unroll
        for (int d0 = 0; d0 < 4; ++d0) { od[d0] = o[d0][r] * rli[r] - X[rr * 128 + d0 * 32]; s = fmaf(od[d0], od[d0], s); }
        s += __shfl_xor(s, 1); s += __shfl_xor(s, 2); s += __shfl_xor(s, 4); s += __shfl_xor(s, 8); s += __shfl_xor(s, 16);
        const float rs = rsqrtf(s * (1.f / 128.f) + EPS);
#pragma unroll
        for (int d0 = 0; d0 < 4; ++d0) { const bf16_t v = f2bf(od[d0] * rs * g[d0]); if (STORE) Ow[rr * LDQ + d0 * 32] = v; else asm volatile("" :: "v"(v)); } }
    }
    __syncthreads();
  }
#undef TBAR
#undef RESC
#undef QKT
#undef PSM
#undef PSM1
#undef FSM
#undef PVD
}
template <bool STORE = true>
__device__ __forceinline__ void attn_diff8(const unsigned char* __restrict__ Q8, const unsigned char* __restrict__ K8, const unsigned char* __restrict__ VT, unsigned char* __restrict__ Y, float lam, const float* __restrict__ subln, char* lds) {
  constexpr int SHK8 = 64 * 128, SHV8 = 128 * 64, L_V = 0, L_K = 8 * SHV8, L_W = L_K + 4 * SHK8;
  const int tid = opaque_tid(), wid = tid >> 6, lane = tid & 63, r32 = lane & 31, hi = lane >> 5;
  const int mp = wid >> 2, wrow = (wid & 3) * 32;
  char* V_lds = lds + L_V; char* K_lds = lds + L_K;
  float* wsf = (float*)(lds + L_W) + wid * 64; float* al_l = wsf + 32;
  float m_reg = 0.f; f32x16 o[4] = {}, ol = {}; f32x16 cinit = {};
  const char* ones_l = lds + L_W + 2048;
  if (tid < 8) ((unsigned*)(lds + L_W + 2048))[tid] = 0x38383838u;
  char* qs_ = lds + L_W + 4096 + wid * 2048 + lane * 16;
  { const unsigned char* qp = Q8 + (size_t)(wrow + r32) * 128 + mp * 64 + hi * 32; const u32x4 a = *(const u32x4*)qp, b = *(const u32x4*)(qp + 16);
    *(u32x4*)qs_ = a; *(u32x4*)(qs_ + 1024) = b; }
  unsigned koff, voff;
  { const int row = wid * 8 + (lane >> 3), c = (lane & 7) ^ ((row >> 1) & 7); koff = (unsigned)(row * 128 + c * 16); }
  { const int d = wid * 16 + (lane >> 2), c = (lane & 3) ^ ((d >> 2) & 3); voff = (unsigned)(d * NKEY + c * 16); }
  auto issue = [&](int tile, int kb, int vbuf) {
    __builtin_amdgcn_global_load_lds((const unsigned*)(VT + (size_t)(voff + (unsigned)tile * 64u)), (unsigned*)(V_lds + vbuf * SHV8 + wid * 1024), 16, 0, 0);
    __builtin_amdgcn_global_load_lds((const unsigned*)(K8 + (size_t)(koff + (unsigned)tile * 8192u)), (unsigned*)(K_lds + kb * SHK8 + wid * 1024), 16, 0, 0);
  };
  const int kro = r32 * 128, kc0 = ((mp * 4 + 2 * hi) ^ ((r32 >> 1) & 7)) << 4, kc1 = ((mp * 4 + 2 * hi + 1) ^ ((r32 >> 1) & 7)) << 4;
  const int vro = r32 * 64, vc0 = ((2 * hi) ^ ((r32 >> 2) & 3)) << 4, vc1 = ((2 * hi + 1) ^ ((r32 >> 2) & 3)) << 4;
#define TBAR() do { asm volatile("s_waitcnt vmcnt(0)" ::: "memory"); __syncthreads(); } while (0)
#define RESC(a) do { if (__any((a) < 1.f)) { if (hi == 0) al_l[r32] = (a); asm volatile("s_waitcnt lgkmcnt(0)" ::: "memory"); \
    _Pragma("unroll") for (int d = 0; d < 4; ++d) _Pragma("unroll") for (int r = 0; r < 16; ++r) o[d][r] *= al_l[crow(r, hi)]; _Pragma("unroll") for (int r = 0; r < 16; ++r) ol[r] *= al_l[crow(r, hi)]; } } while (0)
#define MF8(A_, B_, C_) __builtin_amdgcn_mfma_scale_f32_32x32x64_f8f6f4(A_, B_, C_, 0, 0, 0, 0x7f7f7f7f, 0, 0x7f7f7f7f)
#define RD32(P0_, P1_) ({ const u32x4 a_ = *(const u32x4*)(P0_), b_ = *(const u32x4*)(P1_); (i32x8){(int)a_[0], (int)a_[1], (int)a_[2], (int)a_[3], (int)b_[0], (int)b_[1], (int)b_[2], (int)b_[3]}; })
#define QKT(P0, P1, bb) do { const char* Ks = K_lds + (bb) * SHK8 + kro; const i32x8 k0_ = RD32(Ks + kc0, Ks + kc1), k1_ = RD32(Ks + 32 * 128 + kc0, Ks + 32 * 128 + kc1), qf = RD32(qs_, qs_ + 1024); \
    P0 = MF8(k0_, qf, cinit); P1 = MF8(k1_, qf, cinit); } while (0)
#define FSM8(p0_, p1_, al_, pf_) do {                                                                                                                          \
    _Pragma("unroll") for (int r = 0; r < 16; ++r) p1_[r] = __builtin_amdgcn_exp2f(p1_[r]);                                                                      \
    _Pragma("unroll") for (int q = 0; q < 4; ++q) { pf_[q] = (int)pk4_fp8(p0_[4 * q], p0_[4 * q + 1], p0_[4 * q + 2], p0_[4 * q + 3]); pf_[4 + q] = (int)pk4_fp8(p1_[4 * q], p1_[4 * q + 1], p1_[4 * q + 2], p1_[4 * q + 3]); } } while (0)
#define PV8(vb_, pf_) do { const char* Vs = V_lds + (vb_) * SHV8 + vro;                                                                                          \
    _Pragma("unroll") for (int d0 = 0; d0 < 4; ++d0) { const i32x8 v_ = RD32(Vs + d0 * 2048 + vc0, Vs + d0 * 2048 + vc1); o[d0] = MF8(pf_, v_, o[d0]); } { const i32x8 on_ = RD32(ones_l, ones_l + 16); ol = MF8(pf_, on_, ol); } } while (0)
  f32x16 pA0, pA1, pB0, pB1; float alA, alB; i32x8 pf; constexpr int NT = NKEY / 64;
  if (__builtin_amdgcn_readfirstlane(wid) >= 4) __builtin_amdgcn_s_setprio(1);
  issue(0, 0, 0); issue(1, 1, 1); TBAR(); issue(2, 2, 2); issue(3, 3, 3);
  QKT(pB0, pB1, 0); partialSM_c<true>(pB0, pB1, m_reg, cinit, alB);
  SBAR(); QKT(pA0, pA1, 1);
  FSM8(pB0, pB1, alB, pf); SBAR();
  PV8(0, pf); partialSM_c<false>(pA0, pA1, m_reg, cinit, alA);
  RESC(alA);
  for (int j = 2; j < NT; j += 2) {
    TBAR(); if (j + 2 < NT) { issue(j + 2, (j + 2) & 3, (j + 2) & 7); issue(j + 3, (j + 3) & 3, (j + 3) & 7); }
    SBAR(); QKT(pB0, pB1, j & 3);
    FSM8(pA0, pA1, alA, pf); SBAR();
    PV8((j - 1) & 7, pf); partialSM_c<false>(pB0, pB1, m_reg, cinit, alB);
    RESC(alB);
    SBAR(); QKT(pA0, pA1, (j + 1) & 3);
    FSM8(pB0, pB1, alB, pf); SBAR();
    PV8(j & 7, pf); partialSM_c<false>(pA0, pA1, m_reg, cinit, alA);
    RESC(alA);
  }
  FSM8(pA0, pA1, alA, pf); SBAR();
  PV8((NT - 1) & 7, pf);
  __builtin_amdgcn_s_setprio(0);
#undef TBAR
#undef RESC
#undef MF8
#undef RD32
#undef QKT
#undef FSM8
#undef PV8
  float rli[16];
#pragma unroll
  for (int r = 0; r < 16; ++r) rli[r] = __builtin_amdgcn_rcpf(ol[r]);
  unsigned char* Ow = Y + (size_t)(wrow + 4 * hi) * 128 + r32;
  __syncthreads();
  float* X = (float*)lds + (size_t)((wid & 3) * 32 + 4 * hi) * 128 + r32;
  if (mp == 1) {
#pragma unroll
    for (int r = 0; r < 16; ++r) { const int rr = (r & 3) + 8 * (r >> 2);
#pragma unroll
      for (int d0 = 0; d0 < 4; ++d0) X[rr * 128 + d0 * 32] = lam * o[d0][r] * rli[r]; }
  }
  __syncthreads();
  if (mp == 0) {
    float g[4];
#pragma unroll
    for (int d0 = 0; d0 < 4; ++d0) g[d0] = subln[d0 * 32 + r32] * (1.f - LAMBDA_INIT);
#pragma unroll
    for (int r = 0; r < 16; ++r) { const int rr = (r & 3) + 8 * (r >> 2); float od[4]; float s_ = 0.f;
#pragma unroll
      for (int d0 = 0; d0 < 4; ++d0) { od[d0] = o[d0][r] * rli[r] - X[rr * 128 + d0 * 32]; s_ = fmaf(od[d0], od[d0], s_); }
      s_ += __shfl_xor(s_, 1); s_ += __shfl_xor(s_, 2); s_ += __shfl_xor(s_, 4); s_ += __shfl_xor(s_, 8); s_ += __shfl_xor(s_, 16);
      const float rs = rsqrtf(s_ * (1.f / 128.f) + EPS);
#pragma unroll
      for (int d0 = 0; d0 < 4; ++d0) { const float vf_ = od[d0] * rs * g[d0]; const unsigned char v = (unsigned char)pk4_fp8(vf_, vf_, vf_, vf_); if (STORE) Ow[rr * 128 + d0 * 32] = v; else asm volatile("" :: "v"(v)); } }
  }
  __syncthreads();
}
template <bool STORE = true>
__device__ __forceinline__ void attn_mla8(const unsigned char* __restrict__ Q8, const unsigned char* __restrict__ KN, const unsigned char* __restrict__ KR, const unsigned char* __restrict__ VT, unsigned char* __restrict__ Y, char* lds) {
  constexpr int SHK8 = 64 * 128, SHR8 = 64 * 64, SHV8 = 128 * 64, L_V = 0, L_K = 8 * SHV8, L_R = L_K + 4 * SHK8, L_W = L_R + 4 * SHR8;
  const int tid = opaque_tid(), wid = tid >> 6, lane = tid & 63, r32 = lane & 31, hi = lane >> 5;
  const int wrow = wid * 32;
  char* V_lds = lds + L_V; char* K_lds = lds + L_K; char* R_lds = lds + L_R;
  float* wsf = (float*)(lds + L_W) + wid * 64; float* al_l = wsf + 32;
  float m_reg = -1e30f; f32x16 o[4] = {}, ol = {};
  const char* ones_l = lds + L_W + 2048;
  if (tid < 8) ((unsigned*)(lds + L_W + 2048))[tid] = 0x38383838u;
#define RD32(P0_, P1_) ({ const u32x4 a_ = *(const u32x4*)(P0_), b_ = *(const u32x4*)(P1_); (i32x8){(int)a_[0], (int)a_[1], (int)a_[2], (int)a_[3], (int)b_[0], (int)b_[1], (int)b_[2], (int)b_[3]}; })
  i32x8 qf[2];
  char* qs_ = lds + L_W + 4096 + wid * 2048 + lane * 16;
  { const unsigned char* qp = Q8 + (size_t)(wrow + r32) * 192 + hi * 32;
#pragma unroll
    for (int s3 = 0; s3 < 2; ++s3) qf[s3] = RD32(qp + s3 * 64, qp + s3 * 64 + 16);
    *(u32x4*)qs_ = *(const u32x4*)(qp + 128); *(u32x4*)(qs_ + 1024) = *(const u32x4*)(qp + 144); }
  unsigned koff, roff, voff;
  { const int row = wid * 8 + (lane >> 3), c = (lane & 7) ^ ((row >> 1) & 7); koff = (unsigned)(row * 128 + c * 16); }
  { const int row = (wid & 3) * 16 + (lane >> 2), c = (lane & 3) ^ ((row >> 2) & 3); roff = (unsigned)(row * 64 + c * 16); }
  { const int d = wid * 16 + (lane >> 2), c = (lane & 3) ^ ((d >> 2) & 3); voff = (unsigned)(d * NKEY + c * 16); }
  const bool rw_ = __builtin_amdgcn_readfirstlane(wid) < 4;
  auto issue = [&](int tile, int kb, int vbuf) {
    __builtin_amdgcn_global_load_lds((const unsigned*)(VT + (size_t)(voff + (unsigned)tile * 64u)), (unsigned*)(V_lds + vbuf * SHV8 + wid * 1024), 16, 0, 0);
    __builtin_amdgcn_global_load_lds((const unsigned*)(KN + (size_t)(koff + (unsigned)tile * 8192u)), (unsigned*)(K_lds + kb * SHK8 + wid * 1024), 16, 0, 0);
    if (rw_) __builtin_amdgcn_global_load_lds((const unsigned*)(KR + (size_t)(roff + (unsigned)tile * 4096u)), (unsigned*)(R_lds + kb * SHR8 + (wid & 3) * 1024), 16, 0, 0);
  };
  const int kro = r32 * 128, ksw = (r32 >> 1) & 7;
  const int vro = r32 * 64, vc0 = ((2 * hi) ^ ((r32 >> 2) & 3)) << 4, vc1 = ((2 * hi + 1) ^ ((r32 >> 2) & 3)) << 4;
#define TBAR() do { asm volatile("s_waitcnt vmcnt(0)" ::: "memory"); __syncthreads(); } while (0)
#define RESC(a) do { if (__any((a) < 1.f)) { if (hi == 0) al_l[r32] = (a); asm volatile("s_waitcnt lgkmcnt(0)" ::: "memory"); \
    _Pragma("unroll") for (int d = 0; d < 4; ++d) _Pragma("unroll") for (int r = 0; r < 16; ++r) o[d][r] *= al_l[crow(r, hi)]; _Pragma("unroll") for (int r = 0; r < 16; ++r) ol[r] *= al_l[crow(r, hi)]; } } while (0)
#define MF8(A_, B_, C_) __builtin_amdgcn_mfma_scale_f32_32x32x64_f8f6f4(A_, B_, C_, 0, 0, 0, 0x7f7f7f7f, 0, 0x7f7f7f7f)
#define QKB(P, Ks, Rs) do { P = f32x16{};                                                                                                                       \
    _Pragma("unroll") for (int s3 = 0; s3 < 2; ++s3) { const i32x8 k_ = RD32((Ks) + (((4 * s3 + 2 * hi) ^ ksw) << 4), (Ks) + (((4 * s3 + 2 * hi + 1) ^ ksw) << 4)); P = MF8(k_, qf[s3], P); } \
    { const i32x8 k_ = RD32((Rs) + vc0, (Rs) + vc1), q2_ = RD32(qs_, qs_ + 1024); P = MF8(k_, q2_, P); } } while (0)
#define QKT(P0, P1, bb) do { const char* Ks = K_lds + (bb) * SHK8 + kro; const char* Rs = R_lds + (bb) * SHR8 + vro; QKB(P0, Ks, Rs); QKB(P1, Ks + 32 * 128, Rs + 32 * 64); } while (0)
#define FSM8(p0_, p1_, al_, pf_) do {                                                                                                                          \
    _Pragma("unroll") for (int r = 0; r < 16; ++r) p1_[r] = __builtin_amdgcn_exp2f(p1_[r]);                                                                      \
    _Pragma("unroll") for (int q = 0; q < 4; ++q) { pf_[q] = (int)pk4_fp8(p0_[4 * q], p0_[4 * q + 1], p0_[4 * q + 2], p0_[4 * q + 3]); pf_[4 + q] = (int)pk4_fp8(p1_[4 * q], p1_[4 * q + 1], p1_[4 * q + 2], p1_[4 * q + 3]); } } while (0)
#define PV8(vb_, pf_) do { const char* Vs = V_lds + (vb_) * SHV8 + vro;                                                                                          \
    _Pragma("unroll") for (int d0 = 0; d0 < 4; ++d0) { const i32x8 v_ = RD32(Vs + d0 * 2048 + vc0, Vs + d0 * 2048 + vc1); o[d0] = MF8(pf_, v_, o[d0]); } { const i32x8 on_ = RD32(ones_l, ones_l + 16); ol = MF8(pf_, on_, ol); } } while (0)
  f32x16 pA0, pA1, pB0, pB1; float mnA, mnB, alA, alB; i32x8 pf; constexpr int NT = NKEY / 64;
  if (__builtin_amdgcn_readfirstlane(wid) >= 4) __builtin_amdgcn_s_setprio(1);
  issue(0, 0, 0); issue(1, 1, 1); TBAR(); issue(2, 2, 2); issue(3, 3, 3);
  QKT(pB0, pB1, 0); partialSM<1>(pB0, pB1, m_reg, mnB, alB);
  SBAR(); QKT(pA0, pA1, 1);
  FSM8(pB0, pB1, alB, pf); SBAR();
  PV8(0, pf); partialSM<1>(pA0, pA1, m_reg, mnA, alA);
  RESC(alA);
  for (int j = 2; j < NT; j += 2) {
    TBAR(); if (j + 2 < NT) { issue(j + 2, (j + 2) & 3, (j + 2) & 7); issue(j + 3, (j + 3) & 3, (j + 3) & 7); }
    SBAR(); QKT(pB0, pB1, j & 3);
    FSM8(pA0, pA1, alA, pf); SBAR();
    PV8((j - 1) & 7, pf); partialSM<1>(pB0, pB1, m_reg, mnB, alB);
    RESC(alB);
    SBAR(); QKT(pA0, pA1, (j + 1) & 3);
    FSM8(pB0, pB1, alB, pf); SBAR();
    PV8(j & 7, pf); partialSM<1>(pA0, pA1, m_reg, mnA, alA);
    RESC(alA);
  }
  FSM8(pA0, pA1, alA, pf); SBAR();
  PV8((NT - 1) & 7, pf);
  __builtin_amdgcn_s_setprio(0);
#undef TBAR
#undef RESC
#undef MF8
#undef RD32
#undef QKB
#undef QKT
#undef FSM8
#undef PV8
  float rli[16];
#pragma unroll
  for (int r = 0; r < 16; ++r) rli[r] = __builtin_amdgcn_rcpf(ol[r]);
  unsigned char* Ow = Y + (size_t)(wrow + 4 * hi) * 128 + r32;
#pragma unroll
  for (int r = 0; r < 16; ++r) { const int rr = (r & 3) + 8 * (r >> 2);
#pragma unroll
    for (int d0 = 0; d0 < 4; ++d0) { const float vf_ = o[d0][r] * rli[r]; const unsigned char v = (unsigned char)pk4_fp8(vf_, vf_, vf_, vf_); if (STORE) Ow[rr * 128 + d0 * 32] = v; else asm volatile("" :: "v"(v)); } }
  __syncthreads();
}
template <bool STORE, int WHICH = 3, int GH = 0>
__device__ void att_phase(const Params& p, char* lds) {
  const unsigned char* QA = p.ws + OFF_QA; const unsigned char* KA = p.ws + OFF_KA; const unsigned char* VAT = p.ws + OFF_VAT; unsigned char* YA = p.ws + OFF_YA;
  const unsigned char* QB = p.ws + OFF_QB; const unsigned char* KN = p.ws + OFF_KNOPE; const unsigned char* KR = p.ws + OFF_KROPE; const unsigned char* VBT = p.ws + OFF_VBT; unsigned char* YB = p.ws + OFF_YB;
  const float lam = *(const float*)(p.ws + OFF_LAM);
  for (int vb = blockIdx.x; vb < 256; vb += gridDim.x) {
    const int b = vb & 7, lb = vb >> 3, h = lb >> 2, sub = lb & 3; const size_t bh = (size_t)(b * 8 + h);
    if (WHICH & 1) for (int q = 0; q < 4; ++q) attn_mla8<STORE>(QB + (bh * 4096 + (sub * 4 + q) * 256) * 192, KN + bh * NKEY * 128, KR + (size_t)b * NKEY * 64, VBT + bh * 128 * NKEY, YB + (bh * 4096 + (sub * 4 + q) * 256) * 128, lds);
    if (WHICH & 2) for (int q = 0; q < 8; ++q) attn_diff8<STORE>(QA + (bh * 4096 + (sub * 8 + q) * 128) * 128, KA + bh * NKEY * 128, VAT + bh * 128 * NKEY, YA + (bh * 4096 + (sub * 8 + q) * 128) * 128, lam, p.subln_g, lds);
  }
}

__device__ __forceinline__ void fp8x8_to_f32(u32x2 w, float* f) {
  f[0] = __builtin_amdgcn_cvt_f32_fp8((int)w[0], 0); f[1] = __builtin_amdgcn_cvt_f32_fp8((int)w[0], 1); f[2] = __builtin_amdgcn_cvt_f32_fp8((int)w[0], 2); f[3] = __builtin_amdgcn_cvt_f32_fp8((int)w[0], 3);
  f[4] = __builtin_amdgcn_cvt_f32_fp8((int)w[1], 0); f[5] = __builtin_amdgcn_cvt_f32_fp8((int)w[1], 1); f[6] = __builtin_amdgcn_cvt_f32_fp8((int)w[1], 2); f[7] = __builtin_amdgcn_cvt_f32_fp8((int)w[1], 3);
}
__device__ void g3_phase(const Params& p, char* lds) {
  const unsigned char* YA = p.ws + OFF_YA; const unsigned char* YB = p.ws + OFF_YB;
  const unsigned char* WA = p.ws + OFF_WPAT; const unsigned char* WBt = p.ws + OFF_WPBT; const unsigned char* GT = (const unsigned char*)p.out; bf16_t* Z = (bf16_t*)(p.ws + OFF_Z); unsigned char* Z8 = p.ws + OFF_Z8;
  const int tid = opaque_tid(), wid = __builtin_amdgcn_readfirstlane(tid >> 6), lane = tid & 63, wm = wid >> 2, wn = wid & 3;
  const int G = gridDim.x, nx = (G % 8 == 0) ? 8 : 1, xg = blockIdx.x % nx, lb = blockIdx.x / nx, nlb = G / nx;
  for (int j = lb; j < (128 / nx) * 4; j += nlb) {
    const int mt = xg + nx * (j >> 2), nt = j & 3, b = mt >> 4, pos0 = (mt & 15) * 256;
    f32x16 acc[4][2];
    int ln = lane; asm volatile("" : "+v"(ln));
    char* wl = lds + wid * 16384; const char* rdp = tile_rd_ptr(wl, ln);
    const size_t t0 = (size_t)mt * 256 + wm * 128 + (ln >> 3); const int n0 = nt * 256 + wn * 64 + (ln & 7) * 8;
    auto plain = [&](int i, int r, float& x1, float& x2) { x1 = acc[i][0][r] * (1.f / W8S); x2 = acc[i][1][r] * (1.f / W8S); };
    { HeadLoader8 al{YA + ((size_t)(b * 8) * 4096 + pos0) * 128}; RowLoader8 bl{WA + (size_t)nt * 256 * 1024, 1024}; gemm_tile8(acc, al, bl, 8, lds); }
    tile_stage<4>(wl, ln, plain);
#pragma unroll
    for (int it = 0; it < 16; ++it) { const bf16x8 v = *(const bf16x8*)(rdp + it * 1024); float g[8], f[8]; fp8x8_to_f32(*(const u32x2*)(GT + (t0 + it * 8) * 2048 + n0), g);
#pragma unroll
      for (int k = 0; k < 8; ++k) f[k] = bf2f((bf16_t)v[k]) * g[k];
      *(bf16x8*)(Z + (t0 + it * 8) * 1024 + n0) = pack8(f);
      if ((it & 3) == 3) asm volatile("" ::: "memory"); }
    __syncthreads();
    { HeadLoader8 al{YB + ((size_t)(b * 8) * 4096 + pos0) * 128}; RowLoader8 bl{WBt + (size_t)nt * 256 * 1024, 1024}; gemm_tile8(acc, al, bl, 8, lds); }
    int ln2 = lane; asm volatile("" : "+v"(ln2));
    const char* rdp2 = tile_rd_ptr(wl, ln2); const size_t t2 = (size_t)mt * 256 + wm * 128 + (ln2 >> 3); const int n2 = nt * 256 + wn * 64 + (ln2 & 7) * 8;
    tile_stage<4>(wl, ln2, plain);
#pragma unroll
    for (int it = 0; it < 16; ++it) { const bf16x8 v = *(const bf16x8*)(rdp2 + it * 1024); float g[8], f[8]; fp8x8_to_f32(*(const u32x2*)(GT + (t2 + it * 8) * 2048 + 1024 + n2), g);
      const bf16x8 zo = *(const bf16x8*)(Z + (t2 + it * 8) * 1024 + n2);
#pragma unroll
      for (int k = 0; k < 8; ++k) f[k] = bf2f((bf16_t)zo[k]) + bf2f((bf16_t)v[k]) * g[k];
      u32x2 w = {pk4_fp8(f[0], f[1], f[2], f[3]), pk4_fp8(f[4], f[5], f[6], f[7])};
      *(u32x2*)(Z8 + (t2 + it * 8) * 1024 + n2) = w;
      if ((it & 1) == 1) asm volatile("" ::: "memory"); }
    __syncthreads();
  }
}
__device__ void g4_phase(const Params& p, char* lds) {
  const unsigned char* Z = p.ws + OFF_Z8; const unsigned char* WO = p.ws + OFF_WOUTT; const float* mod = (const float*)(p.ws + OFF_MOD);
  const int tid = opaque_tid(), wid = __builtin_amdgcn_readfirstlane(tid >> 6), lane = tid & 63, r32 = lane & 31, hi = lane >> 5, wm = wid >> 2, wn = wid & 3;
  const int G = gridDim.x, nx = (G % 8 == 0) ? 8 : 1, xg = blockIdx.x % nx, lb = blockIdx.x / nx, nlb = G / nx;
  for (int j = lb; j < (128 / nx) * 4; j += nlb) {
    const int mt = xg + nx * (j >> 2), nt = j & 3, b = mt >> 4;
    f32x16 acc[4][2];
    RowLoader8 al{Z + (size_t)mt * 256 * 1024, 1024}, bl{WO + (size_t)nt * 256 * 1024, 1024};
    gemm_tile8(acc, al, bl, 8, lds);
    int ln = lane; asm volatile("" : "+v"(ln));
    char* wl = lds + wid * 16384; const char* rdp = tile_rd_ptr(wl, ln);
    auto plain = [&](int i, int r, float& x1, float& x2) { x1 = acc[i][0][r] * (1.f / W8S); x2 = acc[i][1][r] * (1.f / W8S); };
    tile_stage<4>(wl, ln, plain);
    const size_t t0 = (size_t)mt * 256 + wm * 128 + (ln >> 3); const int n0 = nt * 256 + wn * 64 + (ln & 7) * 8;
    const f32x8 gt = *(const f32x8*)(mod + b * 6144 + 2048 + n0);
#pragma unroll
    for (int it = 0; it < 16; ++it) { const bf16x8 v = *(const bf16x8*)(rdp + it * 1024); const size_t off = (t0 + it * 8) * 1024 + n0; const f32x8 xv = *(const f32x8*)(p.x + off); f32x8 o;
#pragma unroll
      for (int k = 0; k < 8; ++k) o[k] = fmaf(gt[k], bf2f((bf16_t)v[k]), ALPHA * xv[k]);
      *(f32x8*)(p.out + off) = o; }
    __syncthreads();
  }
}

template <bool NOATT>
__device__ void ln1_phase(const Params& p) {
  const float* mod = (const float*)(p.ws + OFF_MOD); bf16_t* H2 = (bf16_t*)(p.ws + OFF_H2);
  const int tid = opaque_tid(), wid = tid >> 6, lane = tid & 63;
  { const int gw = blockIdx.x * 8 + wid, nw = gridDim.x * 8;
    f32x4 g[4], bb[4];
#pragma unroll
    for (int j = 0; j < 4; ++j) { const int col = j * 256 + lane * 4; g[j] = *(const f32x4*)(p.ln1_g + col); bb[j] = *(const f32x4*)(p.ln1_b + col); }
    for (int b = 0; b < NB; ++b) {
      f32x4 sh[4], sc[4];
#pragma unroll
      for (int j = 0; j < 4; ++j) { const int col = j * 256 + lane * 4; sh[j] = *(const f32x4*)(mod + b * 6144 + 3072 + col); sc[j] = *(const f32x4*)(mod + b * 6144 + 4096 + col) + 1.f; }
      for (int r = 2 * gw; r < SEQ; r += 2 * nw) {
        f32x4 v[2][4];
#pragma unroll
        for (int u = 0; u < 2; ++u)
#pragma unroll
          for (int j = 0; j < 4; ++j) { const size_t off = (size_t)(b * SEQ + r + u) * 1024 + j * 256 + lane * 4;
            if (NOATT) v[u][j] = *(const f32x4*)(p.x + off) * ALPHA; else v[u][j] = *(const f32x4*)(p.out + off); }
#pragma unroll
        for (int u = 0; u < 2; ++u) {
          float s = 0.f;
#pragma unroll
          for (int j = 0; j < 4; ++j) s += (v[u][j][0] + v[u][j][1]) + (v[u][j][2] + v[u][j][3]);
          const float mean = wave_sum(s) * (1.f / 1024.f); float q = 0.f;
#pragma unroll
          for (int j = 0; j < 4; ++j) { const f32x4 d = v[u][j] - mean; q += (d[0] * d[0] + d[1] * d[1]) + (d[2] * d[2] + d[3] * d[3]); }
          const float rstd = rsqrtf(wave_sum(q) * (1.f / 1024.f) + EPS);
#pragma unroll
          for (int j = 0; j < 4; ++j) { const f32x4 x1 = (v[u][j] - mean) * rstd * g[j] + bb[j];
            const f32x4 h = x1 * sc[j] + sh[j]; u32x2 w = {cvtpk(h[0], h[1]), cvtpk(h[2], h[3])}; *(u32x2*)(H2 + (size_t)(b * SEQ + r + u) * 1024 + j * 256 + lane * 4) = w; }
        }
      }
    }
  }
  signed char* U8 = (signed char*)(p.ws + OFF_U8); unsigned char* V8 = (unsigned char*)(p.ws + OFF_V8);
  float* SU = (float*)(p.ws + OFF_SU); float* SV = (float*)(p.ws + OFF_SV); float* SR = (float*)(p.ws + OFF_SR);
  for (int row0 = 2 * (blockIdx.x * 8 + wid); row0 < 2 * 16384; row0 += 2 * gridDim.x * 8) {
    f32x4 v[2][4];
#pragma unroll
    for (int u = 0; u < 2; ++u) { const int row = row0 + u; const float* sp = (row < 16384 ? p.peer_u + (size_t)row * 1024 : p.peer_v + (size_t)(row - 16384) * 1024) + lane * 16;
#pragma unroll
      for (int j = 0; j < 4; ++j) v[u][j] = *(const f32x4*)(sp + 4 * j); }
#pragma unroll
    for (int u = 0; u < 2; ++u) { const int row = row0 + u; const bool isu = row < 16384; const int e = isu ? row : row - 16384; float am = 0.f;
#pragma unroll
      for (int j = 0; j < 4; ++j) am = fmaxf(am, fmaxf(fmaxf(fabsf(v[u][j][0]), fabsf(v[u][j][1])), fmaxf(fabsf(v[u][j][2]), fabsf(v[u][j][3]))));
#pragma unroll
      for (int o = 32; o > 0; o >>= 1) am = fmaxf(am, __shfl_xor(am, o));
      {
        float ss = 0.f;
#pragma unroll
        for (int j = 0; j < 4; ++j) ss += (v[u][j][0] * v[u][j][0] + v[u][j][1] * v[u][j][1]) + (v[u][j][2] * v[u][j][2] + v[u][j][3] * v[u][j][3]);
        ss = wave_sum(ss);
        const float step = fminf(am * (1.f / 7.5f), 0.3352f * sqrtf(ss * (1.f / 1024.f))); const float inv = step > 0.f ? 1.f / step : 0.f; u32x2 w; int nsum = 0;
#pragma unroll
        for (int dd = 0; dd < 2; ++dd) { unsigned pk = 0;
#pragma unroll
          for (int k = 0; k < 4; ++k) { int lo_ = (int)floorf(fmaf(v[u][2 * dd][k], inv, 8.f)), hi_ = (int)floorf(fmaf(v[u][2 * dd + 1][k], inv, 8.f));
            lo_ = lo_ < 0 ? 0 : (lo_ > 15 ? 15 : lo_); hi_ = hi_ < 0 ? 0 : (hi_ > 15 ? 15 : hi_); nsum += lo_ + hi_ - 16; pk |= (unsigned)(lo_ | (hi_ << 4)) << (8 * k); }
          w[dd] = pk ^ (isu ? 0x88888888u : 0x80808080u); }
        *(u32x2*)((isu ? (unsigned char*)U8 : V8) + (size_t)e * 512 + lane * 8) = w;
        const float rs_ = wave_sum((float)nsum);
        if (lane == 0) { (isu ? SU : SV)[e] = step; if (isu) SR[e] = rs_; }
      } }
  }
}

__device__ __forceinline__ int f2key(float f) { const int b = (int)__float_as_uint(f); return b ^ ((b >> 31) & 0x7fffffff); }
__device__ __forceinline__ float key2f(int k) { const int y = k & ~127; return __uint_as_float((unsigned)(y ^ ((y >> 31) & 0x7fffffff))); }
__device__ __forceinline__ void ce_desc(int& a, int& b) { const int hi_ = a > b ? a : b, lo_ = a > b ? b : a; a = hi_; b = lo_; }
__device__ __forceinline__ void bitonic16_desc(int (&x)[16]) {
#pragma unroll
  for (int k = 2; k <= 16; k <<= 1)
#pragma unroll
    for (int j = k >> 1; j > 0; j >>= 1)
#pragma unroll
      for (int i = 0; i < 16; ++i) { const int l = i ^ j; if (l > i) { if ((i & k) == 0) ce_desc(x[i], x[l]); else ce_desc(x[l], x[i]); } }
}
__device__ __forceinline__ void merge16_desc(int (&a)[16], const int (&b)[16]) {
#pragma unroll
  for (int i = 0; i < 16; ++i) a[i] = a[i] > b[15 - i] ? a[i] : b[15 - i];
#pragma unroll
  for (int j = 8; j > 0; j >>= 1)
#pragma unroll
    for (int i = 0; i < 16; ++i) { const int l = i ^ j; if (l > i) ce_desc(a[i], a[l]); }
}
template <int GM_>
__device__ void g5_phase(const Params& p, char* lds) {
  constexpr int GM = GM_ == 3 ? 0 : GM_;
  const bf16_t* wt = (const bf16_t*)(p.ws + OFF_WEFFT); const bf16_t* H2 = (const bf16_t*)(p.ws + OFF_H2); int* IDX = (int*)(p.ws + OFF_IDX); float* WGT = (float*)(p.ws + OFF_WGT);
  const int tid = opaque_tid(), wid = __builtin_amdgcn_readfirstlane(tid >> 6), lane = tid & 63, wm = wid >> 2, wn = wid & 3;
  const int G = gridDim.x, nx = (G % 8 == 0) ? 8 : 1, xg = blockIdx.x % nx, lb = blockIdx.x / nx, nlb = G / nx;
  const int njobs = (128 / nx) * 8;
  int* xl = (int*)lds;
  for (int j = lb; j < njobs; j += nlb) {
    const int nt = xg + nx * (j >> 3), mt = j & 7;
    f32x16 acc[4][2];
    RowLoader al{wt + (size_t)mt * 256 * 1024, 1024}, bl{H2 + (size_t)nt * 256 * 1024, 1024};
    gemm_tile2<256, GM>(acc, al, bl, 16, lds);
    if (GM_ != 0) { asm volatile("" :: "v"(acc[0][0]), "v"(acc[0][1]), "v"(acc[1][0]), "v"(acc[1][1])); asm volatile("" :: "v"(acc[2][0]), "v"(acc[2][1]), "v"(acc[3][0]), "v"(acc[3][1])); continue; }
    int ln = lane; asm volatile("" : "+v"(ln));
    const int r32 = ln & 31, hi64 = (ln >> 5) << 6;
#pragma unroll
    for (int jb = 0; jb < 2; ++jb) {
      int top[16];
#pragma unroll
      for (int i = 0; i < 4; ++i) {
        int x[16];
#pragma unroll
        for (int r = 0; r < 16; ++r) x[r] = (f2key(acc[i][jb][r]) & ~127) | (i * 16 + r);
        bitonic16_desc(x);
        if (i == 0) {
#pragma unroll
          for (int r = 0; r < 16; ++r) top[r] = x[r]; }
        else merge16_desc(top, x);
      }
      int oth[16];
#pragma unroll
      for (int r = 0; r < 16; ++r) { const unsigned v = (unsigned)(top[r] | hi64);
        const auto rr = __builtin_amdgcn_permlane32_swap(v, v, false, false); top[r] = (int)rr[0]; oth[r] = (int)rr[1]; }
      merge16_desc(top, oth);
      int* xp = xl + (wm * 16 + (hi64 ? 8 : 0)) * 256 + wn * 64 + jb * 32 + r32;
#pragma unroll
      for (int r = 0; r < 8; ++r) xp[r * 256] = hi64 ? top[8 + r] : top[r];
    }
    __syncthreads();
    if (tid < 256) {
      int tk = tid; asm volatile("" : "+v"(tk));
      float A[16], B[16]; int KA[16], KB[16];
#pragma unroll
      for (int r = 0; r < 16; ++r) { const int a = xl[r * 256 + tk], bq = xl[(16 + r) * 256 + tk];
        A[r] = key2f(a); B[r] = key2f(bq);
        const int ia = a & 63, ib = bq & 63;
        KA[r] = 32 * (ia >> 4) + (ia & 3) + 8 * ((ia >> 2) & 3) + ((a >> 6) & 1) * 4;
        KB[r] = 32 * (ib >> 4) + (ib & 3) + 8 * ((ib >> 2) & 3) + ((bq >> 6) & 1) * 4; }
      float S[16]; int E[16];
#pragma unroll
      for (int r = 0; r < 16; ++r) { S[r] = -3.0e38f; E[r] = 0; }
#pragma unroll
      for (int i = 0; i < 16; ++i)
#pragma unroll
        for (int jn = 0; jn < 16; ++jn) {
          if ((i + 1) * (jn + 1) > 16) continue;
          float x = A[i] + B[jn]; int e = KA[i] * 128 + KB[jn];
#pragma unroll
          for (int r = 0; r < 16; ++r) { const bool gt = x > S[r]; const float ts = gt ? S[r] : x; const int te = gt ? E[r] : e; S[r] = gt ? x : S[r]; E[r] = gt ? e : E[r]; x = ts; e = te; }
        }
      const float mx = S[0]; float den = 0.f;
#pragma unroll
      for (int r = 0; r < 16; ++r) { S[r] = __expf(S[r] - mx); den += S[r]; }
      const float rden = 1.f / den;
      const size_t t = (size_t)nt * 256 + tk; int* ip = IDX + t * 128 + mt * 16; float* wp = WGT + t * 128 + mt * 16;
#pragma unroll
      for (int r = 0; r < 16; r += 4) { *(int4*)(ip + r) = make_int4(E[r], E[r + 1], E[r + 2], E[r + 3]); *(float4*)(wp + r) = make_float4(S[r] * rden, S[r + 1] * rden, S[r + 2] * rden, S[r + 3] * rden); }
    }
    __syncthreads();
  }
}

__device__ __forceinline__ float gelu_tanh(float x) { const float u = 0.7978845608028654f * (x + 0.044715f * x * x * x); const float e = __builtin_amdgcn_exp2f(2.885390081777927f * u); const float th = 1.f - 2.f * __builtin_amdgcn_rcpf(e + 1.f); return 0.5f * x * (1.f + th); }
__device__ __forceinline__ int sel2(bool hi, int a, int b) { return hi ? b : a; }
__device__ __forceinline__ int rl_at(int v, int k) { asm volatile("" : "+s"(k)); return __builtin_amdgcn_readlane(v, k); }
template <bool STORE, int GP = 0>
__device__ void gather_phase(const Params& p) {
  const float* mod = (const float*)(p.ws + OFF_MOD); const bf16_t* H2 = (const bf16_t*)(p.ws + OFF_H2);
  const unsigned char* U8 = (const unsigned char*)(p.ws + OFF_U8); const unsigned char* V8 = (const unsigned char*)(p.ws + OFF_V8);
  const float* SU = (const float*)(p.ws + OFF_SU); const float* SV = (const float*)(p.ws + OFF_SV); const float* SR = (const float*)(p.ws + OFF_SR);
  const int* IDX = (const int*)(p.ws + OFF_IDX); const float* WGT = (const float*)(p.ws + OFF_WGT);
  const int tid = opaque_tid(), wid = __builtin_amdgcn_readfirstlane(tid >> 6), lane0 = tid & 63;
  const int tstride = gridDim.x * 8;
  int t = blockIdx.x * 8 + wid;
  int e0 = 0, e1 = 0;
  bf16x8 hxn[4] = {}; float w0n = 0.f, w1n = 0.f;
  if (t < T) { e0 = IDX[(size_t)t * 128 + lane0]; e1 = IDX[(size_t)t * 128 + 64 + lane0]; w0n = WGT[(size_t)t * 128 + lane0]; w1n = WGT[(size_t)t * 128 + 64 + lane0];
#pragma unroll
    for (int q = 0; q < 4; ++q) hxn[q] = *(const bf16x8*)(H2 + (size_t)t * 1024 + (lane0 & 31) * 32 + q * 8); }
#define GSB() do { asm volatile("" ::: "memory"); __builtin_amdgcn_sched_barrier(0); } while (0)
  for (; t < T; t += tstride) {
    const int b = t >> 12;
    int lane = lane0; asm volatile("" : "+v"(lane));
    const int l31 = lane & 31; const bool hiH = lane >= 32;
    const unsigned char* urow = U8 + l31 * 16; const unsigned char* vrow = V8 + l31 * 16;
    int e0v = e0, e1v = e1; asm volatile("" : "+v"(e0v), "+v"(e1v));
    bf16x8 hx[4];
#pragma unroll
    for (int q = 0; q < 4; ++q) hx[q] = hxn[q];
    const float w0 = w0n, w1 = w1n;
    const float su0 = SU[e0], su1 = SU[e1], sv0 = SV[e0], sv1 = SV[e1], sr0 = SR[e0], sr1 = SR[e1];
#define ROW2(ev, k) sel2(hiH, rl_at(ev, (k)), rl_at(ev, 32 + (k)))
    u32x4 uu[16];
#pragma unroll
    for (int k = 0; k < 16; ++k) uu[k] = *(const u32x4*)(urow + (size_t)ROW2(e0, k) * 512);
    GSB();
    int XH[4], XL[4]; float sh, hcorr;
    { float hv[32]; float am = 0.f;
#pragma unroll
      for (int q = 0; q < 4; ++q)
#pragma unroll
        for (int k = 0; k < 8; ++k) { hv[8 * q + k] = bf2f((bf16_t)hx[q][k]); am = fmaxf(am, fabsf(hv[8 * q + k])); }
      am = wave_max(am);
      const float inv = am > 0.f ? 127.f / am : 0.f; sh = am * (1.f / 127.f); int qs = 0;
#pragma unroll
      for (int d = 0; d < 4; ++d) { unsigned ph = 0, pl = 0;
#pragma unroll
        for (int k = 0; k < 4; ++k) { const int qa = (int)rintf(hv[8 * d + k] * inv), qb = (int)rintf(hv[8 * d + 4 + k] * inv); qs += qa + qb;
          ph |= (unsigned)(((qa >> 4) & 15) | (((qb >> 4) & 15) << 4)) << (8 * k); pl |= (unsigned)((qa & 15) | ((qb & 15) << 4)) << (8 * k); }
        XH[d] = (int)ph; XL[d] = (int)(pl ^ 0x88888888u); }
      hcorr = 0.5f * wave_sum(hiH ? 0.f : (float)qs); }
    GSB();
    u32x4 vv[16]; float cc[2]; int part[32];
#define TRSTEP(S, CTRL) do { const bool up = (lane & (S)) != 0;                                                                                                            \
      _Pragma("unroll") for (int i = 0; i < (S); ++i) { const int give = up ? part[i] : part[i + (S)], keep = up ? part[i + (S)] : part[i]; part[i] = keep + __builtin_amdgcn_update_dpp(0, give, CTRL, 0xF, 0xF, true); } } while (0)
#define TREDUCE() do { _Pragma("unroll") for (int i = 0; i < 16; ++i) { auto r_ = __builtin_amdgcn_permlane16_swap((unsigned)part[i], (unsigned)part[i + 16], false, false); part[i] = (int)r_[0] + (int)r_[1]; } \
      TRSTEP(8, 0x140); TRSTEP(4, 0x141); TRSTEP(2, 0x4E); TRSTEP(1, 0xB1); } while (0)
#define UINS(i) do { const u32x4 u = uu[(i) & 15]; int a_ = 0, b_ = 0;                                                                                                      \
      _Pragma("unroll") for (int d = 0; d < 4; ++d) { if (GP & 2) { asm volatile("" :: "v"(u[d])); continue; } a_ = __builtin_amdgcn_sdot8((int)u[d], XH[d], a_, false); b_ = __builtin_amdgcn_sdot8((int)u[d], XL[d], b_, false); } \
      a_ = a_ * 16 + b_;                                                                                                                                                      \
      part[(i) & 31] = a_;                                                                                                                                                    \
      if ((i) + 16 < 64) uu[(i) & 15] = *(const u32x4*)(urow + (size_t)ROW2(((i) + 16) < 32 ? e0 : e1, ((i) + 16) & 31) * 512);                                                  \
      else vv[(i) - 48] = *(const u32x4*)(vrow + (size_t)ROW2(e0v, (i) - 48) * 512);                                                                                          \
      GSB(); } while (0)
#pragma unroll
    for (int i = 0; i < 32; ++i) UINS(i);
    TREDUCE(); cc[0] = w0 * gelu_tanh(sh * su0 * ((float)part[0] + 8.f * sr0 + hcorr)) * sv0; GSB();
#pragma unroll
    for (int i = 32; i < 64; ++i) UINS(i);
#undef UINS
    TREDUCE(); cc[1] = w1 * gelu_tanh(sh * su1 * ((float)part[0] + 8.f * sr1 + hcorr)) * sv1;
#undef TREDUCE
#undef TRSTEP
    const int tn = t + tstride < T ? t + tstride : t;
    const int e0n = IDX[(size_t)tn * 128 + lane], e1n = IDX[(size_t)tn * 128 + 64 + lane];
    w0n = WGT[(size_t)tn * 128 + lane]; w1n = WGT[(size_t)tn * 128 + 64 + lane];
#pragma unroll
    for (int q = 0; q < 4; ++q) hxn[q] = *(const bf16x8*)(H2 + (size_t)tn * 1024 + l31 * 32 + q * 8);
    const float cm = wave_max(fmaxf(fabsf(cc[0]), fabsf(cc[1])));
    const float cinv = cm > 0.f ? 127.f / cm : 0.f;
    const int cq0 = (int)rintf(cc[0] * cinv), cq1 = (int)rintf(cc[1] * cinv);
    const float csum = wave_sum((float)(cq0 + cq1));
    int accL[16], accB[16];
#pragma unroll
    for (int k = 0; k < 16; ++k) { accL[k] = 0; accB[k] = 0; }
    int cb = l31 * 32 + (lane >> 5) * 16; asm volatile("" : "+v"(cb));
    f32x4 r1v[4];
    GSB();
#pragma unroll
    for (int i = 0; i < 64; ++i) {
      const int c0_ = ROW2(i < 32 ? cq0 : cq1, i & 31) & 0xff, c1_ = c0_ << 8, c2_ = c0_ << 16, c3_ = c0_ << 24;
#pragma unroll
      for (int d = 0; d < 4; ++d) { const int x = (int)vv[i & 15][d]; const int lo_ = x & 0x0f0f0f0f; if (GP & 1) { asm volatile("" :: "v"(lo_), "s"(c1_), "s"(c2_), "s"(c3_)); continue; }
        accL[4 * d + 0] = __builtin_amdgcn_sdot4(lo_, c0_, accL[4 * d + 0], false); accL[4 * d + 1] = __builtin_amdgcn_sdot4(lo_, c1_, accL[4 * d + 1], false);
        accL[4 * d + 2] = __builtin_amdgcn_sdot4(lo_, c2_, accL[4 * d + 2], false); accL[4 * d + 3] = __builtin_amdgcn_sdot4(lo_, c3_, accL[4 * d + 3], false);
        accB[4 * d + 0] = __builtin_amdgcn_sdot4(x, c0_, accB[4 * d + 0], false); accB[4 * d + 1] = __builtin_amdgcn_sdot4(x, c1_, accB[4 * d + 1], false);
        accB[4 * d + 2] = __builtin_amdgcn_sdot4(x, c2_, accB[4 * d + 2], false); accB[4 * d + 3] = __builtin_amdgcn_sdot4(x, c3_, accB[4 * d + 3], false); }
      if (i + 16 < 64) vv[i & 15] = *(const u32x4*)(vrow + (size_t)ROW2((i + 16) < 32 ? e0v : e1v, (i + 16) & 31) * 512);
      else if (i < 52) r1v[i - 48] = *(const f32x4*)(p.out + (size_t)t * 1024 + cb + (i - 48) * 4);
      GSB();
    }
#undef ROW2
    float fin[16];
    { const float cs = cm * (1.f / 127.f);
#pragma unroll
      for (int m = 0; m < 8; ++m) { auto rl_ = __builtin_amdgcn_permlane32_swap((unsigned)accL[m], (unsigned)accL[m + 8], false, false); auto rb_ = __builtin_amdgcn_permlane32_swap((unsigned)accB[m], (unsigned)accB[m + 8], false, false);
        const int L_ = (int)rl_[0] + (int)rl_[1], B_ = (int)rb_[0] + (int)rb_[1];
        fin[8 * (m >> 2) + (m & 3)] = cs * ((float)L_ - 7.5f * csum); fin[8 * (m >> 2) + 4 + (m & 3)] = cs * ((float)(B_ - L_) * 0.0625f + 0.5f * csum); } }
    float r2[16]; float s = 0.f;
    { float s1 = 0.f;
#pragma unroll
      for (int q = 0; q < 4; ++q) s1 += (r1v[q][0] + r1v[q][1]) + (r1v[q][2] + r1v[q][3]);
      const float m1 = wave_sum(s1) * (1.f / 1024.f); float q1 = 0.f;
#pragma unroll
      for (int q = 0; q < 4; ++q) { const f32x4 d = r1v[q] - m1; q1 += (d[0] * d[0] + d[1] * d[1]) + (d[2] * d[2] + d[3] * d[3]); }
      const float rs1 = rsqrtf(wave_sum(q1) * (1.f / 1024.f) + EPS);
#pragma unroll
      for (int q = 0; q < 4; ++q) { const int col = cb + q * 4; const f32x4 g1 = *(const f32x4*)(p.ln1_g + col), b1 = *(const f32x4*)(p.ln1_b + col), g2 = *(const f32x4*)(mod + b * 6144 + 5120 + col);
#pragma unroll
        for (int k = 0; k < 4; ++k) { const float x1 = (r1v[q][k] - m1) * rs1 * g1[k] + b1[k]; r2[q * 4 + k] = fmaf(g2[k], fin[q * 4 + k], ALPHA * x1); s += r2[q * 4 + k]; } } }
    const float mean = wave_sum(s) * (1.f / 1024.f); float qq = 0.f;
#pragma unroll
    for (int k = 0; k < 16; ++k) { const float d = r2[k] - mean; qq = fmaf(d, d, qq); }
    const float rstd = rsqrtf(wave_sum(qq) * (1.f / 1024.f) + EPS);
#pragma unroll
    for (int q = 0; q < 4; ++q) { const int col = cb + q * 4; const f32x4 g = *(const f32x4*)(p.ln2_g + col), bb = *(const f32x4*)(p.ln2_b + col); f32x4 o;
#pragma unroll
      for (int k = 0; k < 4; ++k) o[k] = (r2[q * 4 + k] - mean) * rstd * g[k] + bb[k];
      if (STORE) *(f32x4*)(p.out + (size_t)t * 1024 + col) = o; else asm volatile("" :: "v"(o)); }
    e0 = e0n; e1 = e1n;
  }
#undef GSB
}

#define REPEAT(id, call) do { int nrep_ = (PROBE_DUP == (id)) ? 2 : 1; asm volatile("" : "+s"(nrep_)); for (int rep_ = 0; rep_ < nrep_; ++rep_) { call; } } while (0)
__global__ void __launch_bounds__(NTHR) fwd_mega(Params p) {
  extern __shared__ __attribute__((aligned(16))) char lds[];
  cg::grid_group grid = cg::this_grid();
  volatile LAS unsigned* xst = (volatile LAS unsigned*)(lds + LDS_BYTES - 16);
  if (threadIdx.x == 0) { xst[0] = 0u; xst[1] = 0u; }
  __syncthreads();
  const XcdBarrier xb = xcd_barrier_post((unsigned*)(p.ws + OFF_BAR), xst);
  { int nrep0_ = (PROBE_DUP == 30) ? 2 : 1; asm volatile("" : "+s"(nrep0_)); for (int rep0_ = 0; rep0_ < nrep0_; ++rep0_) {
  p0_misc(p);
  REPEAT(32, p0_mod(p, lds));
  { int nrt_ = (PROBE_DUP == 33) ? 2 : 1; asm volatile("" : "+s"(nrt_)); for (int rt_ = 0; rt_ < nrt_; ++rt_) { int jc = 0;
    p0_transpose(p.w_in, 1024, IN_COLS, IN_PAD, (bf16_t*)(p.ws + OFF_WINT), nullptr, lds, jc, jc, W8S);
    p0_transpose(p.w_q_up, 256, 1536, 1536, (bf16_t*)(p.ws + OFF_WQUPT), p.q_norm_g, lds, jc, jc);
    p0_transpose(p.w_kv_up, 256, 2048, 2048, (bf16_t*)(p.ws + OFF_WKVUPT), p.kv_norm_g, lds, jc, jc);
    p0_transpose(p.w_pa, 1024, 1024, 1024, (bf16_t*)(p.ws + OFF_WPAT), nullptr, lds, jc, jc, W8S);
    p0_transpose(p.w_pb, 1024, 1024, 1024, (bf16_t*)(p.ws + OFF_WPBT), nullptr, lds, jc, jc, W8S);
    p0_transpose(p.w_out, 1024, 1024, 1024, (bf16_t*)(p.ws + OFF_WOUTT), nullptr, lds, jc, jc, W8S); } }
  REPEAT(34, p0_weff(p, lds));
  } }
  grid.sync();
  p0_mod_reduce(p);
  xcd_barrier(xb);
  REPEAT(8, p0b_hmod(p));
  xcd_barrier(xb);
#if PROBE_DUP == 16
  g1_phase<1>(p, lds);
#elif PROBE_DUP == 17
  g1_phase<2>(p, lds);
#endif
  REPEAT(3, g1_phase<0>(p, lds));
  xcd_barrier(xb);
  REPEAT(4, g2_phase(p, lds));
  xcd_barrier(xb);
#if PROBE_DUP == 1
  att_phase<false>(p, lds);
#elif PROBE_DUP == 14
  att_phase<false, 1>(p, lds);
#elif PROBE_DUP == 15
  att_phase<false, 2>(p, lds);
#elif PROBE_DUP >= 100 && PROBE_DUP < 200
  att_phase<false, 2, PROBE_DUP - 100>(p, lds);
#elif PROBE_DUP >= 200 && PROBE_DUP < 300
  att_phase<false, 1, PROBE_DUP - 200>(p, lds);
#endif
  att_phase<true>(p, lds);
  xcd_barrier(xb);
  REPEAT(5, g3_phase(p, lds));
  xcd_barrier(xb);
  REPEAT(9, g4_phase(p, lds));
  xcd_barrier(xb);
  ln1_phase<false>(p);
  xcd_barrier(xb);
#if PROBE_DUP == 11
  g5_phase<1>(p, lds);
#elif PROBE_DUP == 12
  g5_phase<2>(p, lds);
#elif PROBE_DUP == 13
  g5_phase<3>(p, lds);
#endif
  REPEAT(6, g5_phase<0>(p, lds));
  xcd_barrier(xb);
#if PROBE_DUP == 2
  gather_phase<false>(p);
#elif PROBE_DUP >= 20 && PROBE_DUP < 24
  gather_phase<false, PROBE_DUP - 20>(p);
#endif
  gather_phase<true>(p);
}

extern "C" void kernel_launch(void* const* d_in, const int* in_sizes, int n_in, void* d_out, int out_size, void* d_ws, size_t ws_size, hipStream_t stream) {
  static int grid_blocks = 0;
  if (grid_blocks == 0) {
    if (n_in != 27 || out_size != T * DM || ws_size < WS_END) { fprintf(stderr, "kernel_launch: unexpected shapes n_in %d out %d ws %zu (need %zu)\n", n_in, out_size, ws_size, (size_t)WS_END); grid_blocks = -1; return; }
    int dev = 0, cus = 0, per_cu = 0;
    hipGetDevice(&dev); hipDeviceGetAttribute(&cus, hipDeviceAttributeMultiprocessorCount, dev);
    if (hipFuncSetAttribute((const void*)fwd_mega, hipFuncAttributeMaxDynamicSharedMemorySize, LDS_BYTES) != hipSuccess) { fprintf(stderr, "kernel_launch: hipFuncSetAttribute failed\n"); grid_blocks = -1; return; }
    if (hipOccupancyMaxActiveBlocksPerMultiprocessor(&per_cu, (const void*)fwd_mega, NTHR, LDS_BYTES) != hipSuccess || per_cu < 1) { fprintf(stderr, "kernel_launch: occupancy query failed (%d)\n", per_cu); grid_blocks = -1; return; }
    grid_blocks = cus;
    fprintf(stderr, "kernel_launch: cus %d per_cu %d grid %d\n", cus, per_cu, grid_blocks);
  }
  if (grid_blocks < 0) return;
  Params p{};
  const float** f = (const float**)&p;
  for (int i = 0; i < 27; ++i) f[i] = (const float*)d_in[i];
  p.out = (float*)d_out; p.ws = (unsigned char*)d_ws;
  if (hipMemsetAsync((char*)d_ws + OFF_BAR, 0, XCD_BAR_WORDS * 4, stream) != hipSuccess) { fprintf(stderr, "kernel_launch: memset failed\n"); return; }
  void* args[] = {&p};
  hipError_t e = hipLaunchCooperativeKernel((const void*)fwd_mega, dim3(grid_blocks), dim3(NTHR), args, LDS_BYTES, stream);
  if (e != hipSuccess) fprintf(stderr, "kernel_launch: cooperative launch failed: %s (grid %d)\n", hipGetErrorString(e), grid_blocks);
}
```

```cpp
#include <hip/hip_runtime.h>
#include <hip/hip_cooperative_groups.h>
#include <cstdio>
#include <cstdint>
namespace cg = cooperative_groups;
#ifndef PROBE_DUP
#define PROBE_DUP 0
#endif

typedef unsigned short bf16_t;
typedef short bf16x8 __attribute__((ext_vector_type(8)));
typedef short s16x4 __attribute__((ext_vector_type(4)));
typedef float f32x16 __attribute__((ext_vector_type(16)));
typedef float f32x8 __attribute__((ext_vector_type(8)));
typedef float f32x2 __attribute__((ext_vector_type(2)));
typedef float f32x4 __attribute__((ext_vector_type(4)));
typedef unsigned u32x4 __attribute__((ext_vector_type(4)));
typedef int i32x8 __attribute__((ext_vector_type(8)));
typedef unsigned u32x2 __attribute__((ext_vector_type(2)));

constexpr int DM = 1024, NB = 8, SEQ = 4096, CTXL = 256, T = NB * SEQ, TC = NB * CTXL, NKEY = SEQ + CTXL, TK = NB * NKEY;
constexpr int Q_COLS = 3328, IN_COLS = 5696, IN_PAD = 5888;
constexpr float EPS = 1e-6f;
constexpr float ALPHA = 1.189207115002721f;
constexpr float LAMBDA_INIT = 0.2f;
constexpr int NTHR = 512;
constexpr float W8S = 64.f;
constexpr int LDS_BYTES = 152 * 1024;

constexpr size_t MiB = 1u << 20;
constexpr size_t WS_MODP = (25 + 374 + 80) * MiB;
constexpr size_t OFF_MOD = 0;
constexpr size_t OFF_ROPE = 256 * 1024;
constexpr size_t OFF_LAM = 300 * 1024;
constexpr size_t OFF_BAR = 512 * 1024;
constexpr size_t OFF_SR = 800 * 1024;
constexpr size_t OFF_SU = 600 * 1024, OFF_SV = 700 * 1024;
constexpr size_t OFF_MODP = WS_MODP;
constexpr size_t OFF_WINT = 1 * MiB;
constexpr size_t OFF_WQUPT = 13 * MiB;
constexpr size_t OFF_WKVUPT = 14 * MiB;
constexpr size_t OFF_WPAT = 15 * MiB, OFF_WPBT = 17 * MiB, OFF_WOUTT = 19 * MiB;
constexpr size_t OFF_WEFFT = 21 * MiB;
constexpr size_t WB = 25 * MiB;
constexpr size_t OFF_KA = WB, OFF_VA = WB + 68 * MiB, OFF_KNOPE = WB + 136 * MiB, OFF_VB = WB + 204 * MiB, OFF_KROPE = WB + 272 * MiB;
constexpr size_t OFF_QLAT = WB + 277 * MiB, OFF_KVLAT = WB + 293 * MiB, OFF_QA = WB + 310 * MiB, OFF_QB = WB + 374 * MiB, WS_END = WB + 470 * MiB;
constexpr size_t OFF_HMOD = OFF_QB;
constexpr size_t OFF_VAT = OFF_KA + 34 * MiB;
constexpr size_t OFF_VBT = OFF_KNOPE + 34 * MiB, OFF_YB = OFF_VB;
constexpr size_t OFF_R1B = OFF_VB;
constexpr size_t OFF_SQ = OFF_QA + 32 * MiB;
constexpr size_t OFF_Z8 = OFF_KNOPE;
constexpr size_t OFF_YA = OFF_VA;
constexpr size_t OFF_Z = OFF_KA, OFF_H2 = OFF_VA, OFF_U8 = OFF_KNOPE, OFF_V8 = OFF_KNOPE + 16 * MiB;
constexpr size_t OFF_IDX = OFF_Z, OFF_WGT = OFF_Z + 16 * MiB;

struct Params {
  const float *x, *c, *ctx, *c_ctx, *w_mod, *b_mod, *w_in, *w_q_up, *q_norm_g, *w_kv_up, *kv_norm_g, *lq1, *lk1, *lq2, *lk2, *subln_g, *w_pa, *w_pb, *w_out,
      *ln1_g, *ln1_b, *w_pq, *peer_keys, *peer_u, *peer_v, *ln2_g, *ln2_b;
  float* out; unsigned char* ws;
};

__device__ __forceinline__ unsigned cvtpk(float lo, float hi) { unsigned r; asm volatile("v_cvt_pk_bf16_f32 %0, %1, %2" : "=v"(r) : "v"(lo), "v"(hi)); return r; }
__device__ __forceinline__ bf16_t f2bf(float x) { return (bf16_t)(cvtpk(x, x) & 0xffffu); }
__device__ __forceinline__ float bf2f(bf16_t v) { return __uint_as_float(((unsigned)v) << 16); }
__device__ __forceinline__ int crow(int r, int hi) { return (r & 3) + 8 * (r >> 2) + 4 * hi; }
__device__ __forceinline__ unsigned pk4_fp8(float a, float b, float c, float d) { return (unsigned)__builtin_amdgcn_cvt_pk_fp8_f32(c, d, __builtin_amdgcn_cvt_pk_fp8_f32(a, b, 0, false), true); }
__device__ __forceinline__ unsigned pk8_fp4(const float* v) {
  unsigned w = 0;
  w = __builtin_amdgcn_cvt_scalef32_pk_fp4_f32(w, v[0], v[1], 0.5f, 0); w = __builtin_amdgcn_cvt_scalef32_pk_fp4_f32(w, v[2], v[3], 0.5f, 1);
  w = __builtin_amdgcn_cvt_scalef32_pk_fp4_f32(w, v[4], v[5], 0.5f, 2); w = __builtin_amdgcn_cvt_scalef32_pk_fp4_f32(w, v[6], v[7], 0.5f, 3);
  return w;
}
__device__ __forceinline__ bf16x8 pack8(const float* v) { u32x4 w = {cvtpk(v[0], v[1]), cvtpk(v[2], v[3]), cvtpk(v[4], v[5]), cvtpk(v[6], v[7])}; return *reinterpret_cast<bf16x8*>(&w); }
__device__ __forceinline__ float sigmoid_f(float v) { return __builtin_amdgcn_rcpf(1.f + __builtin_amdgcn_exp2f(-1.4426950408889634f * v)); }
__device__ __forceinline__ float silu_f(float v) { return v * sigmoid_f(v); }
template <int CTRL> __device__ __forceinline__ float dppf(float v) { return __uint_as_float((unsigned)__builtin_amdgcn_update_dpp(0, (int)__float_as_uint(v), CTRL, 0xF, 0xF, true)); }
__device__ __forceinline__ float wave_sum(float v) {
  v += dppf<0xB1>(v); v += dppf<0x4E>(v); v += dppf<0x141>(v); v += dppf<0x140>(v);
  { auto r = __builtin_amdgcn_permlane16_swap(__float_as_uint(v), __float_as_uint(v), false, false); v = __uint_as_float(r[0]) + __uint_as_float(r[1]); }
  { auto r = __builtin_amdgcn_permlane32_swap(__float_as_uint(v), __float_as_uint(v), false, false); v = __uint_as_float(r[0]) + __uint_as_float(r[1]); }
  return v;
}
__device__ __forceinline__ float wave_max(float v) {
  v = fmaxf(v, dppf<0xB1>(v)); v = fmaxf(v, dppf<0x4E>(v)); v = fmaxf(v, dppf<0x141>(v)); v = fmaxf(v, dppf<0x140>(v));
  { auto r = __builtin_amdgcn_permlane16_swap(__float_as_uint(v), __float_as_uint(v), false, false); v = fmaxf(__uint_as_float(r[0]), __uint_as_float(r[1])); }
  { auto r = __builtin_amdgcn_permlane32_swap(__float_as_uint(v), __float_as_uint(v), false, false); v = fmaxf(__uint_as_float(r[0]), __uint_as_float(r[1])); }
  return v;
}

__device__ __forceinline__ int opaque_tid() { int t = threadIdx.x; asm volatile("" : "+v"(t)); return t; }


#define XB_TMO      128
#define XB_XCNT(j)  (256  + 64 * (j))
#define XB_XSUB(j)  (1280 + 64 * (j))
#define XB_XGEN(j)  (2304 + 64 * (j))
#define XB_TOP      3328
#define XB_TOPGEN   3392
#define XCD_BAR_WORDS 3456
#define XB_SPIN_CAP (1u << 20)
#define LAS __attribute__((address_space(3)))
__device__ __forceinline__ unsigned xb_ld(unsigned* p)              { return __hip_atomic_load(p, __ATOMIC_RELAXED, __HIP_MEMORY_SCOPE_AGENT); }
__device__ __forceinline__ unsigned xb_add(unsigned* p, unsigned v) { return __hip_atomic_fetch_add(p, v, __ATOMIC_RELAXED, __HIP_MEMORY_SCOPE_AGENT); }
__device__ __forceinline__ unsigned xb_xcc_id() { return (unsigned)__builtin_amdgcn_s_getreg((3 << 11) | 20) & 0xFu; }
#define XB_SPIN(cond, bar) do { unsigned _sp = 0; while (cond) { __builtin_amdgcn_s_sleep(1); \
    if ((++_sp & 255u) == 0u) { if (xb_ld(&(bar)[XB_TMO])) break; if (_sp > XB_SPIN_CAP) { atomicAdd(&(bar)[XB_TMO], 1u); break; } } } } while (0)
struct XcdBarrier { unsigned* bar; unsigned x; volatile LAS unsigned* st; };
__device__ __forceinline__ XcdBarrier xcd_barrier_post(unsigned* bar, volatile LAS unsigned* st) {
    XcdBarrier b; b.bar = bar; b.x = xb_xcc_id(); b.st = st;
    if (threadIdx.x == 0) (void)xb_add(&bar[XB_XCNT(b.x)], 1u);
    return b;
}
__device__ __forceinline__ void xcd_barrier_complete(unsigned* bar, unsigned x, unsigned& nloc, unsigned& nx) {
    const unsigned G = gridDim.x * gridDim.y * gridDim.z;
    unsigned sum, cnt, mine, sp = 0u;
    for (;;) {
        sum = 0u; cnt = 0u; mine = 0u;
#pragma unroll
        for (unsigned j = 0; j < 16; ++j) { const unsigned c = xb_ld(&bar[XB_XCNT(j)]); sum += c; cnt += (c > 0u) ? 1u : 0u; mine = (j == x) ? c : mine; }
        if (sum == G) break;
        __builtin_amdgcn_s_sleep(1);
        if ((++sp & 255u) == 0u) { if (xb_ld(&bar[XB_TMO])) break; if (sp > XB_SPIN_CAP) { atomicAdd(&bar[XB_TMO], 1u); break; } }
    }
    nloc = mine > 0u ? mine : 1u; nx = cnt > 0u ? cnt : 1u;
}
__device__ __forceinline__ void xcd_barrier(const XcdBarrier& b) {
    asm volatile("s_waitcnt vmcnt(0)" ::: "memory");
    __syncthreads();
    if (threadIdx.x == 0) {
        unsigned* bar = b.bar;
        __builtin_amdgcn_s_waitcnt(0);
        unsigned nloc = b.st[0], nx = b.st[1];
        if (nloc == 0u) { xcd_barrier_complete(bar, b.x, nloc, nx); b.st[0] = nloc; b.st[1] = nx; }
        const unsigned old = xb_add(&bar[XB_XSUB(b.x)], 1u);
        const unsigned gen = old / nloc;
        if (old + 1u == (gen + 1u) * nloc) {
            __builtin_amdgcn_fence(__ATOMIC_RELEASE, "agent");
            asm volatile("s_waitcnt vmcnt(0)" ::: "memory");
            const unsigned og = xb_add(&bar[XB_TOP], 1u);
            const unsigned tg = og / nx;
            if (og + 1u == (tg + 1u) * nx) xb_add(&bar[XB_TOPGEN], 1u);
            else XB_SPIN(xb_ld(&bar[XB_TOPGEN]) == tg, bar);
            __builtin_amdgcn_fence(__ATOMIC_ACQUIRE, "agent");
            xb_add(&bar[XB_XGEN(b.x)], 1u);
            asm volatile("s_waitcnt vmcnt(0)" ::: "memory");
        } else {
            XB_SPIN(xb_ld(&bar[XB_XGEN(b.x)]) == gen, bar);
            __builtin_amdgcn_fence(__ATOMIC_ACQUIRE, "agent");
            asm volatile("s_waitcnt vmcnt(0)" ::: "memory");
        }
    }
    __syncthreads();
}

__device__ void p0_mod(const Params& p, char* lds) {
  float* s_l = (float*)lds;
  float* red = (float*)(lds + 9 * 64 * 4);
  const int tid = opaque_tid();
  float* MODP = (float*)(p.ws + OFF_MODP);
  for (int job = blockIdx.x; job < 256; job += gridDim.x) {
    const int kg = job >> 4, cg = job & 15, k0 = kg * 64, c0 = cg * 384;
    for (int i = tid; i < 9 * 64; i += NTHR) { const int r = i >> 6, k = k0 + (i & 63); const float v = r < 8 ? p.c[r * 1024 + k] : p.c_ctx[k]; s_l[i] = silu_f(v); }
    __syncthreads();
    const int cq = tid % 96, kr = tid / 96;
    if (kr < 5) {
      f32x4 w[13];
#pragma unroll
      for (int i = 0; i < 13; ++i) { const int kk = kr + 5 * i; w[i] = kk < 64 ? __builtin_nontemporal_load((const f32x4*)(p.w_mod + (size_t)(k0 + kk) * 6144 + c0 + cq * 4)) : (f32x4){0.f, 0.f, 0.f, 0.f}; }
      f32x4 acc[9];
#pragma unroll
      for (int r = 0; r < 9; ++r) acc[r] = (f32x4){0.f, 0.f, 0.f, 0.f};
#pragma unroll
      for (int i = 0; i < 13; ++i) { const int kk = kr + 5 * i; if (kk < 64) {
#pragma unroll
        for (int r = 0; r < 9; ++r) acc[r] += w[i] * s_l[r * 64 + kk]; } }
#pragma unroll
      for (int r = 0; r < 9; ++r) *(f32x4*)(red + ((kr * 96 + cq) * 9 + r) * 4) = acc[r];
    }
    __syncthreads();
    for (int i = tid; i < 96 * 9; i += NTHR) { const int cq2 = i / 9, r = i % 9; f32x4 s = {0.f, 0.f, 0.f, 0.f};
#pragma unroll
      for (int q = 0; q < 5; ++q) s += *(const f32x4*)(red + ((q * 96 + cq2) * 9 + r) * 4);
      *(f32x4*)(MODP + ((size_t)kg * 9 + r) * 6144 + c0 + cq2 * 4) = s; }
    __syncthreads();
  }
}
__device__ void p0_mod_reduce(const Params& p) {
  const float* MODP = (const float*)(p.ws + OFF_MODP); float* mod = (float*)(p.ws + OFF_MOD);
  for (int i = blockIdx.x * NTHR + threadIdx.x; i < 9 * 6144 / 4; i += gridDim.x * NTHR) {
    f32x4 s = *(const f32x4*)(p.b_mod + (i % 1536) * 4);
#pragma unroll
    for (int kg = 0; kg < 16; ++kg) s += *(const f32x4*)(MODP + (size_t)kg * 9 * 6144 + (size_t)i * 4);
    *(f32x4*)(mod + (size_t)i * 4) = s; }
}
__device__ void p0_transpose(const float* __restrict__ src, int K, int N, int Npad, bf16_t* __restrict__ dst, const float* __restrict__ gk, char* lds, int job0, int& jobctr, float f8scale = 0.f) {
  float* tile = (float*)lds;
  const int tid = opaque_tid(), nkt = K / 64, nnt = Npad / 64, ntile = nkt * nnt;
  const int Gd = (int)gridDim.x, first = (((int)blockIdx.x - job0) % Gd + Gd) % Gd;
  for (int tI = first; tI < ntile; tI += Gd) {
    const int kt = tI % nkt, nt = tI / nkt;
    { const int kk = tid >> 3, nc = (tid & 7) * 8; const int n0 = nt * 64 + nc; const float* sp = src + (size_t)(kt * 64 + kk) * N + n0;
      float v[8];
      if (n0 + 8 <= N) { const f32x4 a = __builtin_nontemporal_load((const f32x4*)sp), b = __builtin_nontemporal_load((const f32x4*)(sp + 4));     v[0] = a[0]; v[1] = a[1]; v[2] = a[2]; v[3] = a[3]; v[4] = b[0]; v[5] = b[1]; v[6] = b[2]; v[7] = b[3]; }
      else { for (int j = 0; j < 8; ++j) v[j] = (n0 + j < N) ? sp[j] : 0.f; }
      const float g = gk ? gk[kt * 64 + kk] : 1.f;
      for (int j = 0; j < 8; ++j) tile[kk * 65 + nc + j] = v[j] * g; }
    __syncthreads();
    { const int n = tid >> 3, kc = (tid & 7) * 8; float v[8];
      for (int j = 0; j < 8; ++j) v[j] = tile[(kc + j) * 65 + n];
      if (f8scale < 0.f) { float u_[8];
        for (int j = 0; j < 8; ++j) u_[j] = v[j] * (-0.5f * f8scale);
        *(unsigned*)((unsigned char*)dst + ((size_t)(nt * 64 + n) * K + kt * 64 + kc) / 2) = pk8_fp4(u_); }
      else if (f8scale != 0.f) { u32x2 w = {pk4_fp8(v[0] * f8scale, v[1] * f8scale, v[2] * f8scale, v[3] * f8scale), pk4_fp8(v[4] * f8scale, v[5] * f8scale, v[6] * f8scale, v[7] * f8scale)};
        *(u32x2*)((unsigned char*)dst + (size_t)(nt * 64 + n) * K + kt * 64 + kc) = w; }
      else *(bf16x8*)(dst + (size_t)(nt * 64 + n) * K + kt * 64 + kc) = pack8(v); }
    __syncthreads();
  }
  jobctr = job0 + ntile;
}
__device__ void p0_weff(const Params& p, char* lds) {
  float* ks = (float*)lds;
  float* wq = (float*)(lds + 128 * 129 * 4);
  bf16_t* dst = (bf16_t*)(p.ws + OFF_WEFFT);
  const int tid = opaque_tid();
  for (int job = blockIdx.x; job < 256; job += gridDim.x) {
    const int g = job >> 4, kc = job & 15;
#pragma unroll
    for (int it = 0; it < 8; ++it) { const int i = (it * NTHR + tid) * 4, key = i >> 7, d = i & 127; const f32x4 v = *(const f32x4*)(p.peer_keys + (size_t)g * 16384 + i);
      ks[key * 129 + d] = v[0]; ks[key * 129 + d + 1] = v[1]; ks[key * 129 + d + 2] = v[2]; ks[key * 129 + d + 3] = v[3]; }
#pragma unroll
    for (int it = 0; it < 4; ++it) { const int i = (it * NTHR + tid) * 4, kk = i >> 7, d = i & 127; *(f32x4*)(wq + i) = *(const f32x4*)(p.w_pq + (size_t)(kc * 64 + kk) * 2048 + g * 128 + d); }
    __syncthreads();
    const int key0 = tid & 63, ksub = tid >> 6; float a0[8], a1[8];
#pragma unroll
    for (int j = 0; j < 8; ++j) { a0[j] = 0.f; a1[j] = 0.f; }
    for (int d = 0; d < 128; ++d) { const float k0v = ks[key0 * 129 + d], k1v = ks[(key0 + 64) * 129 + d];
#pragma unroll
      for (int j = 0; j < 8; ++j) { const float wv = wq[(ksub * 8 + j) * 128 + d]; a0[j] = fmaf(k0v, wv, a0[j]); a1[j] = fmaf(k1v, wv, a1[j]); } }
    *(bf16x8*)(dst + (size_t)(g * 128 + key0) * 1024 + kc * 64 + ksub * 8) = pack8(a0);
    *(bf16x8*)(dst + (size_t)(g * 128 + key0 + 64) * 1024 + kc * 64 + ksub * 8) = pack8(a1);
    __syncthreads();
  }
}
__device__ void p0_misc(const Params& p) {
  if (blockIdx.x == 0) {
    float* rope = (float*)(p.ws + OFF_ROPE);
    for (int i = threadIdx.x; i < 1024; i += NTHR) { const int pos = i >> 4, q = i & 15; const float inv = powf(10000.f, -(float)q / 16.f); const float ang = (float)pos * inv; rope[i * 2] = cosf(ang); rope[i * 2 + 1] = sinf(ang); }
    if (threadIdx.x < 64) { const int l = threadIdx.x; float a = wave_sum(p.lq1[l] * p.lk1[l]), b = wave_sum(p.lq2[l] * p.lk2[l]);
      if (l == 0) *(float*)(p.ws + OFF_LAM) = expf(a) - expf(b) + LAMBDA_INIT; }
  }
}
__device__ void p0b_hmod(const Params& p) {
  const float* mod = (const float*)(p.ws + OFF_MOD); unsigned char* h = p.ws + OFF_HMOD;
  const size_t nchunk = (size_t)(T + TC) * 128;
  int mrc = -1; f32x8 sh = {}, sc = {};
  for (size_t i = (size_t)blockIdx.x * NTHR + threadIdx.x; i < nchunk; i += (size_t)gridDim.x * NTHR) {
    const int row = (int)(i >> 7), k = (int)(i & 127) * 8; const float* src; int mr;
    if (row < T) { src = p.x + (size_t)row * 1024 + k; mr = row >> 12; } else { src = p.ctx + (size_t)(row - T) * 1024 + k; mr = 8; }
    const f32x8 xv = __builtin_nontemporal_load((const f32x8*)src);
    if (mr != mrc || ((gridDim.x * NTHR) & 127) != 0) { mrc = mr; sh = *(const f32x8*)(mod + mr * 6144 + k); sc = *(const f32x8*)(mod + mr * 6144 + 1024 + k); }
    float v[8];
#pragma unroll
    for (int j = 0; j < 8; ++j) v[j] = fmaf(xv[j], 1.f + sc[j], sh[j]);
    *(unsigned*)(h + (size_t)row * 512 + k / 2) = pk8_fp4(v);
  }
}

template <int BN> struct GT2 { static constexpr int MI = BN == 256 ? 4 : 2, A_B = 32768, B_B = BN * 128, STAGE = A_B + B_B, LDS = 2 * STAGE; };
template <int BN, int GM = 0, bool SUMSQ = false, class AL, class BL>
__device__ __forceinline__ void gemm_tile2(f32x16 (&acc)[GT2<BN>::MI][2], const AL& al, const BL& bl, int nk, char* lds, float* ssq = nullptr) {
  constexpr int MI = GT2<BN>::MI, STAGE = GT2<BN>::STAGE, A_B = GT2<BN>::A_B, NBI = BN / 64;
  const int tid = opaque_tid(), wid = __builtin_amdgcn_readfirstlane(tid >> 6), lane = tid & 63, r32 = lane & 31, hi = lane >> 5;
  const int wm = BN == 256 ? wid >> 2 : wid >> 1, wn = BN == 256 ? wid & 3 : wid & 1;
  const int srow = 8 * wid + (lane >> 3), sch = (lane & 7) ^ ((srow >> 1) & 7);
  const int swz = ((hi ^ ((r32 >> 1) & 7)) << 4);
  const int aoff = (wm * (MI * 32) + r32) * 128, boff = A_B + (wn * 64 + r32) * 128;
#pragma unroll
  for (int i = 0; i < MI; ++i)
#pragma unroll
    for (int j = 0; j < 2; ++j) acc[i][j] = f32x16{};
  auto stage1 = [&](int s, int kt, int n) {
    char* S = lds + s * STAGE + wid * 1024;
    if (n < 4) __builtin_amdgcn_global_load_lds((const unsigned*)al(srow + 64 * n, kt, sch), (unsigned*)(S + n * 8192), 16, 0, 0);
    else if (n - 4 < NBI) __builtin_amdgcn_global_load_lds((const unsigned*)bl(srow + 64 * (n - 4), kt, sch), (unsigned*)(S + A_B + (n - 4) * 8192), 16, 0, 0);
  };
  auto ldfr = [&](const char* S, int ks, bf16x8 (&fa)[MI], bf16x8 (&fb)[2]) {
    const int co = swz ^ (ks << 5);
#pragma unroll
    for (int i = 0; i < MI; ++i) fa[i] = *(const bf16x8*)(S + aoff + i * 4096 + co);
    fb[0] = *(const bf16x8*)(S + boff + co); fb[1] = *(const bf16x8*)(S + boff + 4096 + co);
  };
#define SB_() __builtin_amdgcn_sched_barrier(0)
  auto mm = [&](const bf16x8 (&fa)[MI], const bf16x8 (&fb)[2], bool pf, int s, int kt, int n0) {
    acc[0][0] = __builtin_amdgcn_mfma_f32_32x32x16_bf16(fa[0], fb[0], acc[0][0], 0, 0, 0);
    acc[0][1] = __builtin_amdgcn_mfma_f32_32x32x16_bf16(fa[0], fb[1], acc[0][1], 0, 0, 0);
    SB_(); if (GM != 1 && pf) stage1(s, kt, n0); SB_();
    acc[1][0] = __builtin_amdgcn_mfma_f32_32x32x16_bf16(fa[1], fb[0], acc[1][0], 0, 0, 0);
    acc[1][1] = __builtin_amdgcn_mfma_f32_32x32x16_bf16(fa[1], fb[1], acc[1][1], 0, 0, 0);
    SB_(); if (GM != 1 && pf) stage1(s, kt, n0 + 1); SB_();
#pragma unroll
    for (int i = 2; i < MI; ++i) {
      acc[i][0] = __builtin_amdgcn_mfma_f32_32x32x16_bf16(fa[i], fb[0], acc[i][0], 0, 0, 0);
      acc[i][1] = __builtin_amdgcn_mfma_f32_32x32x16_bf16(fa[i], fb[1], acc[i][1], 0, 0, 0);
    }
  };
  if (GM != 1) {
#pragma unroll
    for (int n = 0; n < 8; ++n) stage1(0, 0, n); }
  asm volatile("s_waitcnt vmcnt(0)" ::: "memory"); __syncthreads();
  for (int kt = 0; kt < nk; ++kt) {
    const char* S = lds + (kt & 1) * STAGE; const int ns = (kt + 1) & 1; const bool pf = kt + 1 < nk;
    if (GM == 2) { if (pf) {
#pragma unroll
      for (int n = 0; n < 8; ++n) stage1(ns, kt + 1, n); } asm volatile("s_waitcnt vmcnt(0)" ::: "memory"); __syncthreads(); continue; }
    bf16x8 a0[MI], b0[2], a1[MI], b1[2];
    ldfr(S, 0, a0, b0);
    if (SUMSQ) {
      const char* rp_ = S + (tid >> 1) * 128 + (tid & 1) * 64; float s_ = *ssq;
#pragma unroll
      for (int q = 0; q < 4; ++q) { const bf16x8 v_ = *(const bf16x8*)(rp_ + q * 16);
#pragma unroll
        for (int k = 0; k < 8; ++k) { const float f_ = bf2f((bf16_t)v_[k]); s_ = fmaf(f_, f_, s_); } }
      *ssq = s_; }
    ldfr(S, 1, a1, b1); SB_(); mm(a0, b0, pf, ns, kt + 1, 0);
    ldfr(S, 2, a0, b0); SB_(); mm(a1, b1, pf, ns, kt + 1, 2);
    ldfr(S, 3, a1, b1); SB_(); mm(a0, b0, pf, ns, kt + 1, 4);
    SB_(); mm(a1, b1, pf, ns, kt + 1, 6);
    asm volatile("s_waitcnt vmcnt(0)" ::: "memory"); __syncthreads();
  }
#undef SB_
}
template <int GM = 0, class AL, class BL>
__device__ __forceinline__ void gemm_tile8(f32x16 (&acc)[4][2], const AL& al, const BL& bl, int nk, char* lds) {
  constexpr int MI = 4, STAGE = GT2<256>::STAGE, A_B = GT2<256>::A_B;
  const int tid = opaque_tid(), wid = __builtin_amdgcn_readfirstlane(tid >> 6), lane = tid & 63, r32 = lane & 31, hi = lane >> 5;
  const int wm = wid >> 2, wn = wid & 3;
  const int srow = 8 * wid + (lane >> 3), sch = (lane & 7) ^ ((srow >> 1) & 7);
  const int sw = (r32 >> 1) & 7;
  const int aoff = (wm * (MI * 32) + r32) * 128, boff = A_B + (wn * 64 + r32) * 128;
#pragma unroll
  for (int i = 0; i < MI; ++i)
#pragma unroll
    for (int j = 0; j < 2; ++j) acc[i][j] = f32x16{};
  auto stage1 = [&](int s, int kt, int n) {
    char* S = lds + s * STAGE + wid * 1024;
    if (n < 4) __builtin_amdgcn_global_load_lds((const unsigned*)al(srow + 64 * n, kt, sch), (unsigned*)(S + n * 8192), 16, 0, 0);
    else __builtin_amdgcn_global_load_lds((const unsigned*)bl(srow + 64 * (n - 4), kt, sch), (unsigned*)(S + A_B + (n - 4) * 8192), 16, 0, 0);
  };
  auto rd32 = [&](const char* rowp, int ks) { const int c0 = ((4 * ks + 2 * hi) ^ sw) << 4, c1 = ((4 * ks + 2 * hi + 1) ^ sw) << 4;
    const u32x4 lo_ = *(const u32x4*)(rowp + c0), hi_ = *(const u32x4*)(rowp + c1);
    return (i32x8){(int)lo_[0], (int)lo_[1], (int)lo_[2], (int)lo_[3], (int)hi_[0], (int)hi_[1], (int)hi_[2], (int)hi_[3]}; };
#define SB_() __builtin_amdgcn_sched_barrier(0)
#define MF8(A_, B_, C_) C_ = __builtin_amdgcn_mfma_scale_f32_32x32x64_f8f6f4(A_, B_, C_, 0, 0, 0, 0x7f7f7f7f, 0, 0x7f7f7f7f)
  if (GM != 1) {
#pragma unroll
    for (int n = 0; n < 8; ++n) stage1(0, 0, n); }
  asm volatile("s_waitcnt vmcnt(0)" ::: "memory"); __syncthreads();
  for (int kt = 0; kt < nk; ++kt) {
    const char* S = lds + (kt & 1) * STAGE; const int ns = (kt + 1) & 1; const bool pf = kt + 1 < nk;
    i32x8 fa[MI], fb0[2], fb1[2];
#pragma unroll
    for (int i = 0; i < MI; ++i) fa[i] = rd32(S + aoff + i * 4096, 0);
    fb0[0] = rd32(S + boff, 0); fb0[1] = rd32(S + boff + 4096, 0); fb1[0] = rd32(S + boff, 1); fb1[1] = rd32(S + boff + 4096, 1);
    SB_();
#pragma unroll
    for (int i = 0; i < MI; ++i) { MF8(fa[i], fb0[0], acc[i][0]); MF8(fa[i], fb0[1], acc[i][1]); SB_(); fa[i] = rd32(S + aoff + i * 4096, 1); if (GM != 1 && pf) stage1(ns, kt + 1, i); SB_(); }
#pragma unroll
    for (int i = 0; i < MI; ++i) { MF8(fa[i], fb1[0], acc[i][0]); MF8(fa[i], fb1[1], acc[i][1]); SB_(); if (GM != 1 && pf) stage1(ns, kt + 1, 4 + i); SB_(); }
    asm volatile("s_waitcnt vmcnt(0)" ::: "memory"); __syncthreads();
  }
#undef MF8
#undef SB_
}
template <int GM = 0, class AL, class BL>
__device__ __forceinline__ void gemm_tile4(f32x16 (&acc)[4][2], const AL& al, const BL& bl, int nk, char* lds) {
  constexpr int MI = 4, STAGE = GT2<256>::STAGE, A_B = GT2<256>::A_B;
  const int tid = opaque_tid(), wid = __builtin_amdgcn_readfirstlane(tid >> 6), lane = tid & 63, r32 = lane & 31, hi = lane >> 5;
  const int wm = wid >> 2, wn = wid & 3;
  const int srow = 8 * wid + (lane >> 3), sch = (lane & 7) ^ ((srow >> 1) & 7);
  const int sw = (r32 >> 1) & 7;
  const int aoff = (wm * (MI * 32) + r32) * 128, boff = A_B + (wn * 64 + r32) * 128;
#pragma unroll
  for (int i = 0; i < MI; ++i)
#pragma unroll
    for (int j = 0; j < 2; ++j) acc[i][j] = f32x16{};
  auto stage1 = [&](int s, int kt, int n) {
    char* S = lds + s * STAGE + wid * 1024;
    if (n < 4) __builtin_amdgcn_global_load_lds((const unsigned*)al(srow + 64 * n, kt, sch), (unsigned*)(S + n * 8192), 16, 0, 0);
    else __builtin_amdgcn_global_load_lds((const unsigned*)bl(srow + 64 * (n - 4), kt, sch), (unsigned*)(S + A_B + (n - 4) * 8192), 16, 0, 0);
  };
  auto rd16 = [&](const char* rowp, int ks) { const u32x4 a_ = *(const u32x4*)(rowp + (((2 * ks + hi) ^ sw) << 4)); return (i32x8){(int)a_[0], (int)a_[1], (int)a_[2], (int)a_[3], 0, 0, 0, 0}; };
  auto ldfr = [&](const char* S, int ks, i32x8 (&fa)[MI], i32x8 (&fb)[2]) {
#pragma unroll
    for (int i = 0; i < MI; ++i) fa[i] = rd16(S + aoff + i * 4096, ks);
    fb[0] = rd16(S + boff, ks); fb[1] = rd16(S + boff + 4096, ks);
  };
#define SB_() __builtin_amdgcn_sched_barrier(0)
#define MF4(A_, B_, C_) C_ = __builtin_amdgcn_mfma_scale_f32_32x32x64_f8f6f4(A_, B_, C_, 4, 4, 0, 0x7f7f7f7f, 0, 0x7f7f7f7f)
  auto mm = [&](const i32x8 (&fa)[MI], const i32x8 (&fb)[2], bool pf, int s, int kt, int n0) {
    MF4(fa[0], fb[0], acc[0][0]); MF4(fa[0], fb[1], acc[0][1]); MF4(fa[1], fb[0], acc[1][0]); MF4(fa[1], fb[1], acc[1][1]);
    SB_(); if (GM != 1 && pf) stage1(s, kt, n0); SB_();
    MF4(fa[2], fb[0], acc[2][0]); MF4(fa[2], fb[1], acc[2][1]); MF4(fa[3], fb[0], acc[3][0]); MF4(fa[3], fb[1], acc[3][1]);
    SB_(); if (GM != 1 && pf) stage1(s, kt, n0 + 1); SB_();
  };
  if (GM != 1) {
#pragma unroll
    for (int n = 0; n < 8; ++n) stage1(0, 0, n); }
  asm volatile("s_waitcnt vmcnt(0)" ::: "memory"); __syncthreads();
  for (int kt = 0; kt < nk; ++kt) {
    const char* S = lds + (kt & 1) * STAGE; const int ns = (kt + 1) & 1; const bool pf = kt + 1 < nk;
    i32x8 a0[MI], b0[2], a1[MI], b1[2];
    ldfr(S, 0, a0, b0);
    ldfr(S, 1, a1, b1); SB_(); mm(a0, b0, pf, ns, kt + 1, 0);
    ldfr(S, 2, a0, b0); SB_(); mm(a1, b1, pf, ns, kt + 1, 2);
    ldfr(S, 3, a1, b1); SB_(); mm(a0, b0, pf, ns, kt + 1, 4);
    SB_(); mm(a1, b1, pf, ns, kt + 1, 6);
    asm volatile("s_waitcnt vmcnt(0)" ::: "memory"); __syncthreads();
  }
#undef MF4
#undef SB_
}
struct HeadLoader8 {
  const unsigned char* base;
  __device__ __forceinline__ const unsigned char* operator()(int r, int kt, int c) const { return base + ((size_t)kt * 4096 + r) * 128 + c * 16; }
};
struct RowLoader8 {
  const unsigned char* base; int ld;
  __device__ __forceinline__ const unsigned char* operator()(int r, int kt, int c) const { return base + (size_t)r * ld + kt * 128 + c * 16; }
};
struct RowLoader {
  const bf16_t* base; int ld;
  __device__ __forceinline__ const bf16_t* operator()(int r, int kt, int c) const { return base + (size_t)r * ld + kt * 64 + c * 8; }
};
struct HeadLoader {
  const bf16_t* base; int rs;
  __device__ __forceinline__ const bf16_t* operator()(int r, int kt, int c) const { return base + ((size_t)(kt >> 1) * 4096 + r) * rs + (kt & 1) * 64 + c * 8; }
};

__device__ __forceinline__ float dpp_xor1(float v) { return __uint_as_float((unsigned)__builtin_amdgcn_update_dpp(0, (int)__float_as_uint(v), 0xB1, 0xF, 0xF, true)); }
template <int MI, class G>
__device__ __forceinline__ void tile_stage(char* wl, int lane, G get) {
  asm volatile("" : "+v"(lane));
  const int c = lane & 31, hh = lane >> 5; const bool odd = (c & 1) != 0;
  char* lp = wl + ((odd ? 1 : 0) + 4 * hh) * 128 + ((c >> 3) << 4) + ((c & 6) << 1);
  const int oj0 = odd ? 64 : 0, oj1 = 64 - oj0;
#pragma unroll
  for (int i = 0; i < MI; ++i)
#pragma unroll
    for (int rq = 0; rq < 4; ++rq)
#pragma unroll
      for (int kp = 0; kp < 2; ++kp) {
        const int r = rq * 4 + 2 * kp, rowc = i * 32 + 8 * rq + 2 * kp;
        asm volatile("" ::: "memory");
        float a1, a2, b1, b2; get(i, r, a1, a2); get(i, r + 1, b1, b2);
        { const float t = dpp_xor1(odd ? a1 : b1); *(unsigned*)(lp + rowc * 128 + oj0) = cvtpk(odd ? t : a1, odd ? b1 : t); }
        { const float t = dpp_xor1(odd ? a2 : b2); *(unsigned*)(lp + rowc * 128 + oj1) = cvtpk(odd ? t : a2, odd ? b2 : t); }
      }
  asm volatile("s_waitcnt lgkmcnt(0)" ::: "memory");
}
__device__ __forceinline__ const char* tile_rd_ptr(const char* wl, int lane) { asm volatile("" : "+v"(lane)); return wl + (lane >> 3) * 128 + (((lane & 7) ^ (((lane >> 3) & 1) << 2)) << 4); }
template <int MI, int LD, bool DOST = true>
__device__ __forceinline__ void tile_store_bf16(const char* wl, int lane, bf16_t* dst) {
  if (!DOST) return;
  asm volatile("" : "+v"(lane));
  const char* rp = tile_rd_ptr(wl, lane); bf16_t* d = dst + (size_t)(lane >> 3) * LD + (lane & 7) * 8;
#pragma unroll
  for (int it = 0; it < 4 * MI; ++it) *(bf16x8*)(d + (size_t)it * 8 * LD) = *(const bf16x8*)(rp + it * 1024);
}

template <int MI, int LD, bool DOST = true>
__device__ __forceinline__ void tile_store_fp4(const char* wl, int lane, unsigned char* dst) {
  if (!DOST) return;
  asm volatile("" : "+v"(lane));
  const char* rp = tile_rd_ptr(wl, lane); unsigned char* d = dst + (size_t)(lane >> 3) * LD + (lane & 7) * 4;
#pragma unroll
  for (int it = 0; it < 4 * MI; ++it) { const u32x4 w = *(const u32x4*)(rp + it * 1024); float f[8];
#pragma unroll
    for (int k = 0; k < 4; ++k) { f[2 * k] = __uint_as_float(w[k] << 16); f[2 * k + 1] = __uint_as_float(w[k] & 0xffff0000u); }
    *(unsigned*)(d + (size_t)it * 8 * LD) = pk8_fp4(f); }
}
template <int MI, int LD, bool DOST = true>
__device__ __forceinline__ void tile_store_fp8(const char* wl, int lane, unsigned char* dst) {
  if (!DOST) return;
  asm volatile("" : "+v"(lane));
  const char* rp = tile_rd_ptr(wl, lane); unsigned char* d = dst + (size_t)(lane >> 3) * LD + (lane & 7) * 8;
#pragma unroll
  for (int it = 0; it < 4 * MI; ++it) { const u32x4 w = *(const u32x4*)(rp + it * 1024); u32x2 o;
    o[0] = pk4_fp8(__uint_as_float(w[0] << 16), __uint_as_float(w[0] & 0xffff0000u), __uint_as_float(w[1] << 16), __uint_as_float(w[1] & 0xffff0000u));
    o[1] = pk4_fp8(__uint_as_float(w[2] << 16), __uint_as_float(w[2] & 0xffff0000u), __uint_as_float(w[3] << 16), __uint_as_float(w[3] & 0xffff0000u));
    *(u32x2*)(d + (size_t)it * 8 * LD) = o; }
}
template <int GM_ = 0>
__device__ void g1_phase(const Params& p, char* lds) {
  const unsigned char* hmod = p.ws + OFF_HMOD; const unsigned char* wt = p.ws + OFF_WINT; const float* rope = (const float*)(p.ws + OFF_ROPE);
  unsigned char* QA = p.ws + OFF_QA; unsigned char* KA = p.ws + OFF_KA; unsigned char* VAT = p.ws + OFF_VAT; unsigned char* KR = p.ws + OFF_KROPE;
  unsigned char* QL = p.ws + OFF_QLAT; unsigned char* KVL = p.ws + OFF_KVLAT; unsigned char* GT = (unsigned char*)p.out;
  const int tid = opaque_tid(), wid = __builtin_amdgcn_readfirstlane(tid >> 6), lane = tid & 63, r32 = lane & 31, hi = lane >> 5, wm = wid >> 2, wn = wid & 3;
  const int G = gridDim.x, nx = (G % 8 == 0) ? 8 : 1, xg = blockIdx.x % nx, lb = blockIdx.x / nx, nlb = G / nx;
  float* ropel = (float*)(lds + GT2<256>::LDS + 1024);
  for (int i = tid; i < 2048; i += NTHR) ropel[i] = rope[i];
  __syncthreads();
  const int nlat = 128 / nx, nctx = 8 / nx, njobs = nlat * 23 + nctx * 10;
  for (int j = lb; j < njobs; j += nlb) {
    int mt, nt;
    if (j < nlat * 23) { mt = xg + nx * (j / 23); nt = j % 23; } else { const int jj = j - nlat * 23; mt = 128 + xg + nx * (jj / 10); nt = 13 + jj % 10; }
    const bool isctx = mt >= 128;
    const int b = isctx ? mt - 128 : mt >> 4, pos0 = isctx ? 0 : (mt & 15) * 256;
    f32x16 acc[4][2];
    RowLoader8 al{hmod + (size_t)mt * 256 * 512, 512}, bl{wt + (size_t)nt * 256 * 512, 512};
    gemm_tile4(acc, al, bl, 4, lds);
#pragma unroll
    for (int i = 0; i < 4; ++i)
#pragma unroll
      for (int jn = 0; jn < 2; ++jn) acc[i][jn] *= (1.f / (2.f * W8S));
    if (GM_ == 1) { asm volatile("" :: "v"(acc[0][0]), "v"(acc[0][1]), "v"(acc[1][0]), "v"(acc[1][1])); asm volatile("" :: "v"(acc[2][0]), "v"(acc[2][1]), "v"(acc[3][0]), "v"(acc[3][1])); __syncthreads(); continue; }
    const int col0 = nt * 256 + wn * 64;
    const int rw0 = wm * 128;
    const int keyb = isctx ? 0 : 256 + pos0;
    char* wl = lds + wid * 16384;
    int ln = lane; asm volatile("" : "+v"(ln));
    const int r32e = ln & 31, hie = ln >> 5; const bool lo = r32e < 16;
    const float* rp = ropel + (lo ? (((pos0 + rw0) >> 6) << 5) : 4 * hie * 32) + (r32e & 15) * 2;
    const int sA = lo ? 32 : 0, sB = lo ? 0 : 32;
    auto plain = [&](int i, int r, float& x1, float& x2) { x1 = acc[i][0][r]; x2 = acc[i][1][r]; };
    auto sigm = [&](int i, int r, float& x1, float& x2) { x1 = sigmoid_f(acc[i][0][r]); x2 = sigmoid_f(acc[i][1][r]); };
    auto rot = [&](int i, int r, float& x1, float& x2) {
      const int rr = i * 32 + (r & 3) + 8 * (r >> 2); const float* e = rp + (rr >> 6) * sA + (rr & 63) * sB; const float cs = e[0], sn = e[1];
      const float a = acc[i][0][r], bq = acc[i][1][r]; x1 = a * cs - bq * sn; x2 = a * sn + bq * cs; };
    if (col0 < 1024) {
      const int h = col0 >> 7, mp = (col0 >> 6) & 1;
      constexpr float QS = 0.125f * 1.4426950408889634f * 0.5f;
      auto rotq = [&](int i, int r, float& x1, float& x2) { float a, bq; rot(i, r, a, bq); x1 = a * QS; x2 = bq * QS; };
      tile_stage<4>(wl, lane, rotq); tile_store_fp8<4, 128, GM_ != 2>(wl, lane, QA + ((size_t)(b * 8 + h) * 4096 + pos0 + rw0) * 128 + mp * 64);
    } else if (col0 < 1280) {
      tile_stage<4>(wl, lane, plain); tile_store_fp4<4, 128, GM_ != 2>(wl, lane, QL + (size_t)(mt * 256 + rw0) * 128 + (col0 - 1024) / 2);
    } else if (col0 < 3328) {
      tile_stage<4>(wl, lane, sigm); tile_store_fp8<4, 2048, GM_ != 2>(wl, lane, GT + (size_t)(mt * 256 + rw0) * 2048 + (col0 - 1280));
    } else if (col0 < 4352) {
      const int cc = col0 - 3328, h = cc >> 7, mp = (cc >> 6) & 1;
      if (isctx) tile_stage<4>(wl, lane, plain); else tile_stage<4>(wl, lane, rot);
      tile_store_fp4<4, 64, GM_ != 2>(wl, lane, KA + ((size_t)(b * 8 + h) * NKEY + keyb + rw0) * 64 + mp * 32);
    } else if (col0 < 5376) {
      const int cc = col0 - 4352;
      if (GM_ != 2) {
        unsigned char* vb_ = VAT + ((size_t)(b * 8 + (cc >> 7)) * 128 + (cc & 127) + r32e) * (NKEY / 2) + (keyb + rw0) / 2 + 16 * hie;
#pragma unroll
        for (int jn = 0; jn < 2; ++jn)
#pragma unroll
          for (int t2 = 0; t2 < 2; ++t2) { u32x4 w_; float f_[8];
#pragma unroll
            for (int q = 0; q < 2; ++q) {
#pragma unroll
              for (int k = 0; k < 8; ++k) f_[k] = acc[2 * t2][jn][8 * q + k];
              w_[q] = pk8_fp4(f_);
#pragma unroll
              for (int k = 0; k < 8; ++k) f_[k] = acc[2 * t2 + 1][jn][8 * q + k];
              w_[2 + q] = pk8_fp4(f_); }
            *(u32x4*)(vb_ + (size_t)(32 * jn) * (NKEY / 2) + 32 * t2) = w_; }
      }
    } else if (col0 < 5632) {
      tile_stage<4>(wl, lane, plain); tile_store_fp4<4, 128, GM_ != 2>(wl, lane, KVL + ((size_t)b * NKEY + keyb + rw0) * 128 + (col0 - 5376) / 2);
    } else if (col0 < IN_COLS) {
      if (isctx) tile_stage<4>(wl, lane, plain); else tile_stage<4>(wl, lane, rot);
      tile_store_fp4<4, 32, GM_ != 2>(wl, lane, KR + ((size_t)b * NKEY + keyb + rw0) * 32);
    }
    __syncthreads();
  }
}

__device__ void g2_phase(const Params& p, char* lds) {
  const unsigned char* QL = p.ws + OFF_QLAT; const unsigned char* KVL = p.ws + OFF_KVLAT;
  const unsigned char* WQ = p.ws + OFF_WQUPT; const unsigned char* WKV = p.ws + OFF_WKVUPT; const float* rope = (const float*)(p.ws + OFF_ROPE);
  unsigned char* QB = p.ws + OFF_QB; unsigned char* KN = p.ws + OFF_KNOPE; unsigned char* VBT = p.ws + OFF_VBT;
  float* rstd_l = (float*)(lds + GT2<256>::LDS);
  float* ropel = (float*)(lds + GT2<256>::LDS + 1024);
  const int tid = opaque_tid(), wid = __builtin_amdgcn_readfirstlane(tid >> 6), lane = tid & 63, r32 = lane & 31, hi = lane >> 5, wm = wid >> 2, wn = wid & 3;
  const int G = gridDim.x, nx = (G % 8 == 0) ? 8 : 1, xg = blockIdx.x % nx, lb = blockIdx.x / nx, nlb = G / nx;
  const int na = (128 / nx) * 6, nb = (136 / nx) * 8;
  for (int i = opaque_tid(); i < 2048; i += NTHR) ropel[i] = rope[i];
  __syncthreads();
  for (int j = lb; j < na + nb; j += nlb) {
    const bool isq = j < na; int mt, nt;
    if (isq) { mt = xg + nx * (j / 6); nt = j % 6; } else { const int jj = j - na; mt = xg + nx * (jj >> 3); nt = jj & 7; }
    const unsigned char* Ab = (isq ? QL : KVL) + (size_t)mt * 256 * 128;
    f32x16 acc[4][2];
    RowLoader8 al{Ab, 128}, bl{(isq ? WQ : WKV) + (size_t)nt * 256 * 128, 128};
    {
      int tq = opaque_tid(); const unsigned char* rp_ = Ab + (size_t)(tq >> 1) * 128 + (tq & 1) * 64; float ssq = 0.f;
#pragma nounroll
      for (int q = 0; q < 4; ++q) { const u32x4 v_ = *(const u32x4*)(rp_ + q * 16);
#pragma unroll
        for (int k = 0; k < 4; ++k) { const f32x2 f0 = __builtin_amdgcn_cvt_scalef32_pk_f32_fp4(v_[k], 1.0f, 0), f1 = __builtin_amdgcn_cvt_scalef32_pk_f32_fp4(v_[k], 1.0f, 1), f2 = __builtin_amdgcn_cvt_scalef32_pk_f32_fp4(v_[k], 1.0f, 2), f3 = __builtin_amdgcn_cvt_scalef32_pk_f32_fp4(v_[k], 1.0f, 3);
          ssq += (f0[0] * f0[0] + f0[1] * f0[1]) + (f1[0] * f1[0] + f1[1] * f1[1]) + (f2[0] * f2[0] + f2[1] * f2[1]) + (f3[0] * f3[0] + f3[1] * f3[1]); } }
      ssq += __shfl_xor(ssq, 1); if ((tq & 1) == 0) rstd_l[tq >> 1] = rsqrtf(ssq * (1.f / 256.f) + 4.f * EPS) * (1.f / 32.f); }
    { int nk1 = 1; asm volatile("" : "+s"(nk1)); gemm_tile4(acc, al, bl, nk1, lds); }
    __syncthreads();
    const int rw0 = wm * 128;
    int ln = lane; asm volatile("" : "+v"(ln));
    const int r32e = ln & 31, hie = ln >> 5; const bool lo = r32e < 16;
    const float* rsp = rstd_l + rw0 + 4 * hie;
    char* wl = lds + wid * 16384;
    auto scaled = [&](int i, int r, float& x1, float& x2) { const float s = rsp[i * 32 + (r & 3) + 8 * (r >> 2)]; x1 = acc[i][0][r] * s; x2 = acc[i][1][r] * s; };
    constexpr float QSB = 0.07216878364870322f * 1.4426950408889634f * 8.f;
    auto scaledq = [&](int i, int r, float& x1, float& x2) { const float s = rsp[i * 32 + (r & 3) + 8 * (r >> 2)] * QSB; x1 = acc[i][0][r] * s; x2 = acc[i][1][r] * s; };
    if (isq) {
      const int b = mt >> 4, pos0 = (mt & 15) * 256, gidx = nt * 4 + wn, h = gidx / 3, part = gidx % 3;
      const float* rp = ropel + (lo ? (((pos0 + rw0) >> 6) << 5) : 4 * hie * 32) + (r32e & 15) * 2;
      const int sA = lo ? 32 : 0, sB = lo ? 0 : 32;
      auto rot = [&](int i, int r, float& x1, float& x2) {
        const int rr = i * 32 + (r & 3) + 8 * (r >> 2); const float* e = rp + (rr >> 6) * sA + (rr & 63) * sB; const float cs = e[0], sn = e[1], s = rsp[rr] * QSB;
        const float a = acc[i][0][r] * s, bq = acc[i][1][r] * s; x1 = a * cs - bq * sn; x2 = a * sn + bq * cs; };
      if (part == 2) tile_stage<4>(wl, lane, rot); else tile_stage<4>(wl, lane, scaledq);
      tile_store_fp4<4, 96>(wl, lane, QB + ((size_t)(b * 8 + h) * 4096 + pos0 + rw0) * 96 + part * 32);
    } else {
      const int b = mt / 17, key0 = (mt % 17) * 256, col0 = nt * 256 + wn * 64, h = col0 >> 8, part = (col0 >> 7) & 1;
      if (part == 0) { tile_stage<4>(wl, lane, scaled); tile_store_fp4<4, 64>(wl, lane, KN + ((size_t)(b * 8 + h) * NKEY + key0 + rw0) * 64 + (col0 & 127) / 2); }
      else {
        unsigned char* vb_ = VBT + ((size_t)(b * 8 + h) * 128 + (col0 & 127) + r32e) * (NKEY / 2) + (key0 + rw0) / 2 + 16 * hie;
#pragma unroll
        for (int jn = 0; jn < 2; ++jn)
#pragma unroll
          for (int t2 = 0; t2 < 2; ++t2) { u32x4 w_; float f_[8];
#pragma unroll
            for (int q = 0; q < 2; ++q) {
#pragma unroll
              for (int k = 0; k < 8; ++k) { const int r = 8 * q + k; f_[k] = acc[2 * t2][jn][r] * rsp[(2 * t2) * 32 + (r & 3) + 8 * (r >> 2)]; }
              w_[q] = pk8_fp4(f_);
#pragma unroll
              for (int k = 0; k < 8; ++k) { const int r = 8 * q + k; f_[k] = acc[2 * t2 + 1][jn][r] * rsp[(2 * t2 + 1) * 32 + (r & 3) + 8 * (r >> 2)]; }
              w_[2 + q] = pk8_fp4(f_); }
            *(u32x4*)(vb_ + (size_t)(32 * jn) * (NKEY / 2) + 32 * t2) = w_; }
      }
    }
    __syncthreads();
  }
}

#define SBAR() __builtin_amdgcn_sched_barrier(0)
constexpr int A_SHV = 64 * 128 * 2;
constexpr float ATT_THR = 5.5f;
template <int SCALE_ID> struct AttScale;
template <> struct AttScale<0> { static constexpr float v = 0.125f; };
template <> struct AttScale<1> { static constexpr float v = 0.07216878364870322f; };
template <int SID>
__device__ __forceinline__ void partialSM(f32x16& p0, f32x16& p1, float& m_reg, float& mn, float& alpha) {
  constexpr float SC = AttScale<SID>::v; constexpr float C = SC * 1.4426950408889634f;
  float pmax = p0[0];
#pragma unroll
  for (int r = 1; r < 16; ++r) pmax = fmaxf(pmax, p0[r]);
#pragma unroll
  for (int r = 0; r < 16; ++r) pmax = fmaxf(pmax, p1[r]);
  { auto rr = __builtin_amdgcn_permlane32_swap(__float_as_uint(pmax), __float_as_uint(pmax), false, false);
    pmax = fmaxf(__uint_as_float(rr[0]), __uint_as_float(rr[1])); }
  if (__builtin_expect(__all(pmax - m_reg <= ATT_THR / SC), 1)) { mn = m_reg; alpha = 1.f; }
  else { mn = fmaxf(m_reg, pmax); alpha = __builtin_amdgcn_exp2f((m_reg - mn) * C); m_reg = mn; }
  const float mnC = -mn * C;
#pragma unroll
  for (int r = 0; r < 16; ++r) p0[r] = fmaf(p0[r], C, mnC);
#pragma unroll
  for (int r = 0; r < 16; ++r) p1[r] = fmaf(p1[r], C, mnC);
#pragma unroll
  for (int r = 0; r < 16; ++r) p0[r] = __builtin_amdgcn_exp2f(p0[r]);
}
template <bool FIRST>
__device__ __forceinline__ void partialSM_c(f32x16& p0, f32x16& p1, float& M, f32x16& cinit, float& alpha) {
  constexpr float THRL = ATT_THR * 1.4426950408889634f;
  float pmax = p0[0];
#pragma unroll
  for (int r = 1; r < 16; ++r) pmax = fmaxf(pmax, p0[r]);
#pragma unroll
  for (int r = 0; r < 16; ++r) pmax = fmaxf(pmax, p1[r]);
  { auto rr = __builtin_amdgcn_permlane32_swap(__float_as_uint(pmax), __float_as_uint(pmax), false, false);
    pmax = fmaxf(__uint_as_float(rr[0]), __uint_as_float(rr[1])); }
  if (!FIRST && __builtin_expect(__all(pmax <= THRL), 1)) { alpha = 1.f; }
  else { const float d = FIRST ? pmax : fmaxf(pmax, 0.f); alpha = FIRST ? 1.f : __builtin_amdgcn_exp2f(-d); M += d;
#pragma unroll
    for (int r = 0; r < 16; ++r) { p0[r] -= d; p1[r] -= d; }
#pragma unroll
    for (int r = 0; r < 16; ++r) cinit[r] = -M; }
#pragma unroll
  for (int r = 0; r < 16; ++r) p0[r] = __builtin_amdgcn_exp2f(p0[r]);
}
__device__ __forceinline__ void finishSM(f32x16& p0, f32x16& p1, float alpha, float& l_reg, bf16x8& pa0, bf16x8& pa1, bf16x8& pa2, bf16x8& pa3) {
#pragma unroll
  for (int r = 0; r < 16; ++r) p1[r] = __builtin_amdgcn_exp2f(p1[r]);
  float ps = 0;
#pragma unroll
  for (int r = 0; r < 16; ++r) ps += p0[r];
#pragma unroll
  for (int r = 0; r < 16; ++r) ps += p1[r];
  { auto rr = __builtin_amdgcn_permlane32_swap(__float_as_uint(ps), __float_as_uint(ps), false, false);
    ps = __uint_as_float(rr[0]) + __uint_as_float(rr[1]); }
  l_reg = l_reg * alpha + ps;
#define PK4(P, BASE, OUT) do { unsigned a0 = cvtpk(P[BASE + 0], P[BASE + 1]), a1 = cvtpk(P[BASE + 2], P[BASE + 3]);   \
    unsigned b0 = cvtpk(P[BASE + 4], P[BASE + 5]), b1 = cvtpk(P[BASE + 6], P[BASE + 7]);                              \
    auto r0 = __builtin_amdgcn_permlane32_swap(a0, b0, false, false); auto r1 = __builtin_amdgcn_permlane32_swap(a1, b1, false, false); \
    u32x4 w = {r0[0], r1[0], r0[1], r1[1]}; OUT = *reinterpret_cast<bf16x8*>(&w); } while (0)
  PK4(p0, 0, pa0); PK4(p0, 8, pa1); PK4(p1, 0, pa2); PK4(p1, 8, pa3);
#undef PK4
}
__device__ __forceinline__ int v_st(int k, int c) { const int kk = (k & ~0xC) | ((k & 4) << 1) | ((k & 8) >> 1); return ((kk >> 3) * 4 + (c >> 5)) * 512 + ((kk & 7) * 32 + (c & 31)) * 2; }
__device__ __forceinline__ int v_rd_base(int lane) { return ((lane & 3) << 3) | (((lane >> 2) & 3) << 6) | (((lane >> 4) & 1) << 5) | (((lane >> 5) & 1) << 8); }
constexpr int v_rd_off(int d0, int ks, int half) { return d0 * 512 + ks * 4096 + half * 2048; }
template <int OFF> __device__ __forceinline__ s16x4 tr_read(int vb) {
  s16x4 r; asm volatile("ds_read_b64_tr_b16 %0, %1 offset:%2" : "=&v"(r) : "v"(vb), "i"(OFF) : "memory"); return r;
}
template <int D0> __device__ __forceinline__ void pv_one(f32x16& od, int vb, bf16x8 pa0, bf16x8 pa1, bf16x8 pa2, bf16x8 pa3) {
  const s16x4 l0 = tr_read<v_rd_off(D0, 0, 0)>(vb), h0 = tr_read<v_rd_off(D0, 0, 1)>(vb), l1 = tr_read<v_rd_off(D0, 1, 0)>(vb), h1 = tr_read<v_rd_off(D0, 1, 1)>(vb);
  const s16x4 l2 = tr_read<v_rd_off(D0, 2, 0)>(vb), h2 = tr_read<v_rd_off(D0, 2, 1)>(vb), l3 = tr_read<v_rd_off(D0, 3, 0)>(vb), h3 = tr_read<v_rd_off(D0, 3, 1)>(vb);
  asm volatile("s_waitcnt lgkmcnt(0)" ::: "memory"); SBAR();
#define PK(L, H) (bf16x8){L[0], L[1], L[2], L[3], H[0], H[1], H[2], H[3]}
  od = __builtin_amdgcn_mfma_f32_32x32x16_bf16(pa0, PK(l0, h0), od, 0, 0, 0);
  od = __builtin_amdgcn_mfma_f32_32x32x16_bf16(pa1, PK(l1, h1), od, 0, 0, 0);
  od = __builtin_amdgcn_mfma_f32_32x32x16_bf16(pa2, PK(l2, h2), od, 0, 0, 0);
  od = __builtin_amdgcn_mfma_f32_32x32x16_bf16(pa3, PK(l3, h3), od, 0, 0, 0);
#undef PK
}
__device__ __forceinline__ void pv_d0(f32x16* o, int vb, bf16x8 pa0, bf16x8 pa1, bf16x8 pa2, bf16x8 pa3) {
  pv_one<0>(o[0], vb, pa0, pa1, pa2, pa3); pv_one<1>(o[1], vb, pa0, pa1, pa2, pa3); pv_one<2>(o[2], vb, pa0, pa1, pa2, pa3); pv_one<3>(o[3], vb, pa0, pa1, pa2, pa3);
}
template <bool MLA, bool STORE = true, int GH = 0>
__device__ __forceinline__ void attn_job(bf16_t* Qb, const bf16_t* __restrict__ Kh, const bf16_t* __restrict__ Kr, const bf16_t* __restrict__ Vh, float lam, const float* __restrict__ subln, char* lds) {
  constexpr int NQ = MLA ? 12 : 4, KROW = MLA ? 384 : 256, SHK = 64 * KROW, LDQ = MLA ? 192 : 128, SID = MLA ? 1 : 0;
  constexpr int NQR = MLA ? 8 : 4;
  constexpr int L_V = 0, L_K = 3 * A_SHV, L_W = L_K + 2 * SHK, L_Q = L_W + 2048;
  const int tid = opaque_tid(), wid = tid >> 6, lane = tid & 63, r32 = lane & 31, hi = lane >> 5;
  const int mp = MLA ? 0 : (wid >> 2), wrow = MLA ? wid * 32 : (wid & 3) * 32;
  char* V_lds = lds + L_V; char* K_lds = lds + L_K;
  float* wsf = (float*)(lds + L_W) + wid * 64; float* li_l = wsf; float* al_l = wsf + 32;
  char* qsp = lds + L_Q + wid * 4096 + lane * 16;
  float m_reg = MLA ? -1e30f : 0.f, l_reg = 0; f32x16 o[4] = {}; bf16x8 qr[NQR];
  f32x16 cinit = {};
  { const bf16_t* Qw = Qb + (size_t)(wrow + r32) * LDQ + mp * 64 + hi * 8;
#pragma unroll
    for (int d0 = 0; d0 < NQR; ++d0) qr[d0] = *(const bf16x8*)(Qw + d0 * 16);
    if (MLA) {
#pragma unroll
      for (int d0 = NQR; d0 < 12; ++d0) *(bf16x8*)(qsp + (d0 - NQR) * 1024) = *(const bf16x8*)(Qw + d0 * 16); } }
  const bf16_t* vsrc[2]; const bf16_t* ksrc[MLA ? 3 : 2]; bool kr_[MLA ? 3 : 2];
#pragma unroll
  for (int i = 0; i < 2; ++i) { const int sub = 2 * (wid * 2 + i) + (lane >> 5), kk = (sub >> 2) * 8 + ((lane & 31) >> 2), k = (kk & ~0xC) | ((kk & 4) << 1) | ((kk & 8) >> 1);
    vsrc[i] = Vh + (size_t)k * 128 + (sub & 3) * 32 + (lane & 3) * 8; }
#pragma unroll
  for (int i = 0; i < (MLA ? 3 : 2); ++i) { const int off = (wid * (MLA ? 3 : 2) + i) * 1024 + lane * 16, row = off / KROW, ch = ((off % KROW) >> 4) ^ (row & 7);
    if (MLA && ch >= 16) { ksrc[i] = Kr + (size_t)row * 64 + (ch - 16) * 8; kr_[i] = true; } else { ksrc[i] = Kh + (size_t)row * 128 + ch * 8; kr_[i] = false; } }
  auto issue = [&](int tile, int kb, int vbuf) {
    if (GH & 8) return;
#pragma unroll
    for (int i = 0; i < 2; ++i) __builtin_amdgcn_global_load_lds((const unsigned*)(vsrc[i] + (size_t)tile * 64 * 128), (unsigned*)(V_lds + vbuf * A_SHV + (wid * 2 + i) * 1024), 16, 0, 0);
#pragma unroll
    for (int i = 0; i < (MLA ? 3 : 2); ++i) __builtin_amdgcn_global_load_lds((const unsigned*)(ksrc[i] + (size_t)tile * 64 * (kr_[i] ? 64 : 128)), (unsigned*)(K_lds + kb * SHK + (wid * (MLA ? 3 : 2) + i) * 1024), 16, 0, 0);
  };
  const int vb0 = (int)(uintptr_t)V_lds + v_rd_base(lane);
  const int kq0 = r32 * KROW, kxor = (r32 & 7) << 4;
#define TBAR() do { asm volatile("s_waitcnt vmcnt(0)" ::: "memory"); __syncthreads(); } while (0)
#define RESC(a) do { if (__any((a) < 1.f)) { if (hi == 0) al_l[r32] = (a); asm volatile("s_waitcnt lgkmcnt(0)" ::: "memory"); \
    _Pragma("unroll") for (int d = 0; d < 4; ++d) _Pragma("unroll") for (int r = 0; r < 16; ++r) o[d][r] *= al_l[crow(r, hi)]; } } while (0)
#define QKT(P0, P1, bb) do { P0 = f32x16{}; P1 = f32x16{}; if (GH & 4) { asm volatile("" : "+v"(P0), "+v"(P1)); break; } const char* Ks = K_lds + (bb) * SHK;                                                     \
    _Pragma("unroll") for (int d0 = 0; d0 < NQ; ++d0) { const int cb = ((mp * 64 + d0 * 16 + hi * 8) * 2) ^ kxor;                                       \
      const bf16x8 b0 = *(const bf16x8*)(Ks + kq0 + cb), b1 = *(const bf16x8*)(Ks + kq0 + 32 * KROW + cb);                                          \
      const bf16x8 qv = d0 < NQR ? qr[d0 < NQR ? d0 : 0] : *(const bf16x8*)(qsp + (d0 - NQR) * 1024);                                                  \
      P0 = __builtin_amdgcn_mfma_f32_32x32x16_bf16(b0, qv, (!MLA && d0 == 0) ? cinit : P0, 0, 0, 0); P1 = __builtin_amdgcn_mfma_f32_32x32x16_bf16(b1, qv, (!MLA && d0 == 0) ? cinit : P1, 0, 0, 0); } } while (0)
#define PSM(p0_, p1_, m_, mn_, al_) do { if (GH & 1) { mn_ = m_; al_ = 1.f; } else if (MLA) partialSM<SID>(p0_, p1_, m_, mn_, al_); else partialSM_c<false>(p0_, p1_, m_, cinit, al_); } while (0)
#define PSM1(p0_, p1_, m_, mn_, al_) do { if (GH & 1) { mn_ = m_; al_ = 1.f; } else if (MLA) partialSM<SID>(p0_, p1_, m_, mn_, al_); else partialSM_c<true>(p0_, p1_, m_, cinit, al_); } while (0)
#define FSM(p0_, p1_, al_, l_, a0_, a1_, a2_, a3_) do { if (GH & 1) { u32x4 w0_ = {__float_as_uint(p0_[0]), __float_as_uint(p0_[5]), __float_as_uint(p0_[10]), __float_as_uint(p0_[15])}, w1_ = {__float_as_uint(p1_[0]), __float_as_uint(p1_[5]), __float_as_uint(p1_[10]), __float_as_uint(p1_[15])}; \
    a0_ = *reinterpret_cast<bf16x8*>(&w0_); a1_ = *reinterpret_cast<bf16x8*>(&w1_); a2_ = a0_; a3_ = a1_; l_ += al_; } else finishSM(p0_, p1_, al_, l_, a0_, a1_, a2_, a3_); } while (0)
#define PVD(o_, vb_, a0_, a1_, a2_, a3_) do { if (GH & 2) { asm volatile("" :: "v"(a0_), "v"(a1_), "v"(a2_), "v"(a3_)); } else pv_d0(o_, vb_, a0_, a1_, a2_, a3_); } while (0)
  f32x16 pA0, pA1, pB0, pB1; float mnA, mnB, alA, alB; bf16x8 pa0, pa1, pa2, pa3; constexpr int NT = NKEY / 64;
  if (__builtin_amdgcn_readfirstlane(wid) < 4) __builtin_amdgcn_s_setprio(1);
  issue(0, 0, 0); TBAR(); issue(1, 1, 1);
  QKT(pA0, pA1, 0); PSM1(pA0, pA1, m_reg, mnA, alA);
  int vcur = 0, vnext = 2;
  for (int j = 1; j + 1 < NT; j += 2) {
    TBAR(); issue(j + 1, 0, vnext);
    SBAR(); QKT(pB0, pB1, 1);
    FSM(pA0, pA1, alA, l_reg, pa0, pa1, pa2, pa3); SBAR();
    PVD(o, vb0 + vcur * A_SHV, pa0, pa1, pa2, pa3); PSM(pB0, pB1, m_reg, mnB, alB);
    RESC(alB);
    vcur = vcur == 2 ? 0 : vcur + 1; vnext = vnext == 2 ? 0 : vnext + 1;
    TBAR(); if (j + 2 < NT) issue(j + 2, 1, vnext);
    SBAR(); QKT(pA0, pA1, 0);
    FSM(pB0, pB1, alB, l_reg, pa0, pa1, pa2, pa3); SBAR();
    PVD(o, vb0 + vcur * A_SHV, pa0, pa1, pa2, pa3); PSM(pA0, pA1, m_reg, mnA, alA);
    RESC(alA);
    vcur = vcur == 2 ? 0 : vcur + 1; vnext = vnext == 2 ? 0 : vnext + 1;
  }
  TBAR();
  SBAR(); QKT(pB0, pB1, 1);
  FSM(pA0, pA1, alA, l_reg, pa0, pa1, pa2, pa3); SBAR();
  PVD(o, vb0 + vcur * A_SHV, pa0, pa1, pa2, pa3); PSM(pB0, pB1, m_reg, mnB, alB);
  RESC(alB);
  vcur = vcur == 2 ? 0 : vcur + 1;
  FSM(pB0, pB1, alB, l_reg, pa0, pa1, pa2, pa3); SBAR();
  PVD(o, vb0 + vcur * A_SHV, pa0, pa1, pa2, pa3);
  __builtin_amdgcn_s_setprio(0);
  if (hi == 0) li_l[r32] = l_reg; asm volatile("s_waitcnt lgkmcnt(0)" ::: "memory");
  float rli[16];
#pragma unroll
  for (int r = 0; r < 16; ++r) rli[r] = __builtin_amdgcn_rcpf(li_l[crow(r, hi)]);
  bf16_t* Ow = Qb + (size_t)(wrow + 4 * hi) * LDQ + r32;
  if (MLA) {
#pragma unroll
    for (int r = 0; r < 16; ++r) { const int rr = (r & 3) + 8 * (r >> 2);
#pragma unroll
      for (int d0 = 0; d0 < 4; ++d0) { const bf16_t v = f2bf(o[d0][r] * rli[r]); if (STORE) Ow[rr * LDQ + d0 * 32] = v; else asm volatile("" :: "v"(v)); } }
    __syncthreads();
  } else {
    __syncthreads();
    float* X = (float*)lds + (size_t)((wid & 3) * 32 + 4 * hi) * 128 + r32;
    if (mp == 1) {
#pragma unroll
      for (int r = 0; r < 16; ++r) { const int rr = (r & 3) + 8 * (r >> 2);
#pragma unroll
        for (int d0 = 0; d0 < 4; ++d0) X[rr * 128 + d0 * 32] = lam * o[d0][r] * rli[r]; }
    }
    __syncthreads();
    if (mp == 0) {
      float g[4];
#pragma unroll
      for (int d0 = 0; d0 < 4; ++d0) g[d0] = subln[d0 * 32 + r32] * (1.f - LAMBDA_INIT);
#pragma unroll
      for (int r = 0; r < 16; ++r) { const int rr = (r & 3) + 8 * (r >> 2); float od[4]; float s = 0.f;
#pragma unroll
        for (int d0 = 0; d0 < 4; ++d0) { od[d0] = o[d0][r] * rli[r] - X[rr * 128 + d0 * 32]; s = fmaf(od[d0], od[d0], s); }
        s += __shfl_xor(s, 1); s += __shfl_xor(s, 2); s += __shfl_xor(s, 4); s += __shfl_xor(s, 8); s += __shfl_xor(s, 16);
        const float rs = rsqrtf(s * (1.f / 128.f) + EPS);
#pragma unroll
        for (int d0 = 0; d0 < 4; ++d0) { const bf16_t v = f2bf(od[d0] * rs * g[d0]); if (STORE) Ow[rr * LDQ + d0 * 32] = v; else asm volatile("" :: "v"(v)); } }
    }
    __syncthreads();
  }
#undef TBAR
#undef RESC
#undef QKT
#undef PSM
#undef PSM1
#undef FSM
#undef PVD
}
template <bool STORE = true, int GH = 0>
__device__ __forceinline__ void attn_diff8(const unsigned char* __restrict__ Q8, const unsigned char* __restrict__ K8, const unsigned char* __restrict__ VT, unsigned char* __restrict__ Y, float lam, const float* __restrict__ subln, char* lds) {
  constexpr int SHK8 = 64 * 64, SHV8 = 128 * 32, L_V = 0, L_K = 8 * SHV8, L_W = L_K + 4 * SHK8;
  const int tid = opaque_tid(), wid = tid >> 6, lane = tid & 63, r32 = lane & 31, hi = lane >> 5;
  const int mp = wid >> 2, wrow = (wid & 3) * 32;
  char* V_lds = lds + L_V; char* K_lds = lds + L_K;
  float* wsf = (float*)(lds + L_W) + wid * 64; float* al_l = wsf + 32;
  float m_reg = 0.f; f32x16 o[4] = {}, ol = {}; f32x16 cinit = {};
  const char* ones_l = lds + L_W + 2048;
  if (tid < 8) ((unsigned*)(lds + L_W + 2048))[tid] = 0x38383838u;
  i32x8 qf; int sbQ;
  { const unsigned char* qp = Q8 + (size_t)(wrow + r32) * 128 + mp * 64 + hi * 32; const u32x4 a = *(const u32x4*)qp, b = *(const u32x4*)(qp + 16); float qv[32]; float am = 0.f;
#pragma unroll
    for (int k = 0; k < 4; ++k) { qv[4 * k] = __builtin_amdgcn_cvt_f32_fp8((int)a[k], 0); qv[4 * k + 1] = __builtin_amdgcn_cvt_f32_fp8((int)a[k], 1); qv[4 * k + 2] = __builtin_amdgcn_cvt_f32_fp8((int)a[k], 2); qv[4 * k + 3] = __builtin_amdgcn_cvt_f32_fp8((int)a[k], 3);
      qv[16 + 4 * k] = __builtin_amdgcn_cvt_f32_fp8((int)b[k], 0); qv[16 + 4 * k + 1] = __builtin_amdgcn_cvt_f32_fp8((int)b[k], 1); qv[16 + 4 * k + 2] = __builtin_amdgcn_cvt_f32_fp8((int)b[k], 2); qv[16 + 4 * k + 3] = __builtin_amdgcn_cvt_f32_fp8((int)b[k], 3); }
#pragma unroll
    for (int k = 0; k < 32; ++k) am = fmaxf(am, fabsf(qv[k]));
    const int eq = (am > 0.f ? __builtin_amdgcn_frexp_expf(am) : -60) - 2; const float sq = __builtin_amdgcn_exp2f((float)eq); sbQ = (127 + eq) * 0x01010101;
    qf = (i32x8){0, 0, 0, 0, 0, 0, 0, 0};
#pragma unroll
    for (int q = 0; q < 4; ++q) { unsigned w_ = 0;
      w_ = __builtin_amdgcn_cvt_scalef32_pk_fp4_f32(w_, qv[8 * q + 0], qv[8 * q + 1], sq, 0); w_ = __builtin_amdgcn_cvt_scalef32_pk_fp4_f32(w_, qv[8 * q + 2], qv[8 * q + 3], sq, 1);
      w_ = __builtin_amdgcn_cvt_scalef32_pk_fp4_f32(w_, qv[8 * q + 4], qv[8 * q + 5], sq, 2); w_ = __builtin_amdgcn_cvt_scalef32_pk_fp4_f32(w_, qv[8 * q + 6], qv[8 * q + 7], sq, 3); qf[q] = (int)w_; } }
  unsigned koff, voff;
  { const int row = (wid & 3) * 16 + (lane >> 2), c = (lane & 3) ^ ((row >> 2) & 3); koff = (unsigned)(row * 64 + c * 16); }
  { const int d = (wid & 3) * 32 + (lane >> 1), c = (lane & 1) ^ ((d >> 3) & 1); voff = (unsigned)(d * (NKEY / 2) + c * 16); }
  const bool kw_ = __builtin_amdgcn_readfirstlane(wid) < 4;
  auto issue = [&](int tile, int kb, int vbuf) {
    if (GH & 8) return;
    if (kw_) __builtin_amdgcn_global_load_lds((const unsigned*)(K8 + (size_t)(koff + (unsigned)tile * 4096u)), (unsigned*)(K_lds + kb * SHK8 + (wid & 3) * 1024), 16, 0, 0);
    else if (!(GH & 32)) __builtin_amdgcn_global_load_lds((const unsigned*)(VT + (size_t)(voff + (unsigned)tile * 32u)), (unsigned*)(V_lds + vbuf * SHV8 + (wid & 3) * 1024), 16, 0, 0);
  };
  const int kro = r32 * 64, kc0 = ((mp * 2 + hi) ^ ((r32 >> 2) & 3)) << 4;
  const int vro = r32 * 32, vc0 = (hi ^ ((r32 >> 3) & 1)) << 4;
#define PSMC(F_, P0_, P1_, AL_) do { if (GH & 1) { AL_ = 1.f; } else partialSM_c<F_>(P0_, P1_, m_reg, cinit, AL_); } while (0)
#define TBAR() do { asm volatile("s_waitcnt vmcnt(0)" ::: "memory"); if (!(GH & 16)) __syncthreads(); } while (0)
#define RESC(a) do { if (__any((a) < 1.f)) { const float a_ = (a); _Pragma("unroll") for (int d = 0; d < 4; ++d) _Pragma("unroll") for (int r = 0; r < 16; ++r) o[d][r] *= a_; _Pragma("unroll") for (int r = 0; r < 16; ++r) ol[r] *= a_; } } while (0)
#define MF8(A_, B_, C_) __builtin_amdgcn_mfma_scale_f32_32x32x64_f8f6f4(A_, B_, C_, 0, 0, 0, 0x7f7f7f7f, 0, 0x7f7f7f7f)
#define MFK(A_, B_, C_) __builtin_amdgcn_mfma_scale_f32_32x32x64_f8f6f4(A_, B_, C_, 4, 4, 0, 0x7f7f7f7f, 0, sbQ)
#define MFV(P_, V_, C_) __builtin_amdgcn_mfma_scale_f32_32x32x64_f8f6f4(V_, P_, C_, 4, 0, 0, 0x7f7f7f7f, 0, 0x7f7f7f7f)
#define RD16(P_) ({ const u32x4 a_ = *(const u32x4*)(P_); (i32x8){(int)a_[0], (int)a_[1], (int)a_[2], (int)a_[3], 0, 0, 0, 0}; })
#define RD32(P0_, P1_) ({ const u32x4 a_ = *(const u32x4*)(P0_), b_ = *(const u32x4*)(P1_); (i32x8){(int)a_[0], (int)a_[1], (int)a_[2], (int)a_[3], (int)b_[0], (int)b_[1], (int)b_[2], (int)b_[3]}; })
#define QKT(P0, P1, bb) do { const char* Ks = K_lds + (bb) * SHK8 + kro; const i32x8 k0_ = RD16(Ks + kc0), k1_ = RD16(Ks + 32 * 64 + kc0);                                \
    if (GH & 4) { P0 = cinit; P1 = cinit; asm volatile("" : "+v"(P0)); asm volatile("" : "+v"(P1)); asm volatile("" :: "v"(k0_)); asm volatile("" :: "v"(k1_)); asm volatile("" :: "v"(qf)); } else { P0 = MFK(k0_, qf, cinit); P1 = MFK(k1_, qf, cinit); } } while (0)
#define PSMB(F_, p0_, p1_, al_, eb_) do { float pl_ = p0_[0];                                                                                                  \
    _Pragma("unroll") for (int r = 1; r < 16; ++r) pl_ = fmaxf(pl_, p0_[r]); _Pragma("unroll") for (int r = 0; r < 16; ++r) pl_ = fmaxf(pl_, p1_[r]);              \
    float pm_; { auto rr_ = __builtin_amdgcn_permlane32_swap(__float_as_uint(pl_), __float_as_uint(pl_), false, false); pm_ = fmaxf(__uint_as_float(rr_[0]), __uint_as_float(rr_[1])); } \
    if (!(F_) && __builtin_expect(__all(pm_ <= ATT_THR * 1.4426950408889634f), 1)) { al_ = 1.f; }                                                               \
    else { const float d_ = (F_) ? pm_ : fmaxf(pm_, 0.f); al_ = (F_) ? 1.f : __builtin_amdgcn_exp2f(-d_); m_reg += d_; pl_ -= d_;                                 \
      _Pragma("unroll") for (int r = 0; r < 16; ++r) { p0_[r] -= d_; p1_[r] -= d_; } _Pragma("unroll") for (int r = 0; r < 16; ++r) cinit[r] = -m_reg; }         \
    eb_ = fmaxf(ceilf(pl_), -100.f) - 2.f;                         \
    _Pragma("unroll") for (int r = 0; r < 16; ++r) p0_[r] = __builtin_amdgcn_exp2f(p0_[r]); } while (0)
#define FSM4(p0_, p1_, eb_, pf_, sb_) do {                                                                                                                     \
    _Pragma("unroll") for (int r = 0; r < 16; ++r) p1_[r] = __builtin_amdgcn_exp2f(p1_[r]);                                                                      \
    const float sc_ = __builtin_amdgcn_exp2f(eb_); sb_ = (127 + (int)(eb_)) * 0x01010101;                                                                         \
    _Pragma("unroll") for (int q = 0; q < 2; ++q) { unsigned w0_ = 0, w1_ = 0;                                                                                    \
      w0_ = __builtin_amdgcn_cvt_scalef32_pk_fp4_f32(w0_, p0_[8 * q + 0], p0_[8 * q + 1], sc_, 0); w1_ = __builtin_amdgcn_cvt_scalef32_pk_fp4_f32(w1_, p1_[8 * q + 0], p1_[8 * q + 1], sc_, 0); \
      w0_ = __builtin_amdgcn_cvt_scalef32_pk_fp4_f32(w0_, p0_[8 * q + 2], p0_[8 * q + 3], sc_, 1); w1_ = __builtin_amdgcn_cvt_scalef32_pk_fp4_f32(w1_, p1_[8 * q + 2], p1_[8 * q + 3], sc_, 1); \
      w0_ = __builtin_amdgcn_cvt_scalef32_pk_fp4_f32(w0_, p0_[8 * q + 4], p0_[8 * q + 5], sc_, 2); w1_ = __builtin_amdgcn_cvt_scalef32_pk_fp4_f32(w1_, p1_[8 * q + 4], p1_[8 * q + 5], sc_, 2); \
      w0_ = __builtin_amdgcn_cvt_scalef32_pk_fp4_f32(w0_, p0_[8 * q + 6], p0_[8 * q + 7], sc_, 3); w1_ = __builtin_amdgcn_cvt_scalef32_pk_fp4_f32(w1_, p1_[8 * q + 6], p1_[8 * q + 7], sc_, 3); \
      pf_[q] = (int)w0_; pf_[2 + q] = (int)w1_; }                                                                                                                 \
    pf_[4] = 0; pf_[5] = 0; pf_[6] = 0; pf_[7] = 0; } while (0)
#define MFP(V_, P_, C_, SB_) __builtin_amdgcn_mfma_scale_f32_32x32x64_f8f6f4(V_, P_, C_, 4, 4, 0, 0x7f7f7f7f, 0, SB_)
#define FSM8(p0_, p1_, al_, pf_) do { if (GH & 1) { _Pragma("unroll") for (int q = 0; q < 8; ++q) pf_[q] = (int)__float_as_uint(q < 4 ? p0_[4 * q] : p1_[4 * q - 16]); break; }                  \
    _Pragma("unroll") for (int r = 0; r < 16; ++r) p1_[r] = __builtin_amdgcn_exp2f(p1_[r]);                                                                      \
    _Pragma("unroll") for (int q = 0; q < 4; ++q) { pf_[q] = (int)pk4_fp8(p0_[4 * q], p0_[4 * q + 1], p0_[4 * q + 2], p0_[4 * q + 3]); pf_[4 + q] = (int)pk4_fp8(p1_[4 * q], p1_[4 * q + 1], p1_[4 * q + 2], p1_[4 * q + 3]); } } while (0)
#define PV8(vb_, pf_) do { if (GH & 2) { asm volatile("" :: "v"(pf_)); break; } const char* Vs = V_lds + (vb_) * SHV8 + vro;                                      \
    _Pragma("unroll") for (int d0 = 0; d0 < 4; ++d0) { const i32x8 v_ = RD16(Vs + d0 * 1024 + vc0); o[d0] = MFP(v_, pf_, o[d0], sbP); } { const i32x8 on_ = {0x22222222, 0x22222222, 0x22222222, 0x22222222, 0, 0, 0, 0}; ol = MFP(on_, pf_, ol, sbP); } } while (0)
#define ANC2(X, Y) asm volatile("" : "+v"(X), "+v"(Y))
#define ANC3(X, Y, Z) asm volatile("" : "+v"(X), "+v"(Y), "+v"(Z))
#define VFR(vb_, d0) RD16(V_lds + (vb_) * SHV8 + vro + (d0) * 1024 + vc0)
#define PVPSM(vb_, P0_, P1_, AL_, EB_) do {                                                                                                                          \
    i32x8 v0_ = VFR(vb_, 0), v1_ = VFR(vb_, 1); ANC2(P0_, o[0]); SBAR();                                                                                         \
    o[0] = MFP(v0_, pf, o[0], sbP); v0_ = VFR(vb_, 2);                                                                                                                \
    float pm_ = P0_[0]; _Pragma("unroll") for (int r = 1; r < 16; ++r) pm_ = fmaxf(pm_, P0_[r]); ANC3(pm_, o[0], o[1]); SBAR();                                   \
    o[1] = MFP(v1_, pf, o[1], sbP); v1_ = VFR(vb_, 3);                                                                                                                \
    _Pragma("unroll") for (int r = 0; r < 16; ++r) pm_ = fmaxf(pm_, P1_[r]);                                                                                     \
    float pl_ = pm_; { auto rr_ = __builtin_amdgcn_permlane32_swap(__float_as_uint(pm_), __float_as_uint(pm_), false, false); pm_ = fmaxf(__uint_as_float(rr_[0]), __uint_as_float(rr_[1])); } \
    ANC3(pm_, o[1], o[2]); SBAR();                                                                                                                               \
    o[2] = MFP(v0_, pf, o[2], sbP); v0_ = (i32x8){0x22222222, 0x22222222, 0x22222222, 0x22222222, 0, 0, 0, 0}; ANC3(pm_, o[2], v1_); SBAR();                                                                    \
    if (__builtin_expect(__all(pm_ <= ATT_THR * 1.4426950408889634f), 1)) { AL_ = 1.f; }                                                                          \
    else { const float d_ = fmaxf(pm_, 0.f); AL_ = __builtin_amdgcn_exp2f(-d_); m_reg += d_; pl_ -= d_;                                                                      \
      _Pragma("unroll") for (int r = 0; r < 16; ++r) { P0_[r] -= d_; P1_[r] -= d_; } _Pragma("unroll") for (int r = 0; r < 16; ++r) cinit[r] = -m_reg; }         \
    EB_ = fmaxf(ceilf(pl_), -100.f) - 2.f; ANC2(P0_, o[3]); SBAR();                                                                                                                                     \
    o[3] = MFP(v1_, pf, o[3], sbP); _Pragma("unroll") for (int r = 0; r < 8; ++r) P0_[r] = __builtin_amdgcn_exp2f(P0_[r]); ANC3(P0_, o[3], ol); SBAR();                \
    ol = MFP(v0_, pf, ol, sbP); _Pragma("unroll") for (int r = 8; r < 16; ++r) P0_[r] = __builtin_amdgcn_exp2f(P0_[r]); ANC2(P0_, ol); SBAR(); } while (0)
  f32x16 pA0, pA1, pB0, pB1; float alA, alB, ebA = 0.f, ebB = 0.f; int sbP = 0x7f7f7f7f; i32x8 pf; constexpr int NT = NKEY / 64;
  if (__builtin_amdgcn_readfirstlane(wid) < 4) __builtin_amdgcn_s_setprio(1);
  issue(0, 0, 0); issue(1, 1, 1); TBAR(); issue(2, 2, 2); issue(3, 3, 3);
  QKT(pB0, pB1, 0); PSMB(true, pB0, pB1, alB, ebB);
  SBAR(); QKT(pA0, pA1, 1);
  FSM4(pB0, pB1, ebB, pf, sbP); SBAR();
  PV8(0, pf); PSMB(false, pA0, pA1, alA, ebA);
  RESC(alA);
  for (int j = 2; j < NT; j += 2) {
    TBAR(); if (j + 2 < NT) { issue(j + 2, (j + 2) & 3, (j + 2) & 7); issue(j + 3, (j + 3) & 3, (j + 3) & 7); }
    SBAR(); QKT(pB0, pB1, j & 3);
    FSM4(pA0, pA1, ebA, pf, sbP); SBAR();
    if (GH) { PV8((j - 1) & 7, pf); PSMB(false, pB0, pB1, alB, ebB); } else PVPSM((j - 1) & 7, pB0, pB1, alB, ebB);
    RESC(alB);
    SBAR(); QKT(pA0, pA1, (j + 1) & 3);
    FSM4(pB0, pB1, ebB, pf, sbP); SBAR();
    if (GH) { PV8(j & 7, pf); PSMB(false, pA0, pA1, alA, ebA); } else PVPSM(j & 7, pA0, pA1, alA, ebA);
    RESC(alA);
  }
  FSM4(pA0, pA1, ebA, pf, sbP); SBAR();
  PV8((NT - 1) & 7, pf);
  __builtin_amdgcn_s_setprio(0);
#undef TBAR
#undef ANC2
#undef ANC3
#undef VFR
#undef PVPSM
#undef PSMC
#undef RESC
#undef MF8
#undef MFK
#undef MFV
#undef RD16
#undef RD32
#undef QKT
#undef FSM8
#undef PSMB
#undef FSM4
#undef MFP
#undef PV8
  const float rl_ = 0.5f * __builtin_amdgcn_rcpf(ol[0]);
  __syncthreads();
  float* X = (float*)lds + (size_t)((wid & 3) * 32 + r32) * 132 + 4 * hi;
  if (mp == 1) {
#pragma unroll
    for (int d0 = 0; d0 < 4; ++d0)
#pragma unroll
      for (int g = 0; g < 4; ++g) { const float c_ = lam * rl_; const f32x4 v_ = {o[d0][4 * g] * c_, o[d0][4 * g + 1] * c_, o[d0][4 * g + 2] * c_, o[d0][4 * g + 3] * c_}; *(f32x4*)(X + 32 * d0 + 8 * g) = v_; }
  }
  __syncthreads();
  if (mp == 0) {
    float s_ = 0.f;
#pragma unroll
    for (int d0 = 0; d0 < 4; ++d0)
#pragma unroll
      for (int g = 0; g < 4; ++g) { const f32x4 x_ = *(const f32x4*)(X + 32 * d0 + 8 * g);
#pragma unroll
        for (int k = 0; k < 4; ++k) { const float od_ = o[d0][4 * g + k] * rl_ - x_[k]; o[d0][4 * g + k] = od_; s_ = fmaf(od_, od_, s_); } }
    { const auto rr_ = __builtin_amdgcn_permlane32_swap(__float_as_uint(s_), __float_as_uint(s_), false, false); s_ = __uint_as_float(rr_[0]) + __uint_as_float(rr_[1]); }
    const float rs_ = rsqrtf(s_ * (1.f / 128.f) + EPS) * (1.f - LAMBDA_INIT);
    unsigned char* Yq = Y + (size_t)((wid & 3) * 32 + r32) * 128 + 16 * hi;
#pragma unroll
    for (int d0 = 0; d0 < 4; ++d0) { unsigned w_[4];
#pragma unroll
      for (int g = 0; g < 4; ++g) { const f32x4 gg_ = *(const f32x4*)(subln + 32 * d0 + 8 * g + 4 * hi);
        w_[g] = pk4_fp8(o[d0][4 * g] * rs_ * gg_[0], o[d0][4 * g + 1] * rs_ * gg_[1], o[d0][4 * g + 2] * rs_ * gg_[2], o[d0][4 * g + 3] * rs_ * gg_[3]); }
      const auto s0_ = __builtin_amdgcn_permlane32_swap(w_[0], w_[2], false, false), s1_ = __builtin_amdgcn_permlane32_swap(w_[1], w_[3], false, false);
      const u32x4 st_ = {s0_[0], s0_[1], s1_[0], s1_[1]};
      if (STORE) *(u32x4*)(Yq + 32 * d0) = st_; else asm volatile("" :: "v"(st_)); }
  }
  __syncthreads();
}
template <bool STORE = true>
__device__ __forceinline__ void attn_mla8(const unsigned char* __restrict__ Q8, const unsigned char* __restrict__ KN, const unsigned char* __restrict__ KR, const unsigned char* __restrict__ VT, unsigned char* __restrict__ Y, char* lds) {
  constexpr int SHK8 = 64 * 64, SHR8 = 64 * 32, SHV8 = 128 * 32, L_V = 0, L_K = 8 * SHV8, L_R = L_K + 4 * SHK8, L_W = L_R + 4 * SHR8;
  const int tid = opaque_tid(), wid = tid >> 6, lane = tid & 63, r32 = lane & 31, hi = lane >> 5;
  const int wrow = wid * 32;
  char* V_lds = lds + L_V; char* K_lds = lds + L_K; char* R_lds = lds + L_R;
  float* wsf = (float*)(lds + L_W) + wid * 64; float* al_l = wsf + 32;
  float m_reg = 0.f; f32x16 o[4] = {}, ol = {}; f32x16 cinit = {};
  const char* ones_l = lds + L_W + 2048;
  if (tid < 8) ((unsigned*)(lds + L_W + 2048))[tid] = 0x38383838u;
#define RD32(P0_, P1_) ({ const u32x4 a_ = *(const u32x4*)(P0_), b_ = *(const u32x4*)(P1_); (i32x8){(int)a_[0], (int)a_[1], (int)a_[2], (int)a_[3], (int)b_[0], (int)b_[1], (int)b_[2], (int)b_[3]}; })
#define RD16(P_) ({ const u32x4 a_ = *(const u32x4*)(P_); (i32x8){(int)a_[0], (int)a_[1], (int)a_[2], (int)a_[3], 0, 0, 0, 0}; })
  i32x8 qf[3];
  { const unsigned char* qp = Q8 + (size_t)(wrow + r32) * 96 + hi * 16;
#pragma unroll
    for (int s3 = 0; s3 < 3; ++s3) qf[s3] = RD16(qp + s3 * 32); }
  unsigned koff, roff, voff;
  { const int row = (wid & 3) * 16 + (lane >> 2), c = (lane & 3) ^ ((row >> 2) & 3); koff = (unsigned)(row * 64 + c * 16); }
  { const int row = (wid & 3) * 32 + (lane >> 1), c = (lane & 1) ^ ((row >> 3) & 1); roff = (unsigned)(row * 32 + c * 16); }
  { const int d = (wid & 3) * 32 + (lane >> 1), c = (lane & 1) ^ ((d >> 3) & 1); voff = (unsigned)(d * (NKEY / 2) + c * 16); }
  const int swid_ = __builtin_amdgcn_readfirstlane(wid);
  auto issue = [&](int tile, int kb, int vbuf) {
    if (swid_ < 4) __builtin_amdgcn_global_load_lds((const unsigned*)(KN + (size_t)(koff + (unsigned)tile * 4096u)), (unsigned*)(K_lds + kb * SHK8 + (wid & 3) * 1024), 16, 0, 0);
    else __builtin_amdgcn_global_load_lds((const unsigned*)(VT + (size_t)(voff + (unsigned)tile * 32u)), (unsigned*)(V_lds + vbuf * SHV8 + (wid & 3) * 1024), 16, 0, 0);
    if (swid_ < 4 && !(tile & 1)) __builtin_amdgcn_global_load_lds((const unsigned*)(KR + (size_t)(roff + (unsigned)tile * 2048u)), (unsigned*)(R_lds + kb * SHR8 + (wid & 3) * 1024), 16, 0, 0);
  };
  const int kro = r32 * 64, ksw = (r32 >> 2) & 3;
  const int rro = r32 * 32, rc0 = (hi ^ ((r32 >> 3) & 1)) << 4;
  const int vro = r32 * 32, vc0 = (hi ^ ((r32 >> 3) & 1)) << 4;
#define TBAR() do { asm volatile("s_waitcnt vmcnt(0)" ::: "memory"); __syncthreads(); } while (0)
#define RESC(a) do { if (__any((a) < 1.f)) { const float a_ = (a); _Pragma("unroll") for (int d = 0; d < 4; ++d) _Pragma("unroll") for (int r = 0; r < 16; ++r) o[d][r] *= a_; _Pragma("unroll") for (int r = 0; r < 16; ++r) ol[r] *= a_; } } while (0)
#define MF8(A_, B_, C_) __builtin_amdgcn_mfma_scale_f32_32x32x64_f8f6f4(A_, B_, C_, 0, 0, 0, 0x7f7f7f7f, 0, 0x7f7f7f7f)
#define MFK(A_, B_, C_) __builtin_amdgcn_mfma_scale_f32_32x32x64_f8f6f4(A_, B_, C_, 4, 4, 0, 0x7f7f7f7f, 0, 0x7a7a7a7a)
#define MFV(P_, V_, C_) __builtin_amdgcn_mfma_scale_f32_32x32x64_f8f6f4(V_, P_, C_, 4, 0, 0, 0x7f7f7f7f, 0, 0x7f7f7f7f)
#define QKB(P, Ks, Rs) do {                                                                                                                                     \
    _Pragma("unroll") for (int s3 = 0; s3 < 2; ++s3) { const i32x8 k_ = RD16((Ks) + (((2 * s3 + hi) ^ ksw) << 4)); P = s3 == 0 ? MFK(k_, qf[0], cinit) : MFK(k_, qf[1], P); }       \
    { const i32x8 k_ = RD16((Rs) + rc0); P = MFK(k_, qf[2], P); } } while (0)
#define QKT(P0, P1, bb) do { const char* Ks = K_lds + (bb) * SHK8 + kro; const char* Rs = R_lds + (bb) * SHR8 + rro; QKB(P0, Ks, Rs); QKB(P1, Ks + 32 * 64, Rs + 32 * 32); } while (0)
#define PSMB(F_, p0_, p1_, al_, eb_) do { float pl_ = p0_[0];                                                                                                  \
    _Pragma("unroll") for (int r = 1; r < 16; ++r) pl_ = fmaxf(pl_, p0_[r]); _Pragma("unroll") for (int r = 0; r < 16; ++r) pl_ = fmaxf(pl_, p1_[r]);              \
    float pm_; { auto rr_ = __builtin_amdgcn_permlane32_swap(__float_as_uint(pl_), __float_as_uint(pl_), false, false); pm_ = fmaxf(__uint_as_float(rr_[0]), __uint_as_float(rr_[1])); } \
    if (!(F_) && __builtin_expect(__all(pm_ <= ATT_THR * 1.4426950408889634f), 1)) { al_ = 1.f; }                                                               \
    else { const float d_ = (F_) ? pm_ : fmaxf(pm_, 0.f); al_ = (F_) ? 1.f : __builtin_amdgcn_exp2f(-d_); m_reg += d_; pl_ -= d_;                                 \
      _Pragma("unroll") for (int r = 0; r < 16; ++r) { p0_[r] -= d_; p1_[r] -= d_; } _Pragma("unroll") for (int r = 0; r < 16; ++r) cinit[r] = -m_reg; }         \
    eb_ = fmaxf(ceilf(pl_), -100.f) - 2.f;                         \
    _Pragma("unroll") for (int r = 0; r < 16; ++r) p0_[r] = __builtin_amdgcn_exp2f(p0_[r]); } while (0)
#define FSM4(p0_, p1_, eb_, pf_, sb_) do {                                                                                                                     \
    _Pragma("unroll") for (int r = 0; r < 16; ++r) p1_[r] = __builtin_amdgcn_exp2f(p1_[r]);                                                                      \
    const float sc_ = __builtin_amdgcn_exp2f(eb_); sb_ = (127 + (int)(eb_)) * 0x01010101;                                                                         \
    _Pragma("unroll") for (int q = 0; q < 2; ++q) { unsigned w0_ = 0, w1_ = 0;                                                                                    \
      w0_ = __builtin_amdgcn_cvt_scalef32_pk_fp4_f32(w0_, p0_[8 * q + 0], p0_[8 * q + 1], sc_, 0); w1_ = __builtin_amdgcn_cvt_scalef32_pk_fp4_f32(w1_, p1_[8 * q + 0], p1_[8 * q + 1], sc_, 0); \
      w0_ = __builtin_amdgcn_cvt_scalef32_pk_fp4_f32(w0_, p0_[8 * q + 2], p0_[8 * q + 3], sc_, 1); w1_ = __builtin_amdgcn_cvt_scalef32_pk_fp4_f32(w1_, p1_[8 * q + 2], p1_[8 * q + 3], sc_, 1); \
      w0_ = __builtin_amdgcn_cvt_scalef32_pk_fp4_f32(w0_, p0_[8 * q + 4], p0_[8 * q + 5], sc_, 2); w1_ = __builtin_amdgcn_cvt_scalef32_pk_fp4_f32(w1_, p1_[8 * q + 4], p1_[8 * q + 5], sc_, 2); \
      w0_ = __builtin_amdgcn_cvt_scalef32_pk_fp4_f32(w0_, p0_[8 * q + 6], p0_[8 * q + 7], sc_, 3); w1_ = __builtin_amdgcn_cvt_scalef32_pk_fp4_f32(w1_, p1_[8 * q + 6], p1_[8 * q + 7], sc_, 3); \
      pf_[q] = (int)w0_; pf_[2 + q] = (int)w1_; }                                                                                                                 \
    pf_[4] = 0; pf_[5] = 0; pf_[6] = 0; pf_[7] = 0; } while (0)
#define MFP(V_, P_, C_, SB_) __builtin_amdgcn_mfma_scale_f32_32x32x64_f8f6f4(V_, P_, C_, 4, 4, 0, 0x7f7f7f7f, 0, SB_)
#define PV8(vb_, pf_) do { const char* Vs = V_lds + (vb_) * SHV8 + vro;                                                                                          \
    _Pragma("unroll") for (int d0 = 0; d0 < 4; ++d0) { const i32x8 v_ = RD16(Vs + d0 * 1024 + vc0); o[d0] = MFP(v_, pf_, o[d0], sbP); } { const i32x8 on_ = {0x22222222, 0x22222222, 0x22222222, 0x22222222, 0, 0, 0, 0}; ol = MFP(on_, pf_, ol, sbP); } } while (0)
  f32x16 pA0, pA1, pB0, pB1; float alA, alB, ebA = 0.f, ebB = 0.f; int sbP = 0x7f7f7f7f; i32x8 pf; constexpr int NT = NKEY / 64;
  if (__builtin_amdgcn_readfirstlane(wid) < 4) __builtin_amdgcn_s_setprio(1);
  issue(0, 0, 0); issue(1, 1, 1); TBAR(); issue(2, 2, 2); issue(3, 3, 3);
  QKT(pB0, pB1, 0); PSMB(true, pB0, pB1, alB, ebB);
  SBAR(); QKT(pA0, pA1, 1);
  FSM4(pB0, pB1, ebB, pf, sbP); SBAR();
  PV8(0, pf); PSMB(false, pA0, pA1, alA, ebA);
  RESC(alA);
  for (int j = 2; j < NT; j += 2) {
    TBAR(); if (j + 2 < NT) { issue(j + 2, (j + 2) & 3, (j + 2) & 7); issue(j + 3, (j + 3) & 3, (j + 3) & 7); }
    SBAR(); QKT(pB0, pB1, j & 3);
    FSM4(pA0, pA1, ebA, pf, sbP); SBAR();
    PV8((j - 1) & 7, pf); PSMB(false, pB0, pB1, alB, ebB);
    RESC(alB);
    SBAR(); QKT(pA0, pA1, (j + 1) & 3);
    FSM4(pB0, pB1, ebB, pf, sbP); SBAR();
    PV8(j & 7, pf); PSMB(false, pA0, pA1, alA, ebA);
    RESC(alA);
  }
  FSM4(pA0, pA1, ebA, pf, sbP); SBAR();
  PV8((NT - 1) & 7, pf);
  __builtin_amdgcn_s_setprio(0);
#undef TBAR
#undef RESC
#undef MF8
#undef MFK
#undef MFV
#undef RD16
#undef RD32
#undef QKB
#undef QKT
#undef PSMB
#undef FSM4
#undef MFP
#undef PV8
  { const float rl_ = 0.5f * __builtin_amdgcn_rcpf(ol[0]);
    unsigned char* Yq = Y + (size_t)(wrow + r32) * 128 + 16 * hi;
#pragma unroll
    for (int d0 = 0; d0 < 4; ++d0) { unsigned w_[4];
#pragma unroll
      for (int g = 0; g < 4; ++g) w_[g] = pk4_fp8(o[d0][4 * g] * rl_, o[d0][4 * g + 1] * rl_, o[d0][4 * g + 2] * rl_, o[d0][4 * g + 3] * rl_);
      const auto s0_ = __builtin_amdgcn_permlane32_swap(w_[0], w_[2], false, false), s1_ = __builtin_amdgcn_permlane32_swap(w_[1], w_[3], false, false);
      const u32x4 st_ = {s0_[0], s0_[1], s1_[0], s1_[1]};
      if (STORE) *(u32x4*)(Yq + 32 * d0) = st_; else asm volatile("" :: "v"(st_)); } }
  __syncthreads();
}
template <bool STORE, int WHICH = 3, int GH = 0>
__device__ void att_phase(const Params& p, char* lds) {
  const unsigned char* QA = p.ws + OFF_QA; const unsigned char* KA = p.ws + OFF_KA; const unsigned char* VAT = p.ws + OFF_VAT; unsigned char* YA = p.ws + OFF_YA;
  const unsigned char* QB = p.ws + OFF_QB; const unsigned char* KN = p.ws + OFF_KNOPE; const unsigned char* KR = p.ws + OFF_KROPE; const unsigned char* VBT = p.ws + OFF_VBT; unsigned char* YB = p.ws + OFF_YB;
  const float lam = *(const float*)(p.ws + OFF_LAM);
  for (int vb = blockIdx.x; vb < 256; vb += gridDim.x) {
    const int b = vb & 7, lb = vb >> 3, h = lb >> 2, sub = lb & 3; const size_t bh = (size_t)(b * 8 + h);
    if (WHICH & 1) for (int q = 0; q < 4; ++q) attn_mla8<STORE>(QB + (bh * 4096 + (sub * 4 + q) * 256) * 96, KN + bh * NKEY * 64, KR + (size_t)b * NKEY * 32, VBT + bh * 128 * (NKEY / 2), YB + (bh * 4096 + (sub * 4 + q) * 256) * 128, lds);
    if (WHICH & 2) for (int q = 0; q < 8; ++q) attn_diff8<STORE, GH>(QA + (bh * 4096 + (sub * 8 + q) * 128) * 128, KA + bh * NKEY * 64, VAT + bh * 128 * (NKEY / 2), YA + (bh * 4096 + (sub * 8 + q) * 128) * 128, lam, p.subln_g, lds);
  }
}

__device__ __forceinline__ void fp8x8_to_f32(u32x2 w, float* f) {
  f[0] = __builtin_amdgcn_cvt_f32_fp8((int)w[0], 0); f[1] = __builtin_amdgcn_cvt_f32_fp8((int)w[0], 1); f[2] = __builtin_amdgcn_cvt_f32_fp8((int)w[0], 2); f[3] = __builtin_amdgcn_cvt_f32_fp8((int)w[0], 3);
  f[4] = __builtin_amdgcn_cvt_f32_fp8((int)w[1], 0); f[5] = __builtin_amdgcn_cvt_f32_fp8((int)w[1], 1); f[6] = __builtin_amdgcn_cvt_f32_fp8((int)w[1], 2); f[7] = __builtin_amdgcn_cvt_f32_fp8((int)w[1], 3);
}
__device__ void g3_phase(const Params& p, char* lds) {
  const unsigned char* YA = p.ws + OFF_YA; const unsigned char* YB = p.ws + OFF_YB;
  const unsigned char* WA = p.ws + OFF_WPAT; const unsigned char* WBt = p.ws + OFF_WPBT; const unsigned char* GT = (const unsigned char*)p.out; bf16_t* Z = (bf16_t*)(p.ws + OFF_Z); unsigned char* Z8 = p.ws + OFF_Z8;
  const int tid = opaque_tid(), wid = __builtin_amdgcn_readfirstlane(tid >> 6), lane = tid & 63, wm = wid >> 2, wn = wid & 3;
  const int G = gridDim.x, nx = (G % 8 == 0) ? 8 : 1, xg = blockIdx.x % nx, lb = blockIdx.x / nx, nlb = G / nx;
  for (int j = lb; j < (128 / nx) * 4; j += nlb) {
    const int mt = xg + nx * (j >> 2), nt = j & 3, b = mt >> 4, pos0 = (mt & 15) * 256;
    f32x16 acc[4][2];
    int ln = lane; asm volatile("" : "+v"(ln));
    char* wl = lds + wid * 16384; const char* rdp = tile_rd_ptr(wl, ln);
    const size_t t0 = (size_t)mt * 256 + wm * 128 + (ln >> 3); const int n0 = nt * 256 + wn * 64 + (ln & 7) * 8;
    auto plain = [&](int i, int r, float& x1, float& x2) { x1 = acc[i][0][r] * (1.f / W8S); x2 = acc[i][1][r] * (1.f / W8S); };
    { HeadLoader8 al{YA + ((size_t)(b * 8) * 4096 + pos0) * 128}; RowLoader8 bl{WA + (size_t)nt * 256 * 1024, 1024}; gemm_tile8(acc, al, bl, 8, lds); }
    tile_stage<4>(wl, ln, plain);
#pragma unroll
    for (int it = 0; it < 16; ++it) { const bf16x8 v = *(const bf16x8*)(rdp + it * 1024); float g[8], f[8]; fp8x8_to_f32(__builtin_nontemporal_load((const u32x2*)(GT + (t0 + it * 8) * 2048 + n0)), g);
#pragma unroll
      for (int k = 0; k < 8; ++k) f[k] = bf2f((bf16_t)v[k]) * g[k];
      { u32x2 w1_ = {pk4_fp8(f[0], f[1], f[2], f[3]), pk4_fp8(f[4], f[5], f[6], f[7])}; *(u32x2*)(Z8 + (t0 + it * 8) * 1024 + n0) = w1_; }
      if ((it & 3) == 3) asm volatile("" ::: "memory"); }
    __syncthreads();
    { HeadLoader8 al{YB + ((size_t)(b * 8) * 4096 + pos0) * 128}; RowLoader8 bl{WBt + (size_t)nt * 256 * 1024, 1024}; gemm_tile8(acc, al, bl, 8, lds); }
    int ln2 = lane; asm volatile("" : "+v"(ln2));
    const char* rdp2 = tile_rd_ptr(wl, ln2); const size_t t2 = (size_t)mt * 256 + wm * 128 + (ln2 >> 3); const int n2 = nt * 256 + wn * 64 + (ln2 & 7) * 8;
    tile_stage<4>(wl, ln2, plain);
#pragma unroll
    for (int it = 0; it < 16; ++it) { const bf16x8 v = *(const bf16x8*)(rdp2 + it * 1024); float g[8], f[8]; fp8x8_to_f32(__builtin_nontemporal_load((const u32x2*)(GT + (t2 + it * 8) * 2048 + 1024 + n2)), g);
      float zo[8]; fp8x8_to_f32(*(const u32x2*)(Z8 + (t2 + it * 8) * 1024 + n2), zo);
#pragma unroll
      for (int k = 0; k < 8; ++k) f[k] = zo[k] + bf2f((bf16_t)v[k]) * g[k];
      u32x2 w = {pk4_fp8(f[0], f[1], f[2], f[3]), pk4_fp8(f[4], f[5], f[6], f[7])};
      *(u32x2*)(Z8 + (t2 + it * 8) * 1024 + n2) = w;
      if ((it & 1) == 1) asm volatile("" ::: "memory"); }
    __syncthreads();
  }
}
__device__ void g4_phase(const Params& p, char* lds) {
  const unsigned char* Z = p.ws + OFF_Z8; const unsigned char* WO = p.ws + OFF_WOUTT; const float* mod = (const float*)(p.ws + OFF_MOD); bf16_t* R1B = (bf16_t*)(p.ws + OFF_R1B);
  const int tid = opaque_tid(), wid = __builtin_amdgcn_readfirstlane(tid >> 6), lane = tid & 63, r32 = lane & 31, hi = lane >> 5, wm = wid >> 2, wn = wid & 3;
  const int G = gridDim.x, nx = (G % 8 == 0) ? 8 : 1, xg = blockIdx.x % nx, lb = blockIdx.x / nx, nlb = G / nx;
  for (int j = lb; j < (128 / nx) * 4; j += nlb) {
    const int mt = xg + nx * (j >> 2), nt = j & 3, b = mt >> 4;
    f32x16 acc[4][2];
    RowLoader8 al{Z + (size_t)mt * 256 * 1024, 1024}, bl{WO + (size_t)nt * 256 * 1024, 1024};
    gemm_tile8(acc, al, bl, 8, lds);
    int ln = lane; asm volatile("" : "+v"(ln));
    char* wl = lds + wid * 16384; const char* rdp = tile_rd_ptr(wl, ln);
    auto plain = [&](int i, int r, float& x1, float& x2) { x1 = acc[i][0][r] * (1.f / W8S); x2 = acc[i][1][r] * (1.f / W8S); };
    tile_stage<4>(wl, ln, plain);
    const size_t t0 = (size_t)mt * 256 + wm * 128 + (ln >> 3); const int n0 = nt * 256 + wn * 64 + (ln & 7) * 8;
    const f32x8 gt = *(const f32x8*)(mod + b * 6144 + 2048 + n0);
#pragma unroll
    for (int it = 0; it < 16; ++it) { const bf16x8 v = *(const bf16x8*)(rdp + it * 1024); const size_t off = (t0 + it * 8) * 1024 + n0; const f32x8 xv = __builtin_nontemporal_load((const f32x8*)(p.x + off)); f32x8 o;
#pragma unroll
      for (int k = 0; k < 8; ++k) o[k] = fmaf(gt[k], bf2f((bf16_t)v[k]), ALPHA * xv[k]);
      *(bf16x8*)(R1B + off) = pack8((const float*)&o); }
    __syncthreads();
  }
}

template <bool NOATT>
__device__ void ln1_phase(const Params& p) {
  const float* mod = (const float*)(p.ws + OFF_MOD); bf16_t* H2 = (bf16_t*)(p.ws + OFF_H2);
  const int tid = opaque_tid(), wid = tid >> 6, lane = tid & 63;
  { const int gw = blockIdx.x * 8 + wid, nw = gridDim.x * 8;
    f32x4 g[4], bb[4];
#pragma unroll
    for (int j = 0; j < 4; ++j) { const int col = j * 256 + lane * 4; g[j] = *(const f32x4*)(p.ln1_g + col); bb[j] = *(const f32x4*)(p.ln1_b + col); }
    for (int b = 0; b < NB; ++b) {
      f32x4 sh[4], sc[4];
#pragma unroll
      for (int j = 0; j < 4; ++j) { const int col = j * 256 + lane * 4; sh[j] = *(const f32x4*)(mod + b * 6144 + 3072 + col); sc[j] = *(const f32x4*)(mod + b * 6144 + 4096 + col) + 1.f; }
      for (int r = 2 * gw; r < SEQ; r += 2 * nw) {
        f32x4 v[2][4];
#pragma unroll
        for (int u = 0; u < 2; ++u)
#pragma unroll
          for (int j = 0; j < 4; ++j) { const size_t off = (size_t)(b * SEQ + r + u) * 1024 + j * 256 + lane * 4;
            if (NOATT) v[u][j] = *(const f32x4*)(p.x + off) * ALPHA; else { const u32x2 w_ = __builtin_nontemporal_load((const u32x2*)((const bf16_t*)(p.ws + OFF_R1B) + off)); v[u][j] = (f32x4){__uint_as_float(w_[0] << 16), __uint_as_float(w_[0] & 0xffff0000u), __uint_as_float(w_[1] << 16), __uint_as_float(w_[1] & 0xffff0000u)}; } }
#pragma unroll
        for (int u = 0; u < 2; ++u) {
          float s = 0.f;
#pragma unroll
          for (int j = 0; j < 4; ++j) s += (v[u][j][0] + v[u][j][1]) + (v[u][j][2] + v[u][j][3]);
          const float mean = wave_sum(s) * (1.f / 1024.f); float q = 0.f;
#pragma unroll
          for (int j = 0; j < 4; ++j) { const f32x4 d = v[u][j] - mean; q += (d[0] * d[0] + d[1] * d[1]) + (d[2] * d[2] + d[3] * d[3]); }
          const float rstd = rsqrtf(wave_sum(q) * (1.f / 1024.f) + EPS);
#pragma unroll
          for (int j = 0; j < 4; ++j) { const f32x4 x1 = (v[u][j] - mean) * rstd * g[j] + bb[j];
            const f32x4 h = x1 * sc[j] + sh[j]; u32x2 w = {cvtpk(h[0], h[1]), cvtpk(h[2], h[3])}; *(u32x2*)(H2 + (size_t)(b * SEQ + r + u) * 1024 + j * 256 + lane * 4) = w; }
        }
      }
    }
  }
  signed char* U8 = (signed char*)(p.ws + OFF_U8); unsigned char* V8 = (unsigned char*)(p.ws + OFF_V8);
  float* SU = (float*)(p.ws + OFF_SU); float* SV = (float*)(p.ws + OFF_SV); float* SR = (float*)(p.ws + OFF_SR);
  float* SQ = (float*)(p.ws + OFF_SQ);
  for (int row0 = 2 * (blockIdx.x * 8 + wid); row0 < 2 * 16384; row0 += 2 * gridDim.x * 8) {
    f32x4 v[2][4];
#pragma unroll
    for (int u = 0; u < 2; ++u) { const int row = row0 + u; const float* sp = (row < 16384 ? p.peer_u + (size_t)row * 1024 : p.peer_v + (size_t)(row - 16384) * 1024) + lane * 16;
#pragma unroll
      for (int j = 0; j < 4; ++j) v[u][j] = __builtin_nontemporal_load((const f32x4*)(sp + 4 * j)); }
#pragma unroll
    for (int u = 0; u < 2; ++u) { const int row = row0 + u; const bool isu = row < 16384; const int e = isu ? row : row - 16384; float am = 0.f;
#pragma unroll
      for (int j = 0; j < 4; ++j) am = fmaxf(am, fmaxf(fmaxf(fabsf(v[u][j][0]), fabsf(v[u][j][1])), fmaxf(fabsf(v[u][j][2]), fabsf(v[u][j][3]))));
#pragma unroll
      for (int o = 32; o > 0; o >>= 1) am = fmaxf(am, __shfl_xor(am, o));
      {
        float ss = 0.f;
#pragma unroll
        for (int j = 0; j < 4; ++j) ss += (v[u][j][0] * v[u][j][0] + v[u][j][1] * v[u][j][1]) + (v[u][j][2] * v[u][j][2] + v[u][j][3] * v[u][j][3]);
        ss = wave_sum(ss);
        const float step = fminf(am * (1.f / 7.5f), 0.3352f * sqrtf(ss * (1.f / 1024.f))); const float inv = step > 0.f ? 1.f / step : 0.f; u32x2 w; int nsum = 0;
#pragma unroll
        for (int dd = 0; dd < 2; ++dd) { unsigned pk = 0;
#pragma unroll
          for (int k = 0; k < 4; ++k) { int lo_ = (int)floorf(fmaf(v[u][2 * dd][k], inv, 8.f)), hi_ = (int)floorf(fmaf(v[u][2 * dd + 1][k], inv, 8.f));
            lo_ = lo_ < 0 ? 0 : (lo_ > 15 ? 15 : lo_); hi_ = hi_ < 0 ? 0 : (hi_ > 15 ? 15 : hi_); nsum += lo_ + hi_ - 16; pk |= (unsigned)(lo_ | (hi_ << 4)) << (8 * k); }
          w[dd] = pk ^ (isu ? 0x88888888u : 0x80808080u); }
        *(u32x2*)((isu ? (unsigned char*)U8 : V8) + (size_t)e * 512 + lane * 8) = w;
        const float rs_ = wave_sum((float)nsum);
        if (lane == 0) { (isu ? SU : SV)[e] = step; if (isu) SR[e] = rs_; SQ[e * 4 + (isu ? 0 : 1)] = step; if (isu) SQ[e * 4 + 2] = rs_; }
      } }
  }
}

__device__ __forceinline__ int f2key(float f) { const int b = (int)__float_as_uint(f); return b ^ ((b >> 31) & 0x7fffffff); }
__device__ __forceinline__ float key2f(int k) { const int y = k & ~127; return __uint_as_float((unsigned)(y ^ ((y >> 31) & 0x7fffffff))); }
__device__ __forceinline__ void ce_desc(int& a, int& b) { const int hi_ = a > b ? a : b, lo_ = a > b ? b : a; a = hi_; b = lo_; }
__device__ __forceinline__ void bitonic16_desc(int (&x)[16]) {
#pragma unroll
  for (int k = 2; k <= 16; k <<= 1)
#pragma unroll
    for (int j = k >> 1; j > 0; j >>= 1)
#pragma unroll
      for (int i = 0; i < 16; ++i) { const int l = i ^ j; if (l > i) { if ((i & k) == 0) ce_desc(x[i], x[l]); else ce_desc(x[l], x[i]); } }
}
__device__ __forceinline__ void merge16_desc(int (&a)[16], const int (&b)[16]) {
#pragma unroll
  for (int i = 0; i < 16; ++i) a[i] = a[i] > b[15 - i] ? a[i] : b[15 - i];
#pragma unroll
  for (int j = 8; j > 0; j >>= 1)
#pragma unroll
    for (int i = 0; i < 16; ++i) { const int l = i ^ j; if (l > i) ce_desc(a[i], a[l]); }
}
template <int GM_>
__device__ void g5_phase(const Params& p, char* lds) {
  constexpr int GM = GM_ == 3 ? 0 : GM_;
  const bf16_t* wt = (const bf16_t*)(p.ws + OFF_WEFFT); const bf16_t* H2 = (const bf16_t*)(p.ws + OFF_H2); int* IDX = (int*)(p.ws + OFF_IDX); float* WGT = (float*)(p.ws + OFF_WGT);
  const int tid = opaque_tid(), wid = __builtin_amdgcn_readfirstlane(tid >> 6), lane = tid & 63, wm = wid >> 2, wn = wid & 3;
  const int G = gridDim.x, nx = (G % 8 == 0) ? 8 : 1, xg = blockIdx.x % nx, lb = blockIdx.x / nx, nlb = G / nx;
  const int njobs = (128 / nx) * 8;
  int* xl = (int*)lds;
  for (int j = lb; j < njobs; j += nlb) {
    const int nt = xg + nx * (j >> 3), mt = j & 7;
    f32x16 acc[4][2];
    RowLoader al{wt + (size_t)mt * 256 * 1024, 1024}, bl{H2 + (size_t)nt * 256 * 1024, 1024};
    gemm_tile2<256, GM>(acc, al, bl, 16, lds);
    if (GM_ != 0) { asm volatile("" :: "v"(acc[0][0]), "v"(acc[0][1]), "v"(acc[1][0]), "v"(acc[1][1])); asm volatile("" :: "v"(acc[2][0]), "v"(acc[2][1]), "v"(acc[3][0]), "v"(acc[3][1])); continue; }
    int ln = lane; asm volatile("" : "+v"(ln));
    const int r32 = ln & 31, hi64 = (ln >> 5) << 6;
#pragma unroll
    for (int jb = 0; jb < 2; ++jb) {
      int top[16];
#pragma unroll
      for (int i = 0; i < 4; ++i) {
        int x[16];
#pragma unroll
        for (int r = 0; r < 16; ++r) x[r] = (f2key(acc[i][jb][r]) & ~127) | (i * 16 + r);
        bitonic16_desc(x);
        if (i == 0) {
#pragma unroll
          for (int r = 0; r < 16; ++r) top[r] = x[r]; }
        else merge16_desc(top, x);
      }
      int oth[16];
#pragma unroll
      for (int r = 0; r < 16; ++r) { const unsigned v = (unsigned)(top[r] | hi64);
        const auto rr = __builtin_amdgcn_permlane32_swap(v, v, false, false); top[r] = (int)rr[0]; oth[r] = (int)rr[1]; }
      merge16_desc(top, oth);
      int* xp = xl + (wm * 16 + (hi64 ? 8 : 0)) * 256 + wn * 64 + jb * 32 + r32;
#pragma unroll
      for (int r = 0; r < 8; ++r) xp[r * 256] = hi64 ? top[8 + r] : top[r];
    }
    __syncthreads();
    {
      int tk = tid & 255; asm volatile("" : "+v"(tk));
      const bool h1 = wid >= 4;
      float A[16], B[16];
#pragma unroll
      for (int r = 0; r < 16; ++r) { A[r] = key2f(xl[r * 256 + tk]); B[r] = key2f(xl[(16 + r) * 256 + tk]); }
      int L[16];
#pragma unroll
      for (int r = 0; r < 16; ++r) L[r] = (int)0x80000000;
#define INS(i_, jn_) do { int x = (f2key(A[i_] + B[jn_]) & ~255) | ((i_) * 16 + (jn_)); _Pragma("unroll") for (int r = 0; r < 16; ++r) { const int hi_ = L[r] > x ? L[r] : x; x = L[r] > x ? x : L[r]; L[r] = hi_; } } while (0)
      if (!h1) { int pc = 0;
#pragma unroll
        for (int i = 0; i < 16; ++i)
#pragma unroll
          for (int jn = 0; jn < 16; ++jn) { if ((i + 1) * (jn + 1) > 16) continue; if (((pc++) & 1) == 0) INS(i, jn); } }
      else { int pc = 0;
#pragma unroll
        for (int i = 0; i < 16; ++i)
#pragma unroll
          for (int jn = 0; jn < 16; ++jn) { if ((i + 1) * (jn + 1) > 16) continue; if (((pc++) & 1) == 1) INS(i, jn); } }
#undef INS
      int* xl2 = xl + 32 * 256;
      if (h1) {
#pragma unroll
        for (int r = 0; r < 16; ++r) xl2[r * 256 + tk] = L[r]; }
      __syncthreads();
      if (!h1) {
        int O[16];
#pragma unroll
        for (int r = 0; r < 16; ++r) O[r] = xl2[r * 256 + tk];
        merge16_desc(L, O);
        float S[16]; int E[16];
#pragma unroll
        for (int r = 0; r < 16; ++r) { const int code = L[r] & 255, y = L[r] & ~255; S[r] = __uint_as_float((unsigned)(y ^ ((y >> 31) & 0x7fffffff)));
          const int a = xl[(code >> 4) * 256 + tk], bq = xl[(16 + (code & 15)) * 256 + tk]; const int ia = a & 63, ib = bq & 63;
          const int ka = 32 * (ia >> 4) + (ia & 3) + 8 * ((ia >> 2) & 3) + ((a >> 6) & 1) * 4, kb = 32 * (ib >> 4) + (ib & 3) + 8 * ((ib >> 2) & 3) + ((bq >> 6) & 1) * 4;
          E[r] = ka * 128 + kb; }
        const float mx = S[0]; float den = 0.f;
#pragma unroll
        for (int r = 0; r < 16; ++r) { S[r] = __expf(S[r] - mx); den += S[r]; }
        const float rden = 1.f / den;
        const size_t t = (size_t)nt * 256 + tk; int* ip = IDX + t * 128 + mt * 16; float* wp = WGT + t * 128 + mt * 16;
#pragma unroll
        for (int r = 0; r < 16; r += 4) { *(int4*)(ip + r) = make_int4(E[r], E[r + 1], E[r + 2], E[r + 3]); *(float4*)(wp + r) = make_float4(S[r] * rden, S[r + 1] * rden, S[r + 2] * rden, S[r + 3] * rden); }
      }
    }
    __syncthreads();
  }
}

__device__ __forceinline__ float gelu_tanh(float x) { const float u = 0.7978845608028654f * (x + 0.044715f * x * x * x); const float e = __builtin_amdgcn_exp2f(2.885390081777927f * u); const float th = 1.f - 2.f * __builtin_amdgcn_rcpf(e + 1.f); return 0.5f * x * (1.f + th); }
__device__ __forceinline__ int sel2(bool hi, int a, int b) { return hi ? b : a; }
__device__ __forceinline__ int rl_at(int v, int k) { asm volatile("" : "+s"(k)); return __builtin_amdgcn_readlane(v, k); }
template <bool STORE, int GP = 0>
__device__ void gather_phase(const Params& p) {
  const float* mod = (const float*)(p.ws + OFF_MOD); const bf16_t* H2 = (const bf16_t*)(p.ws + OFF_H2);
  const unsigned char* U8 = (const unsigned char*)(p.ws + OFF_U8); const unsigned char* V8 = (const unsigned char*)(p.ws + OFF_V8);
  const float* SU = (const float*)(p.ws + OFF_SU); const float* SV = (const float*)(p.ws + OFF_SV); const float* SR = (const float*)(p.ws + OFF_SR);
  const int* IDX = (const int*)(p.ws + OFF_IDX); const float* WGT = (const float*)(p.ws + OFF_WGT);
  const int tid = opaque_tid(), wid = __builtin_amdgcn_readfirstlane(tid >> 6), lane0 = tid & 63;
  const int tstride = gridDim.x * 8;
  int t = blockIdx.x * 8 + wid;
  int e0 = 0, e1 = 0;
  bf16x8 hxn[4] = {}; float w0n = 0.f, w1n = 0.f;
  if (t < T) { e0 = IDX[(size_t)t * 128 + lane0]; e1 = IDX[(size_t)t * 128 + 64 + lane0]; w0n = WGT[(size_t)t * 128 + lane0]; w1n = WGT[(size_t)t * 128 + 64 + lane0];
#pragma unroll
    for (int q = 0; q < 4; ++q) hxn[q] = *(const bf16x8*)(H2 + (size_t)t * 1024 + (lane0 & 31) * 32 + q * 8); }
#define GSB() do { asm volatile("" ::: "memory"); __builtin_amdgcn_sched_barrier(0); } while (0)
  for (; t < T; t += tstride) {
    const int b = t >> 12;
    int lane = lane0; asm volatile("" : "+v"(lane));
    const int l31 = lane & 31; const bool hiH = lane >= 32;
    const unsigned char* urow = U8 + l31 * 16; const unsigned char* vrow = V8 + l31 * 16;
    int e0v = e0, e1v = e1; asm volatile("" : "+v"(e0v), "+v"(e1v));
    bf16x8 hx[4];
#pragma unroll
    for (int q = 0; q < 4; ++q) hx[q] = hxn[q];
    const float w0 = w0n, w1 = w1n;
    const float su0 = SU[e0], su1 = SU[e1], sv0 = SV[e0], sv1 = SV[e1], sr0 = SR[e0], sr1 = SR[e1];
#define ROW2(ev, k) sel2(hiH, rl_at(ev, (k)), rl_at(ev, 32 + (k)))
    u32x4 uu[16];
#pragma unroll
    for (int k = 0; k < 16; ++k) uu[k] = *(const u32x4*)(urow + (size_t)ROW2(e0, k) * 512);
    GSB();
    int XH[4], XL[4]; float sh, hcorr;
    { float hv[32]; float am = 0.f;
#pragma unroll
      for (int q = 0; q < 4; ++q)
#pragma unroll
        for (int k = 0; k < 8; ++k) { hv[8 * q + k] = bf2f((bf16_t)hx[q][k]); am = fmaxf(am, fabsf(hv[8 * q + k])); }
      am = wave_max(am);
      const float inv = am > 0.f ? 127.f / am : 0.f; sh = am * (1.f / 127.f); int qs = 0;
#pragma unroll
      for (int d = 0; d < 4; ++d) { unsigned ph = 0, pl = 0;
#pragma unroll
        for (int k = 0; k < 4; ++k) { const int qa = (int)rintf(hv[8 * d + k] * inv), qb = (int)rintf(hv[8 * d + 4 + k] * inv); qs += qa + qb;
          ph |= (unsigned)(((qa >> 4) & 15) | (((qb >> 4) & 15) << 4)) << (8 * k); pl |= (unsigned)((qa & 15) | ((qb & 15) << 4)) << (8 * k); }
        XH[d] = (int)ph; XL[d] = (int)(pl ^ 0x88888888u); }
      hcorr = 0.5f * wave_sum(hiH ? 0.f : (float)qs); }
    GSB();
    u32x4 vv[16]; float cc[2]; int part[32];
#define TRSTEP(S, CTRL) do { const bool up = (lane & (S)) != 0;                                                                                                            \
      _Pragma("unroll") for (int i = 0; i < (S); ++i) { const int give = up ? part[i] : part[i + (S)], keep = up ? part[i + (S)] : part[i]; part[i] = keep + __builtin_amdgcn_update_dpp(0, give, CTRL, 0xF, 0xF, true); } } while (0)
#define TREDUCE() do { _Pragma("unroll") for (int i = 0; i < 16; ++i) { auto r_ = __builtin_amdgcn_permlane16_swap((unsigned)part[i], (unsigned)part[i + 16], false, false); part[i] = (int)r_[0] + (int)r_[1]; } \
      TRSTEP(8, 0x140); TRSTEP(4, 0x141); TRSTEP(2, 0x4E); TRSTEP(1, 0xB1); } while (0)
#define UINS(i) do { const u32x4 u = uu[(i) & 15]; int a_ = 0, b_ = 0;                                                                                                      \
      _Pragma("unroll") for (int d = 0; d < 4; ++d) { if (GP & 2) { asm volatile("" :: "v"(u[d])); continue; } a_ = __builtin_amdgcn_sdot8((int)u[d], XH[d], a_, false); b_ = __builtin_amdgcn_sdot8((int)u[d], XL[d], b_, false); } \
      a_ = a_ * 16 + b_;                                                                                                                                                      \
      part[(i) & 31] = a_;                                                                                                                                                    \
      if ((i) + 16 < 64) uu[(i) & 15] = *(const u32x4*)(urow + (size_t)ROW2(((i) + 16) < 32 ? e0 : e1, ((i) + 16) & 31) * 512);                                                  \
      else vv[(i) - 48] = *(const u32x4*)(vrow + (size_t)ROW2(e0v, (i) - 48) * 512);                                                                                          \
      GSB(); } while (0)
#pragma unroll
    for (int i = 0; i < 32; ++i) UINS(i);
    TREDUCE(); cc[0] = w0 * gelu_tanh(sh * su0 * ((float)part[0] + 8.f * sr0 + hcorr)) * sv0; GSB();
#pragma unroll
    for (int i = 32; i < 64; ++i) UINS(i);
#undef UINS
    TREDUCE(); cc[1] = w1 * gelu_tanh(sh * su1 * ((float)part[0] + 8.f * sr1 + hcorr)) * sv1;
#undef TREDUCE
#undef TRSTEP
    const int tn = t + tstride < T ? t + tstride : t;
    const int e0n = IDX[(size_t)tn * 128 + lane], e1n = IDX[(size_t)tn * 128 + 64 + lane];
    w0n = WGT[(size_t)tn * 128 + lane]; w1n = WGT[(size_t)tn * 128 + 64 + lane];
#pragma unroll
    for (int q = 0; q < 4; ++q) hxn[q] = *(const bf16x8*)(H2 + (size_t)tn * 1024 + l31 * 32 + q * 8);
    const float cm = wave_max(fmaxf(fabsf(cc[0]), fabsf(cc[1])));
    const float cinv = cm > 0.f ? 127.f / cm : 0.f;
    const int cq0 = (int)rintf(cc[0] * cinv), cq1 = (int)rintf(cc[1] * cinv);
    const float csum = wave_sum((float)(cq0 + cq1));
    int accL[16], accB[16];
#pragma unroll
    for (int k = 0; k < 16; ++k) { accL[k] = 0; accB[k] = 0; }
    int cb = l31 * 32 + (lane >> 5) * 16; asm volatile("" : "+v"(cb));
    u32x4 r1w[2];
    GSB();
#pragma unroll
    for (int i = 0; i < 64; ++i) {
      const int c0_ = ROW2(i < 32 ? cq0 : cq1, i & 31) & 0xff, c1_ = c0_ << 8, c2_ = c0_ << 16, c3_ = c0_ << 24;
#pragma unroll
      for (int d = 0; d < 4; ++d) { const int x = (int)vv[i & 15][d]; const int lo_ = x & 0x0f0f0f0f; if (GP & 1) { asm volatile("" :: "v"(lo_), "s"(c1_), "s"(c2_), "s"(c3_)); continue; }
        accL[4 * d + 0] = __builtin_amdgcn_sdot4(lo_, c0_, accL[4 * d + 0], false); accL[4 * d + 1] = __builtin_amdgcn_sdot4(lo_, c1_, accL[4 * d + 1], false);
        accL[4 * d + 2] = __builtin_amdgcn_sdot4(lo_, c2_, accL[4 * d + 2], false); accL[4 * d + 3] = __builtin_amdgcn_sdot4(lo_, c3_, accL[4 * d + 3], false);
        accB[4 * d + 0] = __builtin_amdgcn_sdot4(x, c0_, accB[4 * d + 0], false); accB[4 * d + 1] = __builtin_amdgcn_sdot4(x, c1_, accB[4 * d + 1], false);
        accB[4 * d + 2] = __builtin_amdgcn_sdot4(x, c2_, accB[4 * d + 2], false); accB[4 * d + 3] = __builtin_amdgcn_sdot4(x, c3_, accB[4 * d + 3], false); }
      if (i + 16 < 64) vv[i & 15] = *(const u32x4*)(vrow + (size_t)ROW2((i + 16) < 32 ? e0v : e1v, (i + 16) & 31) * 512);
      else if (i < 50) r1w[i - 48] = *(const u32x4*)((const bf16_t*)(p.ws + OFF_R1B) + (size_t)t * 1024 + cb + (i - 48) * 8);
      GSB();
    }
#undef ROW2
    float fin[16];
    { const float cs = cm * (1.f / 127.f);
#pragma unroll
      for (int m = 0; m < 8; ++m) { auto rl_ = __builtin_amdgcn_permlane32_swap((unsigned)accL[m], (unsigned)accL[m + 8], false, false); auto rb_ = __builtin_amdgcn_permlane32_swap((unsigned)accB[m], (unsigned)accB[m + 8], false, false);
        const int L_ = (int)rl_[0] + (int)rl_[1], B_ = (int)rb_[0] + (int)rb_[1];
        fin[8 * (m >> 2) + (m & 3)] = cs * ((float)L_ - 7.5f * csum); fin[8 * (m >> 2) + 4 + (m & 3)] = cs * ((float)(B_ - L_) * 0.0625f + 0.5f * csum); } }
    float r2[16]; float s = 0.f;
    { float s1 = 0.f; f32x4 r1v[4];
#pragma unroll
      for (int q = 0; q < 4; ++q) { const unsigned a_ = r1w[q >> 1][2 * (q & 1)], b_ = r1w[q >> 1][2 * (q & 1) + 1]; r1v[q] = (f32x4){__uint_as_float(a_ << 16), __uint_as_float(a_ & 0xffff0000u), __uint_as_float(b_ << 16), __uint_as_float(b_ & 0xffff0000u)}; }
#pragma unroll
      for (int q = 0; q < 4; ++q) s1 += (r1v[q][0] + r1v[q][1]) + (r1v[q][2] + r1v[q][3]);
      const float m1 = wave_sum(s1) * (1.f / 1024.f); float q1 = 0.f;
#pragma unroll
      for (int q = 0; q < 4; ++q) { const f32x4 d = r1v[q] - m1; q1 += (d[0] * d[0] + d[1] * d[1]) + (d[2] * d[2] + d[3] * d[3]); }
      const float rs1 = rsqrtf(wave_sum(q1) * (1.f / 1024.f) + EPS);
#pragma unroll
      for (int q = 0; q < 4; ++q) { const int col = cb + q * 4; const f32x4 g1 = *(const f32x4*)(p.ln1_g + col), b1 = *(const f32x4*)(p.ln1_b + col), g2 = *(const f32x4*)(mod + b * 6144 + 5120 + col);
#pragma unroll
        for (int k = 0; k < 4; ++k) { const float x1 = (r1v[q][k] - m1) * rs1 * g1[k] + b1[k]; r2[q * 4 + k] = fmaf(g2[k], fin[q * 4 + k], ALPHA * x1); s += r2[q * 4 + k]; } } }
    const float mean = wave_sum(s) * (1.f / 1024.f); float qq = 0.f;
#pragma unroll
    for (int k = 0; k < 16; ++k) { const float d = r2[k] - mean; qq = fmaf(d, d, qq); }
    const float rstd = rsqrtf(wave_sum(qq) * (1.f / 1024.f) + EPS);
#pragma unroll
    for (int q = 0; q < 4; ++q) { const int col = cb + q * 4; const f32x4 g = *(const f32x4*)(p.ln2_g + col), bb = *(const f32x4*)(p.ln2_b + col); f32x4 o;
#pragma unroll
      for (int k = 0; k < 4; ++k) o[k] = (r2[q * 4 + k] - mean) * rstd * g[k] + bb[k];
      if (STORE) *(f32x4*)(p.out + (size_t)t * 1024 + col) = o; else asm volatile("" :: "v"(o)); }
    e0 = e0n; e1 = e1n;
  }
#undef GSB
}

constexpr size_t OFF_GPK = OFF_QA;
constexpr size_t OFF_GCM = OFF_QA + 16 * MiB;
template <int PASS>
__device__ void gather2_phase(const Params& p, char* lds) {
  const float* mod = (const float*)(p.ws + OFF_MOD); const bf16_t* H2 = (const bf16_t*)(p.ws + OFF_H2);
  const unsigned char* U8 = (const unsigned char*)(p.ws + OFF_U8); const unsigned char* V8 = (const unsigned char*)(p.ws + OFF_V8);
  const float* SU = (const float*)(p.ws + OFF_SU); const float* SV = (const float*)(p.ws + OFF_SV); const float* SR = (const float*)(p.ws + OFF_SR);
  const int* IDX = (const int*)(p.ws + OFF_IDX); const float* WGT = (const float*)(p.ws + OFF_WGT);
  int* GPK = (int*)(p.ws + OFF_GPK); f32x2* GCM = (f32x2*)(p.ws + OFF_GCM);
  const int tid = opaque_tid(), wid = __builtin_amdgcn_readfirstlane(tid >> 6), lane0 = tid & 63;
  const int tstride = gridDim.x * 8;
  int t = blockIdx.x * 8 + wid;
  float* pl = (float*)lds;
  if (PASS == 2) {
    for (int c = tid; c < 1024; c += NTHR) { const int idx = ((((c >> 2) & 3) * 64) + (((c >> 4) & 1) * 32 + (c >> 5))) * 4 + (c & 3);
      pl[idx] = p.ln1_g[c]; pl[1024 + idx] = p.ln1_b[c]; pl[2048 + idx] = p.ln2_g[c]; pl[3072 + idx] = p.ln2_b[c];
      for (int bq = 0; bq < NB; ++bq) pl[4096 + bq * 1024 + idx] = mod[bq * 6144 + 5120 + c]; }
    __syncthreads();
  }
  if (t >= T) return;
#define GSB() do { asm volatile("" ::: "memory"); __builtin_amdgcn_sched_barrier(0); } while (0)
#define ROW2(ev, k) sel2(hiH, rl_at(ev, (k)), rl_at(ev, 32 + (k)))
  if (PASS == 1) {
    int e0 = IDX[(size_t)t * 128 + lane0], e1 = IDX[(size_t)t * 128 + 64 + lane0];
    float w0n = WGT[(size_t)t * 128 + lane0], w1n = WGT[(size_t)t * 128 + 64 + lane0];
    bf16x8 hxn[4];
#pragma unroll
    for (int q = 0; q < 4; ++q) hxn[q] = *(const bf16x8*)(H2 + (size_t)t * 1024 + (lane0 & 31) * 32 + q * 8);
    u32x4 uu[8];
    { const bool hiH = lane0 >= 32; const unsigned char* urow = U8 + (lane0 & 31) * 16;
#pragma unroll
      for (int k = 0; k < 8; ++k) uu[k] = *(const u32x4*)(urow + (size_t)ROW2(e0, k) * 512); }
    GSB();
    for (; t < T; t += tstride) {
      int lane = lane0; asm volatile("" : "+v"(lane));
      const int l31 = lane & 31; const bool hiH = lane >= 32;
      const unsigned char* urow = U8 + l31 * 16;
      bf16x8 hx[4];
#pragma unroll
      for (int q = 0; q < 4; ++q) hx[q] = hxn[q];
      const float w0 = w0n, w1 = w1n;
      const int tn = t + tstride < T ? t + tstride : t;
      const int e0n = IDX[(size_t)tn * 128 + lane], e1n = IDX[(size_t)tn * 128 + 64 + lane];
      w0n = __builtin_nontemporal_load(WGT + (size_t)tn * 128 + lane); w1n = __builtin_nontemporal_load(WGT + (size_t)tn * 128 + 64 + lane);
#pragma unroll
      for (int q = 0; q < 4; ++q) hxn[q] = *(const bf16x8*)(H2 + (size_t)tn * 1024 + l31 * 32 + q * 8);
      const f32x4 sq0 = *(const f32x4*)((const float*)(p.ws + OFF_SQ) + (size_t)e0 * 4), sq1 = *(const f32x4*)((const float*)(p.ws + OFF_SQ) + (size_t)e1 * 4);
      const float su0 = sq0[0], su1 = sq1[0], sv0 = sq0[1], sv1 = sq1[1], sr0 = sq0[2], sr1 = sq1[2];
      GSB();
    int XH[4], XL[4]; float sh, hcorr;
    { float hv[32]; float am = 0.f;
#pragma unroll
      for (int q = 0; q < 4; ++q)
#pragma unroll
        for (int k = 0; k < 8; ++k) { hv[8 * q + k] = bf2f((bf16_t)hx[q][k]); am = fmaxf(am, fabsf(hv[8 * q + k])); }
      am = wave_max(am);
      const float inv = am > 0.f ? 127.f / am : 0.f; sh = am * (1.f / 127.f); int qs = 0;
#pragma unroll
      for (int d = 0; d < 4; ++d) { unsigned ph = 0, pl = 0;
#pragma unroll
        for (int k = 0; k < 4; ++k) { const int qa = (int)rintf(hv[8 * d + k] * inv), qb = (int)rintf(hv[8 * d + 4 + k] * inv); qs += qa + qb;
          ph |= (unsigned)(((qa >> 4) & 15) | (((qb >> 4) & 15) << 4)) << (8 * k); pl |= (unsigned)((qa & 15) | ((qb & 15) << 4)) << (8 * k); }
        XH[d] = (int)ph; XL[d] = (int)(pl ^ 0x88888888u); }
      hcorr = 0.5f * wave_sum(hiH ? 0.f : (float)qs); }
      GSB();
      float cc[2]; int part[32];
#define TRSTEP(S, CTRL) do { const bool up = (lane & (S)) != 0;                                                                                                            \
      _Pragma("unroll") for (int i = 0; i < (S); ++i) { const int give = up ? part[i] : part[i + (S)], keep = up ? part[i + (S)] : part[i]; part[i] = keep + __builtin_amdgcn_update_dpp(0, give, CTRL, 0xF, 0xF, true); } } while (0)
#define TREDUCE() do { _Pragma("unroll") for (int i = 0; i < 16; ++i) { auto r_ = __builtin_amdgcn_permlane16_swap((unsigned)part[i], (unsigned)part[i + 16], false, false); part[i] = (int)r_[0] + (int)r_[1]; } \
      TRSTEP(8, 0x140); TRSTEP(4, 0x141); TRSTEP(2, 0x4E); TRSTEP(1, 0xB1); } while (0)
#define UINS(i) do { const u32x4 u = uu[(i) & 7]; int a_ = 0, b_ = 0;                                                                                                      \
      _Pragma("unroll") for (int d = 0; d < 4; ++d) { a_ = __builtin_amdgcn_sdot8((int)u[d], XH[d], a_, false); b_ = __builtin_amdgcn_sdot8((int)u[d], XL[d], b_, false); } \
      a_ = a_ * 16 + b_;                                                                                                                                                      \
      part[(i) & 31] = a_;                                                                                                                                                    \
      if ((i) + 8 < 64) uu[(i) & 7] = *(const u32x4*)(urow + (size_t)ROW2(((i) + 8) < 32 ? e0 : e1, ((i) + 8) & 31) * 512);                                                  \
      else uu[(i) & 7] = *(const u32x4*)(urow + (size_t)ROW2(e0n, (i) - 56) * 512);                                                                                          \
      GSB(); } while (0)
#pragma unroll
      for (int i = 0; i < 32; ++i) UINS(i);
      TREDUCE(); cc[0] = w0 * gelu_tanh(sh * su0 * ((float)part[0] + 8.f * sr0 + hcorr)) * sv0; GSB();
#pragma unroll
      for (int i = 32; i < 64; ++i) UINS(i);
#undef UINS
      TREDUCE(); cc[1] = w1 * gelu_tanh(sh * su1 * ((float)part[0] + 8.f * sr1 + hcorr)) * sv1;
#undef TREDUCE
#undef TRSTEP
      const float cm = wave_max(fmaxf(fabsf(cc[0]), fabsf(cc[1])));
      const float cinv = cm > 0.f ? 127.f / cm : 0.f;
      const int cq0 = (int)rintf(cc[0] * cinv), cq1 = (int)rintf(cc[1] * cinv);
      const float csum = wave_sum((float)(cq0 + cq1));
      GPK[(size_t)t * 64 + lane] = (cq0 & 0xff) | ((cq1 & 0xff) << 8);
      if (lane == 0) GCM[t] = (f32x2){cm, csum};
      e0 = e0n; e1 = e1n;
    }
  } else {
    int e0v = IDX[(size_t)t * 128 + lane0], e1v = IDX[(size_t)t * 128 + 64 + lane0];
    int pk = GPK[(size_t)t * 64 + lane0]; f32x2 cmv = GCM[t];
    u32x4 vv[16];
    { const bool hiH = lane0 >= 32; const unsigned char* vrow = V8 + (lane0 & 31) * 16;
#pragma unroll
      for (int k = 0; k < 16; ++k) vv[k] = *(const u32x4*)(vrow + (size_t)ROW2(e0v, k) * 512); }
    GSB();
    for (; t < T; t += tstride) {
      const int b = t >> 12;
      int lane = lane0; asm volatile("" : "+v"(lane));
      const int l31 = lane & 31; const bool hiH = lane >= 32;
      const unsigned char* vrow = V8 + l31 * 16;
      const int tn = t + tstride < T ? t + tstride : t;
      const int e0n = __builtin_nontemporal_load(IDX + (size_t)tn * 128 + lane), e1n = __builtin_nontemporal_load(IDX + (size_t)tn * 128 + 64 + lane);
      const int pkn = __builtin_nontemporal_load(GPK + (size_t)tn * 64 + lane); const f32x2 cmn = GCM[tn];
      int cb = l31 * 32 + (lane >> 5) * 16; asm volatile("" : "+v"(cb));
      u32x4 r1w[2];
#pragma unroll
      for (int q = 0; q < 2; ++q) r1w[q] = __builtin_nontemporal_load((const u32x4*)((const bf16_t*)(p.ws + OFF_R1B) + (size_t)t * 1024 + cb + q * 8));
      const int cq0 = pk, cq1 = pk >> 8; const float cm = cmv[0], csum = cmv[1];
      int accL[16], accB[16];
#pragma unroll
      for (int k = 0; k < 16; ++k) { accL[k] = 0; accB[k] = 0; }
      GSB();
#pragma unroll
      for (int i = 0; i < 64; ++i) {
      const int c0_ = ROW2(i < 32 ? cq0 : cq1, i & 31) & 0xff, c1_ = c0_ << 8, c2_ = c0_ << 16, c3_ = c0_ << 24;
#pragma unroll
      for (int d = 0; d < 4; ++d) { const int x = (int)vv[i & 15][d]; const int lo_ = x & 0x0f0f0f0f;
        accL[4 * d + 0] = __builtin_amdgcn_sdot4(lo_, c0_, accL[4 * d + 0], false); accL[4 * d + 1] = __builtin_amdgcn_sdot4(lo_, c1_, accL[4 * d + 1], false);
        accL[4 * d + 2] = __builtin_amdgcn_sdot4(lo_, c2_, accL[4 * d + 2], false); accL[4 * d + 3] = __builtin_amdgcn_sdot4(lo_, c3_, accL[4 * d + 3], false);
        accB[4 * d + 0] = __builtin_amdgcn_sdot4(x, c0_, accB[4 * d + 0], false); accB[4 * d + 1] = __builtin_amdgcn_sdot4(x, c1_, accB[4 * d + 1], false);
        accB[4 * d + 2] = __builtin_amdgcn_sdot4(x, c2_, accB[4 * d + 2], false); accB[4 * d + 3] = __builtin_amdgcn_sdot4(x, c3_, accB[4 * d + 3], false); }
      if (i + 16 < 64) vv[i & 15] = *(const u32x4*)(vrow + (size_t)ROW2((i + 16) < 32 ? e0v : e1v, (i + 16) & 31) * 512);
        else vv[i & 15] = *(const u32x4*)(vrow + (size_t)ROW2(e0n, i - 48) * 512);
        GSB();
      }
    float fin[16];
    { const float cs = cm * (1.f / 127.f);
#pragma unroll
      for (int m = 0; m < 8; ++m) { auto rl_ = __builtin_amdgcn_permlane32_swap((unsigned)accL[m], (unsigned)accL[m + 8], false, false); auto rb_ = __builtin_amdgcn_permlane32_swap((unsigned)accB[m], (unsigned)accB[m + 8], false, false);
        const int L_ = (int)rl_[0] + (int)rl_[1], B_ = (int)rb_[0] + (int)rb_[1];
        fin[8 * (m >> 2) + (m & 3)] = cs * ((float)L_ - 7.5f * csum); fin[8 * (m >> 2) + 4 + (m & 3)] = cs * ((float)(B_ - L_) * 0.0625f + 0.5f * csum); } }
    float r2[16]; float s = 0.f;
    { float s1 = 0.f; f32x4 r1v[4];
#pragma unroll
      for (int q = 0; q < 4; ++q) { const unsigned a_ = r1w[q >> 1][2 * (q & 1)], b_ = r1w[q >> 1][2 * (q & 1) + 1]; r1v[q] = (f32x4){__uint_as_float(a_ << 16), __uint_as_float(a_ & 0xffff0000u), __uint_as_float(b_ << 16), __uint_as_float(b_ & 0xffff0000u)}; }
#pragma unroll
      for (int q = 0; q < 4; ++q) s1 += (r1v[q][0] + r1v[q][1]) + (r1v[q][2] + r1v[q][3]);
      const float m1 = wave_sum(s1) * (1.f / 1024.f); float q1 = 0.f;
#pragma unroll
      for (int q = 0; q < 4; ++q) { const f32x4 d = r1v[q] - m1; q1 += (d[0] * d[0] + d[1] * d[1]) + (d[2] * d[2] + d[3] * d[3]); }
      const float rs1 = rsqrtf(wave_sum(q1) * (1.f / 1024.f) + EPS);
#pragma unroll
      for (int q = 0; q < 4; ++q) { const float* pq = pl + (q * 64 + lane) * 4; const f32x4 g1 = *(const f32x4*)pq, b1 = *(const f32x4*)(pq + 1024), g2 = *(const f32x4*)(pq + 4096 + b * 1024);
#pragma unroll
        for (int k = 0; k < 4; ++k) { const float x1 = (r1v[q][k] - m1) * rs1 * g1[k] + b1[k]; r2[q * 4 + k] = fmaf(g2[k], fin[q * 4 + k], ALPHA * x1); s += r2[q * 4 + k]; } } }
    const float mean = wave_sum(s) * (1.f / 1024.f); float qq = 0.f;
#pragma unroll
    for (int k = 0; k < 16; ++k) { const float d = r2[k] - mean; qq = fmaf(d, d, qq); }
    const float rstd = rsqrtf(wave_sum(qq) * (1.f / 1024.f) + EPS);
#pragma unroll
    for (int q = 0; q < 4; ++q) { const int col = cb + q * 4; const float* pq = pl + (q * 64 + lane) * 4; const f32x4 g = *(const f32x4*)(pq + 2048), bb = *(const f32x4*)(pq + 3072); f32x4 o;
#pragma unroll
      for (int k = 0; k < 4; ++k) o[k] = (r2[q * 4 + k] - mean) * rstd * g[k] + bb[k];
      __builtin_nontemporal_store(o, (f32x4*)(p.out + (size_t)t * 1024 + col)); }
      e0v = e0n; e1v = e1n; pk = pkn; cmv = cmn;
    }
  }
#undef ROW2
#undef GSB
}

template <int MODE>
__device__ void mfma_probe(const Params& p) {
  i32x8 a = {1, 2, 3, 4, 5, 6, 7, 8}, b = {8, 7, 6, 5, 4, 3, 2, 1}; f32x16 c0 = {}, c1 = {}, c2 = {}, c3 = {}; float e[32];
#pragma unroll
  for (int i = 0; i < 32; ++i) e[i] = (float)(threadIdx.x + i) * 1e-3f;
  const int sc = 0x7f7f7f7f;
#define PM(C) asm volatile("v_mfma_scale_f32_32x32x64_f8f6f4 %0, %1, %2, %0, %3, %3 op_sel_hi:[0,0,0]" : "+v"(C) : "v"(a), "v"(b), "v"(sc))
#define PE(i0) do { _Pragma("unroll") for (int i = (i0); i < (i0) + 8; ++i) asm volatile("v_exp_f32 %0, %0" : "+v"(e[i])); } while (0)
#pragma nounroll
  for (int it = 0; it < 2000; ++it) {
    if (MODE & 1) PM(c0); if (MODE & 2) PE(0);
    if (MODE & 1) PM(c1); if (MODE & 2) PE(8);
    if (MODE & 1) PM(c2); if (MODE & 2) PE(16);
    if (MODE & 1) PM(c3); if (MODE & 2) PE(24);
  }
#undef PM
#undef PE
  float s_ = 0.f;
#pragma unroll
  for (int i = 0; i < 32; ++i) s_ += e[i];
  s_ += c0[0] + c1[1] + c2[2] + c3[3];
  if (s_ == 12345.678f) *(float*)(p.ws + OFF_LAM + 64) = s_;
}
#define REPEAT(id, call) do { int nrep_ = (PROBE_DUP == (id)) ? 2 : 1; asm volatile("" : "+s"(nrep_)); for (int rep_ = 0; rep_ < nrep_; ++rep_) { call; } } while (0)
__global__ void __launch_bounds__(NTHR) fwd_mega(Params p) {
  extern __shared__ __attribute__((aligned(16))) char lds[];
  cg::grid_group grid = cg::this_grid();
  volatile LAS unsigned* xst = (volatile LAS unsigned*)(lds + LDS_BYTES - 16);
  if (threadIdx.x == 0) { xst[0] = 0u; xst[1] = 0u; }
  __syncthreads();
  const XcdBarrier xb = xcd_barrier_post((unsigned*)(p.ws + OFF_BAR), xst);
#if PROBE_DUP >= 300 && PROBE_DUP < 304
  mfma_probe<PROBE_DUP - 300>(p);
#endif
  { int nrep0_ = (PROBE_DUP == 30) ? 2 : 1; asm volatile("" : "+s"(nrep0_)); for (int rep0_ = 0; rep0_ < nrep0_; ++rep0_) {
  p0_misc(p);
  REPEAT(32, p0_mod(p, lds));
  { int nrt_ = (PROBE_DUP == 33) ? 2 : 1; asm volatile("" : "+s"(nrt_)); for (int rt_ = 0; rt_ < nrt_; ++rt_) { int jc = 0;
    p0_transpose(p.w_in, 1024, IN_COLS, IN_PAD, (bf16_t*)(p.ws + OFF_WINT), nullptr, lds, jc, jc, -W8S);
    p0_transpose(p.w_q_up, 256, 1536, 1536, (bf16_t*)(p.ws + OFF_WQUPT), p.q_norm_g, lds, jc, jc, -32.f);
    p0_transpose(p.w_kv_up, 256, 2048, 2048, (bf16_t*)(p.ws + OFF_WKVUPT), p.kv_norm_g, lds, jc, jc, -32.f);
    p0_transpose(p.w_pa, 1024, 1024, 1024, (bf16_t*)(p.ws + OFF_WPAT), nullptr, lds, jc, jc, W8S);
    p0_transpose(p.w_pb, 1024, 1024, 1024, (bf16_t*)(p.ws + OFF_WPBT), nullptr, lds, jc, jc, W8S);
    p0_transpose(p.w_out, 1024, 1024, 1024, (bf16_t*)(p.ws + OFF_WOUTT), nullptr, lds, jc, jc, W8S); } }
  REPEAT(34, p0_weff(p, lds));
  } }
  grid.sync();
  p0_mod_reduce(p);
  xcd_barrier(xb);
  REPEAT(8, p0b_hmod(p));
  xcd_barrier(xb);
#if PROBE_DUP == 16
  g1_phase<1>(p, lds);
#elif PROBE_DUP == 17
  g1_phase<2>(p, lds);
#endif
  REPEAT(3, g1_phase<0>(p, lds));
  xcd_barrier(xb);
  REPEAT(4, g2_phase(p, lds));
  xcd_barrier(xb);
#if PROBE_DUP == 1
  att_phase<false>(p, lds);
#elif PROBE_DUP == 14
  att_phase<false, 1>(p, lds);
#elif PROBE_DUP == 15
  att_phase<false, 2>(p, lds);
#elif PROBE_DUP >= 100 && PROBE_DUP < 200
  att_phase<false, 2, PROBE_DUP - 100>(p, lds);
#elif PROBE_DUP >= 200 && PROBE_DUP < 300
  att_phase<false, 1, PROBE_DUP - 200>(p, lds);
#endif
  att_phase<true>(p, lds);
  xcd_barrier(xb);
  REPEAT(5, g3_phase(p, lds));
  xcd_barrier(xb);
  REPEAT(9, g4_phase(p, lds));
  xcd_barrier(xb);
  ln1_phase<false>(p);
  xcd_barrier(xb);
#if PROBE_DUP == 11
  g5_phase<1>(p, lds);
#elif PROBE_DUP == 12
  g5_phase<2>(p, lds);
#elif PROBE_DUP == 13
  g5_phase<3>(p, lds);
#endif
  REPEAT(6, g5_phase<0>(p, lds));
  xcd_barrier(xb);
#if PROBE_DUP == 2
  gather_phase<false>(p);
#elif PROBE_DUP >= 20 && PROBE_DUP < 24
  gather_phase<false, PROBE_DUP - 20>(p);
#endif
  gather2_phase<1>(p, lds);
  xcd_barrier(xb);
  gather2_phase<2>(p, lds);
}

extern "C" void kernel_launch(void* const* d_in, const int* in_sizes, int n_in, void* d_out, int out_size, void* d_ws, size_t ws_size, hipStream_t stream) {
  static int grid_blocks = 0;
  if (grid_blocks == 0) {
    if (n_in != 27 || out_size != T * DM || ws_size < WS_END) { fprintf(stderr, "kernel_launch: unexpected shapes n_in %d out %d ws %zu (need %zu)\n", n_in, out_size, ws_size, (size_t)WS_END); grid_blocks = -1; return; }
    int dev = 0, cus = 0, per_cu = 0;
    hipGetDevice(&dev); hipDeviceGetAttribute(&cus, hipDeviceAttributeMultiprocessorCount, dev);
    if (hipFuncSetAttribute((const void*)fwd_mega, hipFuncAttributeMaxDynamicSharedMemorySize, LDS_BYTES) != hipSuccess) { fprintf(stderr, "kernel_launch: hipFuncSetAttribute failed\n"); grid_blocks = -1; return; }
    if (hipOccupancyMaxActiveBlocksPerMultiprocessor(&per_cu, (const void*)fwd_mega, NTHR, LDS_BYTES) != hipSuccess || per_cu < 1) { fprintf(stderr, "kernel_launch: occupancy query failed (%d)\n", per_cu); grid_blocks = -1; return; }
    grid_blocks = cus;
    fprintf(stderr, "kernel_launch: cus %d per_cu %d grid %d\n", cus, per_cu, grid_blocks);
  }
  if (grid_blocks < 0) return;
  Params p{};
  const float** f = (const float**)&p;
  for (int i = 0; i < 27; ++i) f[i] = (const float*)d_in[i];
  p.out = (float*)d_out; p.ws = (unsigned char*)d_ws;
  if (hipMemsetAsync((char*)d_ws + OFF_BAR, 0, XCD_BAR_WORDS * 4, stream) != hipSuccess) { fprintf(stderr, "kernel_launch: memset failed\n"); return; }
  void* args[] = {&p};
  hipError_t e = hipLaunchCooperativeKernel((const void*)fwd_mega, dim3(grid_blocks), dim3(NTHR), args, LDS_BYTES, stream);
  if (e != hipSuccess) fprintf(stderr, "kernel_launch: cooperative launch failed: %s (grid %d)\n", hipGetErrorString(e), grid_blocks);
}
```
